# Optimizing an MI355X kernel written in HIP

```python
import math
import jax, jax.numpy as jnp
from jax import lax
import numpy as np

D_MODEL = 1024
BATCH = 16
SEQ = 2048
DEPTH = 1
DEC_BATCH = 32
DEC_SEQ = 16
PAST_LEN = 1024

CHUNK = 64
A_HEADS = 16
A_HEAD_DIM = D_MODEL // A_HEADS
A_LEFT_CHUNKS = 8
A_WINDOW = A_LEFT_CHUNKS * CHUNK
A_BAND = A_WINDOW + CHUNK
A_REL_CLIP = 128
B_HEADS = 8
B_HEAD_DIM = D_MODEL // B_HEADS
B_CONV = 4
MEM_TOKENS = 256
C_HEADS = 4
C_HEAD_DIM = D_MODEL // C_HEADS
D_FF = 4 * D_MODEL

A_WIDTH = A_HEADS * A_HEAD_DIM
B_WIDTH = B_HEADS * B_HEAD_DIM
C_WIDTH = C_HEADS * C_HEAD_DIM
N_BRANCH = 3
IN_COLS = 3 * A_WIDTH + 3 * B_WIDTH + C_WIDTH + N_BRANCH * D_MODEL + 2 * B_HEADS
DN_ALPHA = (2.0 * DEPTH) ** 0.25
DN_BETA = (8.0 * DEPTH) ** -0.25
LN_EPS = 1e-5
RMS_EPS = 1e-6
L2_EPS = 1e-6
NEG_INF = -1e30

kernel_name = 'hybrid_stream_chunkband_gdn_mem'


def _layer_norm(x, g, b):
    xf = x.astype(jnp.float32)
    mu = jnp.mean(xf, axis=-1, keepdims=True)
    var = jnp.mean(jnp.square(xf - mu), axis=-1, keepdims=True)
    return ((xf - mu) * lax.rsqrt(var + LN_EPS) * g.astype(jnp.float32) + b.astype(jnp.float32)).astype(x.dtype)


def _l2norm(x):
    return x * lax.rsqrt(jnp.sum(jnp.square(x), axis=-1, keepdims=True) + L2_EPS)


def _split_in(z):
    sizes = (A_WIDTH, A_WIDTH, A_WIDTH, 3 * B_WIDTH, C_WIDTH, N_BRANCH * D_MODEL, B_HEADS, B_HEADS)
    offs = tuple(int(o) for o in np.cumsum(sizes)[:-1])
    return jnp.split(z, offs, axis=-1)


def _band_attention(q, k, v, q_pos, k_pos, k_valid, rel_bias):
    s = jnp.einsum('bqhd,bkhd->bhqk', q, k).astype(jnp.float32) * (A_HEAD_DIM ** -0.5)
    rel = jnp.clip(q_pos[:, None] - k_pos[None, :], -A_REL_CLIP, A_REL_CLIP) + A_REL_CLIP
    s = s + rel_bias[:, rel].astype(jnp.float32)[None]
    s = jnp.where(k_valid[None, None, None, :], s, NEG_INF)
    p = jax.nn.softmax(s, axis=-1).astype(v.dtype)
    return jnp.einsum('bhqk,bkhd->bqhd', p, v)


def _chunk_band_prompt(q, k, v, rel_bias):
    bsz, t = q.shape[0], q.shape[1]
    nc = t // CHUNK
    pad = ((0, 0), (A_WINDOW, 0), (0, 0), (0, 0))
    kp = jnp.pad(k, pad)
    vp = jnp.pad(v, pad)
    qc = jnp.moveaxis(q.reshape(bsz, nc, CHUNK, A_HEADS, A_HEAD_DIM), 1, 0)

    def one_chunk(args):
        c, qb = args
        start = c * CHUNK
        kb = lax.dynamic_slice_in_dim(kp, start, A_BAND, axis=1)
        vb = lax.dynamic_slice_in_dim(vp, start, A_BAND, axis=1)
        q_pos = start + jnp.arange(CHUNK)
        k_pos = start - A_WINDOW + jnp.arange(A_BAND)
        return _band_attention(qb, kb, vb, q_pos, k_pos, k_pos >= 0, rel_bias)

    out = lax.map(one_chunk, (jnp.arange(nc), qc))
    return jnp.moveaxis(out, 0, 1).reshape(bsz, t, A_WIDTH)


def _causal_conv(x, buf, w):
    t = x.shape[1]
    xp = jnp.concatenate([buf.astype(x.dtype), x], axis=1)
    y = xp[:, 0:t] * w[0]
    for i in range(1, B_CONV):
        y = y + xp[:, i:i + t] * w[i]
    return jax.nn.silu(y), xp[:, xp.shape[1] - (B_CONV - 1):]


def _gated_delta(q, k, v, g, beta, state):
    bsz, t, h, dk = k.shape
    dv = v.shape[-1]
    c = min(CHUNK, t)
    nc = t // c

    def blk(a):
        return jnp.swapaxes(a.reshape((bsz, nc, c) + a.shape[2:]), 2, 3)

    qc, kc, vc, gc, bc = blk(q), blk(k), blk(v), blk(g), blk(beta)
    G = jnp.cumsum(gc, axis=-1)
    diff = G[..., :, None] - G[..., None, :]
    tri_strict = jnp.tril(jnp.ones((c, c), dtype=bool), -1)
    tri_incl = jnp.tril(jnp.ones((c, c), dtype=bool))
    dec_strict = jnp.exp(jnp.where(tri_strict, diff, -jnp.inf))
    dec_incl = jnp.exp(jnp.where(tri_incl, diff, -jnp.inf))
    a_kk = bc[..., :, None] * jnp.einsum('bnhtd,bnhsd->bnhts', kc, kc) * dec_strict
    lower = jnp.eye(c, dtype=q.dtype) + a_kk
    rhs = jnp.concatenate([bc[..., None] * vc, (bc * jnp.exp(G))[..., None] * kc], axis=-1)
    sol = lax.linalg.triangular_solve(lower, rhs, left_side=True, lower=True, unit_diagonal=True)
    u_blk, w_blk = sol[..., :dv], sol[..., dv:]
    a_qk = jnp.einsum('bnhtd,bnhsd->bnhts', qc, kc) * dec_incl
    q_dec = qc * jnp.exp(G)[..., None]
    k_dec = kc * jnp.exp(G[..., -1:] - G)[..., None]
    g_end = jnp.exp(G[..., -1])

    def step(s, inp):
        u_n, w_n, qd_n, aqk_n, kd_n, ge_n = inp
        wv = u_n - jnp.einsum('bhtk,bhkv->bhtv', w_n, s)
        o = jnp.einsum('bhtk,bhkv->bhtv', qd_n, s) + jnp.einsum('bhts,bhsv->bhtv', aqk_n, wv)
        s = ge_n[..., None, None] * s + jnp.einsum('bhsk,bhsv->bhkv', kd_n, wv)
        return s, o

    xs = tuple(jnp.moveaxis(a, 1, 0) for a in (u_blk, w_blk, q_dec, a_qk, k_dec, g_end))
    s_final, o = lax.scan(step, state, xs)
    o = jnp.transpose(o, (1, 0, 3, 2, 4)).reshape(bsz, t, h, dv)
    return o, s_final


def _mixer_b(qkv_b, a_b, b_b, conv_buf, state, conv_w, a_log, dt_bias, norm_g):
    bsz, t, _ = qkv_b.shape
    y, new_buf = _causal_conv(qkv_b, conv_buf, conv_w)
    y = y.astype(jnp.float32).reshape(bsz, t, 3, B_HEADS, B_HEAD_DIM)
    q = _l2norm(y[:, :, 0]) * (B_HEAD_DIM ** -0.5)
    k = _l2norm(y[:, :, 1])
    v = y[:, :, 2]
    g = -jnp.exp(a_log.astype(jnp.float32)) * jax.nn.softplus(a_b.astype(jnp.float32) + dt_bias.astype(jnp.float32))
    beta = jax.nn.sigmoid(b_b.astype(jnp.float32))
    o, new_state = _gated_delta(q, k, v, g, beta, state.astype(jnp.float32))
    o = o * lax.rsqrt(jnp.mean(jnp.square(o), axis=-1, keepdims=True) + RMS_EPS) * norm_g.astype(jnp.float32)
    return o.reshape(bsz, t, B_WIDTH).astype(qkv_b.dtype), new_buf, new_state.astype(qkv_b.dtype)


def _mem_kv(mem, w_kv):
    bsz, m, _ = mem.shape
    kv = (mem @ w_kv).reshape(bsz, m, 2, C_HEADS, C_HEAD_DIM)
    return kv[:, :, 0], kv[:, :, 1]


def _mem_attention(q, mk, mv):
    s = jnp.einsum('bqhd,bmhd->bhqm', q, mk).astype(jnp.float32) * (C_HEAD_DIM ** -0.5)
    p = jax.nn.softmax(s, axis=-1).astype(mv.dtype)
    o = jnp.einsum('bhqm,bmhd->bqhd', p, mv)
    return o.reshape(q.shape[0], q.shape[1], C_WIDTH)


def _merge_and_ffn(x, o_a, o_b, o_c, gate_logits, w_out, ln1_g, ln1_b, w_ff1, b_ff1, w_ff2, b_ff2, ln2_g, ln2_b):
    bsz, t, _ = x.shape
    gates = jax.nn.sigmoid(gate_logits.reshape(bsz, t, N_BRANCH, D_MODEL))
    merged = jnp.sum(gates * jnp.stack([o_a, o_b, o_c], axis=2), axis=2)
    h = _layer_norm(DN_ALPHA * x + merged @ w_out, ln1_g, ln1_b)
    f = jnp.square(jax.nn.relu(h @ w_ff1 + b_ff1)) @ w_ff2 + b_ff2
    return _layer_norm(DN_ALPHA * h + f, ln2_g, ln2_b)


def setup_inputs(seed: int = 0) -> dict:
    key = jax.random.key(seed)
    ks = jax.random.split(key, 26)
    f32 = jnp.float32
    a_cache = min(A_WINDOW, PAST_LEN)

    def nrm(k, shape, scale=1.0):
        return jax.random.normal(k, shape, f32) * scale

    dt = jnp.exp(jax.random.uniform(ks[12], (DEPTH, B_HEADS), f32, math.log(1e-3), math.log(1e-1)))
    return {
        'x_prompt': nrm(ks[0], (BATCH, SEQ, D_MODEL)),
        'x_sample': nrm(ks[1], (DEC_BATCH, DEC_SEQ, D_MODEL)),
        'cache_a_k': nrm(ks[2], (DEPTH, DEC_BATCH, a_cache, A_HEADS, A_HEAD_DIM)),
        'cache_a_v': nrm(ks[3], (DEPTH, DEC_BATCH, a_cache, A_HEADS, A_HEAD_DIM)),
        'state_b_conv': nrm(ks[4], (DEPTH, DEC_BATCH, B_CONV - 1, 3 * B_WIDTH)),
        'state_b_ssm': nrm(ks[5], (DEPTH, DEC_BATCH, B_HEADS, B_HEAD_DIM, B_HEAD_DIM), 0.1),
        'cache_mem_k': nrm(ks[6], (DEPTH, DEC_BATCH, MEM_TOKENS, C_HEADS, C_HEAD_DIM)),
        'cache_mem_v': nrm(ks[7], (DEPTH, DEC_BATCH, MEM_TOKENS, C_HEADS, C_HEAD_DIM)),
        'mem_prompt': nrm(ks[8], (BATCH, MEM_TOKENS, D_MODEL)),
        'w_in': nrm(ks[9], (DEPTH, D_MODEL, IN_COLS), D_MODEL ** -0.5),
        'w_b_conv': nrm(ks[10], (DEPTH, B_CONV, 3 * B_WIDTH), B_CONV ** -0.5),
        'b_a_log': jnp.log(jax.random.uniform(ks[11], (DEPTH, B_HEADS), f32, 1.0, 16.0)),
        'b_dt_bias': dt + jnp.log(-jnp.expm1(-dt)),
        'b_norm_g': 1.0 + nrm(ks[13], (DEPTH, B_HEAD_DIM), 0.05),
        'a_rel_bias': nrm(ks[14], (DEPTH, A_HEADS, 2 * A_REL_CLIP + 1), 0.5),
        'w_mem_kv': nrm(ks[15], (DEPTH, D_MODEL, 2 * C_WIDTH), D_MODEL ** -0.5),
        'w_out': nrm(ks[16], (DEPTH, D_MODEL, D_MODEL), D_MODEL ** -0.5 * DN_BETA),
        'ln1_g': 1.0 + nrm(ks[17], (DEPTH, D_MODEL), 0.05),
        'ln1_b': nrm(ks[18], (DEPTH, D_MODEL), 0.05),
        'w_ff1': nrm(ks[19], (DEPTH, D_MODEL, D_FF), D_MODEL ** -0.5),
        'b_ff1': nrm(ks[20], (DEPTH, D_FF), 0.05),
        'w_ff2': nrm(ks[21], (DEPTH, D_FF, D_MODEL), D_FF ** -0.5 * DN_BETA),
        'b_ff2': nrm(ks[22], (DEPTH, D_MODEL), 0.05),
        'ln2_g': 1.0 + nrm(ks[23], (DEPTH, D_MODEL), 0.05),
        'ln2_b': nrm(ks[24], (DEPTH, D_MODEL), 0.05),
    }


def reference(x_prompt, x_sample, cache_a_k, cache_a_v, state_b_conv, state_b_ssm,
              cache_mem_k, cache_mem_v, mem_prompt, w_in, w_b_conv, b_a_log, b_dt_bias,
              b_norm_g, a_rel_bias, w_mem_kv, w_out, ln1_g, ln1_b, w_ff1, b_ff1,
              w_ff2, b_ff2, ln2_g, ln2_b):
    bp, tp, _ = x_prompt.shape
    bs, tn, _ = x_sample.shape
    keep_p = min(A_WINDOW, tp)
    lc = cache_a_k.shape[2]
    xp, xs = x_prompt, x_sample
    a_k_p, a_v_p, conv_p, ssm_p, mk_p, mv_p = [], [], [], [], [], []
    a_k_s, a_v_s, conv_s, ssm_s = [], [], [], []
    for l in range(DEPTH):
        ffn_w = (w_out[l], ln1_g[l], ln1_b[l], w_ff1[l], b_ff1[l], w_ff2[l], b_ff2[l], ln2_g[l], ln2_b[l])
        q_a, k_a, v_a, qkv_b, q_c, g_logit, a_b, b_b = _split_in(xp @ w_in[l])
        q_a, k_a, v_a = (t.reshape(bp, tp, A_HEADS, A_HEAD_DIM) for t in (q_a, k_a, v_a))
        o_a = _chunk_band_prompt(q_a, k_a, v_a, a_rel_bias[l])
        conv0 = jnp.zeros((bp, B_CONV - 1, 3 * B_WIDTH), xp.dtype)
        ssm0 = jnp.zeros((bp, B_HEADS, B_HEAD_DIM, B_HEAD_DIM), jnp.float32)
        o_b, cbuf, ssm = _mixer_b(qkv_b, a_b, b_b, conv0, ssm0, w_b_conv[l], b_a_log[l], b_dt_bias[l], b_norm_g[l])
        mk, mv = _mem_kv(mem_prompt, w_mem_kv[l])
        o_c = _mem_attention(q_c.reshape(bp, tp, C_HEADS, C_HEAD_DIM), mk, mv)
        xp = _merge_and_ffn(xp, o_a, o_b, o_c, g_logit, *ffn_w)
        a_k_p.append(k_a[:, tp - keep_p:])
        a_v_p.append(v_a[:, tp - keep_p:])
        conv_p.append(cbuf)
        ssm_p.append(ssm)
        mk_p.append(mk)
        mv_p.append(mv)
        q_a, k_a, v_a, qkv_b, q_c, g_logit, a_b, b_b = _split_in(xs @ w_in[l])
        q_a, k_a, v_a = (t.reshape(bs, tn, A_HEADS, A_HEAD_DIM) for t in (q_a, k_a, v_a))
        k_all = jnp.concatenate([cache_a_k[l], k_a], axis=1)
        v_all = jnp.concatenate([cache_a_v[l], v_a], axis=1)
        q_pos = PAST_LEN + jnp.arange(tn)
        k_pos = PAST_LEN - lc + jnp.arange(lc + tn)
        o_a = _band_attention(q_a, k_all, v_all, q_pos, k_pos, k_pos >= 0, a_rel_bias[l]).reshape(bs, tn, A_WIDTH)
        o_b, cbuf, ssm = _mixer_b(qkv_b, a_b, b_b, state_b_conv[l], state_b_ssm[l], w_b_conv[l], b_a_log[l], b_dt_bias[l], b_norm_g[l])
        o_c = _mem_attention(q_c.reshape(bs, tn, C_HEADS, C_HEAD_DIM), cache_mem_k[l], cache_mem_v[l])
        xs = _merge_and_ffn(xs, o_a, o_b, o_c, g_logit, *ffn_w)
        a_k_s.append(k_all[:, tn:])
        a_v_s.append(v_all[:, tn:])
        conv_s.append(cbuf)
        ssm_s.append(ssm)
    return (xp, xs,
            jnp.stack(a_k_p), jnp.stack(a_v_p), jnp.stack(conv_p), jnp.stack(ssm_p),
            jnp.stack(mk_p), jnp.stack(mv_p),
            jnp.stack(a_k_s), jnp.stack(a_v_s), jnp.stack(conv_s), jnp.stack(ssm_s))
```

```cpp
#include <hip/hip_runtime.h>
#include <cstdio>
#include <cstdint>

constexpr int DM = 1024, BATCH = 16, SEQ = 2048, DEC_B = 32, DEC_T = 16, PAST = 1024;
constexpr int CHUNK = 64, AH = 16, AHD = 64, AWIN = 512, ABAND = 576, ACLIP = 128;
constexpr int BH = 8, BHD = 128, MEMT = 256, CH = 4, CHD = 256, DFF = 4096;
constexpr int ZW = 10256;
constexpr int ZQ_A = 0, ZK_A = 1024, ZV_A = 2048, ZB = 3072, ZQ_C = 6144, ZG = 7168, ZA_B = 10240, ZB_B = 10248;
constexpr float DN_ALPHA = 1.189207115002721f;
constexpr float LN_EPS = 1e-5f, RMS_EPS = 1e-6f, L2_EPS = 1e-6f;

constexpr size_t O_YP = 0, O_YS = 33554432, O_AKP = 34078720, O_AVP = 42467328, O_CONVP = 50855936, O_SSMP = 51003392,
                 O_MKP = 53100544, O_MVP = 57294848, O_AKS = 61489152, O_AVS = 78266368, O_CONVS = 95043584, O_SSMS = 95338496;

struct GemmP {
    const float* A; const float* B; float* C; const float* bias;
    int M, N, K, lda, ldb, ldc; int nz1; long sA0, sA1, sB0, sB1, sC0, sC1; int act; float scale;
};
template <int TB>
__global__ void __launch_bounds__(256) gemm_naive(GemmP p) {
    __shared__ float As[16][65];
    __shared__ float Bs[16][65];
    const int z0 = blockIdx.z / p.nz1, z1 = blockIdx.z % p.nz1;
    const float* A = p.A + z0 * p.sA0 + z1 * p.sA1;
    const float* B = p.B + z0 * p.sB0 + z1 * p.sB1;
    float* C = p.C + z0 * p.sC0 + z1 * p.sC1;
    const int tid = threadIdx.x, tx = tid & 15, ty = tid >> 4;
    const int m0 = blockIdx.y * 64, n0 = blockIdx.x * 64;
    float acc[4][4];
#pragma unroll
    for (int i = 0; i < 4; ++i)
#pragma unroll
        for (int j = 0; j < 4; ++j) acc[i][j] = 0.f;
    for (int k0 = 0; k0 < p.K; k0 += 16) {
        {
            const int r = tid >> 2, kk = (tid & 3) * 4;
            float4 v = make_float4(0.f, 0.f, 0.f, 0.f);
            if (m0 + r < p.M) v = *(const float4*)(A + (size_t)(m0 + r) * p.lda + k0 + kk);
            As[kk + 0][r] = v.x; As[kk + 1][r] = v.y; As[kk + 2][r] = v.z; As[kk + 3][r] = v.w;
        }
        if (TB == 0) {
            const int kk = tid >> 4, c = (tid & 15) * 4;
            float4 v = make_float4(0.f, 0.f, 0.f, 0.f);
            if (n0 + c < p.N) v = *(const float4*)(B + (size_t)(k0 + kk) * p.ldb + n0 + c);
            Bs[kk][c + 0] = v.x; Bs[kk][c + 1] = v.y; Bs[kk][c + 2] = v.z; Bs[kk][c + 3] = v.w;
        } else {
            const int r = tid >> 2, kk = (tid & 3) * 4;
            float4 v = make_float4(0.f, 0.f, 0.f, 0.f);
            if (n0 + r < p.N) v = *(const float4*)(B + (size_t)(n0 + r) * p.ldb + k0 + kk);
            Bs[kk + 0][r] = v.x; Bs[kk + 1][r] = v.y; Bs[kk + 2][r] = v.z; Bs[kk + 3][r] = v.w;
        }
        __syncthreads();
#pragma unroll
        for (int k = 0; k < 16; ++k) {
            float a[4], b[4];
#pragma unroll
            for (int i = 0; i < 4; ++i) a[i] = As[k][ty * 4 + i];
#pragma unroll
            for (int j = 0; j < 4; ++j) b[j] = Bs[k][tx * 4 + j];
#pragma unroll
            for (int i = 0; i < 4; ++i)
#pragma unroll
                for (int j = 0; j < 4; ++j) acc[i][j] += a[i] * b[j];
        }
        __syncthreads();
    }
#pragma unroll
    for (int i = 0; i < 4; ++i) {
        const int r = m0 + ty * 4 + i;
        if (r >= p.M) continue;
#pragma unroll
        for (int j = 0; j < 4; ++j) {
            const int c = n0 + tx * 4 + j;
            if (c >= p.N) continue;
            float v = acc[i][j] * p.scale;
            if (p.bias) v += p.bias[c];
            if (p.act == 1) { v = v > 0.f ? v : 0.f; v = v * v; }
            C[(size_t)r * p.ldc + c] = v;
        }
    }
}
static void gemm(hipStream_t st, int tb, const float* A, int lda, const float* B, int ldb, float* C, int ldc, int M, int N, int K,
                 const float* bias = nullptr, int act = 0, float scale = 1.f, int nz0 = 1, int nz1 = 1,
                 long sA0 = 0, long sA1 = 0, long sB0 = 0, long sB1 = 0, long sC0 = 0, long sC1 = 0) {
    GemmP p{}; p.A = A; p.B = B; p.C = C; p.bias = bias; p.M = M; p.N = N; p.K = K; p.lda = lda; p.ldb = ldb; p.ldc = ldc;
    p.nz1 = nz1; p.sA0 = sA0; p.sA1 = sA1; p.sB0 = sB0; p.sB1 = sB1; p.sC0 = sC0; p.sC1 = sC1; p.act = act; p.scale = scale;
    dim3 grid((N + 63) / 64, (M + 63) / 64, nz0 * nz1);
    if (tb) gemm_naive<1><<<grid, 256, 0, st>>>(p); else gemm_naive<0><<<grid, 256, 0, st>>>(p);
}

__device__ __forceinline__ float wave_sum(float v) {
#pragma unroll
    for (int o = 1; o < 64; o <<= 1) v += __shfl_xor(v, o);
    return v;
}
__device__ __forceinline__ float wave_max(float v) {
#pragma unroll
    for (int o = 1; o < 64; o <<= 1) v = fmaxf(v, __shfl_xor(v, o));
    return v;
}

__global__ void __launch_bounds__(256) attnA_naive(const float* Z, const float* ck, const float* cv, const float* relb, float* O, int nrows, int T, int sample) {
    __shared__ float pbuf[4][576];
    const int w = threadIdx.x >> 6, lane = threadIdx.x & 63;
    const long gw = (long)blockIdx.x * 4 + w;
    if (gw >= (long)nrows * AH) return;
    const int row = (int)(gw / AH), h = (int)(gw % AH);
    const int b = row / T, t = row % T;
    const float* q = Z + (size_t)row * ZW + ZQ_A + h * AHD;
    float qv[64];
#pragma unroll
    for (int d = 0; d < 64; ++d) qv[d] = q[d];
    int nkeys, qpos, kpos0;
    if (sample) { nkeys = 528; qpos = PAST + t; kpos0 = PAST - 512; }
    else { const int s = (t / CHUNK) * CHUNK; nkeys = ABAND; qpos = t; kpos0 = s - AWIN; }
    float sc[9]; float mx = -1e30f;
#pragma unroll
    for (int i = 0; i < 9; ++i) {
        const int j = lane + 64 * i; float s = -1e30f;
        if (j < nkeys) {
            const int kpos = kpos0 + j;
            if (kpos >= 0) {
                const float* kp;
                if (sample && j < 512) kp = ck + ((size_t)b * 512 + j) * 1024 + h * AHD;
                else { const int zr = sample ? (b * T + (j - 512)) : (b * T + kpos); kp = Z + (size_t)zr * ZW + ZK_A + h * AHD; }
                float a = 0.f;
#pragma unroll
                for (int d = 0; d < 64; ++d) a += qv[d] * kp[d];
                int rel = qpos - kpos; rel = rel < -ACLIP ? -ACLIP : (rel > ACLIP ? ACLIP : rel); rel += ACLIP;
                s = a * 0.125f + relb[h * 257 + rel];
            }
        }
        sc[i] = s; mx = fmaxf(mx, s);
    }
    mx = wave_max(mx);
    float sum = 0.f;
#pragma unroll
    for (int i = 0; i < 9; ++i) { const int j = lane + 64 * i; float e = 0.f; if (j < nkeys) { e = (sc[i] <= -1e29f) ? 0.f : __expf(sc[i] - mx); pbuf[w][j] = e; } sum += e; }
    sum = wave_sum(sum);
    __builtin_amdgcn_fence(__ATOMIC_RELEASE, "workgroup"); __builtin_amdgcn_wave_barrier();
    float o = 0.f;
    for (int j = 0; j < nkeys; ++j) {
        const float pj = pbuf[w][j];
        if (pj == 0.f) continue;
        const int kpos = kpos0 + j;
        const float* vp;
        if (sample && j < 512) vp = cv + ((size_t)b * 512 + j) * 1024 + h * AHD;
        else { const int zr = sample ? (b * T + (j - 512)) : (b * T + kpos); vp = Z + (size_t)zr * ZW + ZV_A + h * AHD; }
        o += pj * vp[lane];
    }
    O[(size_t)row * 1024 + h * AHD + lane] = o / sum;
}

__global__ void __launch_bounds__(256) softmax256(float* S, long nrows) {
    const long r = (long)blockIdx.x * 4 + (threadIdx.x >> 6); const int lane = threadIdx.x & 63;
    if (r >= nrows) return;
    float4 v = *(float4*)(S + r * 256 + lane * 4);
    float mx = wave_max(fmaxf(fmaxf(v.x, v.y), fmaxf(v.z, v.w)));
    v.x = __expf(v.x - mx); v.y = __expf(v.y - mx); v.z = __expf(v.z - mx); v.w = __expf(v.w - mx);
    const float s = 1.f / wave_sum(v.x + v.y + v.z + v.w);
    v.x *= s; v.y *= s; v.z *= s; v.w *= s;
    *(float4*)(S + r * 256 + lane * 4) = v;
}

__global__ void __launch_bounds__(256) gdn_prep(const float* Z, const float* convbuf  , const float* cw  ,
                                                const float* alog, const float* dtb, float* qn, float* kn, float* vv, float* gg, float* bb, int T) {
    const int row = blockIdx.x, b = row / T, t = row % T, tid = threadIdx.x;
    __shared__ float red[2][8][4];
    float y[12];
#pragma unroll
    for (int i = 0; i < 12; ++i) {
        const int c = tid + 256 * i;
        float acc = 0.f;
#pragma unroll
        for (int j = 0; j < 4; ++j) {
            const int tt = t + j - 3; float xv;
            if (tt >= 0) xv = Z[(size_t)(b * T + tt) * ZW + ZB + c];
            else xv = convbuf ? convbuf[((size_t)b * 3 + (tt + 3)) * 3072 + c] : 0.f;
            acc += xv * cw[j * 3072 + c];
        }
        y[i] = acc / (1.f + __expf(-acc));
    }
    const int wv = tid >> 6, lane = tid & 63;
#pragma unroll
    for (int i = 0; i < 8; ++i) {
        float s = wave_sum(y[i] * y[i]);
        if (lane == 0) red[i >> 2][2 * (i & 3) + (wv >> 1)][wv & 1] = s;
    }
    __syncthreads();
#pragma unroll
    for (int i = 0; i < 8; ++i) {
        const int hh = 2 * (i & 3) + (wv >> 1);
        const float s = red[i >> 2][hh][0] + red[i >> 2][hh][1];
        const float r = rsqrtf(s + L2_EPS);
        const int c = (tid + 256 * i) & 1023;
        if (i < 4) qn[(size_t)row * 1024 + c] = y[i] * r * 0.08838834764831845f;
        else kn[(size_t)row * 1024 + c] = y[i] * r;
    }
#pragma unroll
    for (int i = 8; i < 12; ++i) vv[(size_t)row * 1024 + ((tid + 256 * i) & 1023)] = y[i];
    if (tid < 8) {
        const float a = Z[(size_t)row * ZW + ZA_B + tid] + dtb[tid];
        const float sp = a > 20.f ? a : log1pf(__expf(a));
        gg[(size_t)row * 8 + tid] = -__expf(alog[tid]) * sp;
        const float bv = Z[(size_t)row * ZW + ZB_B + tid];
        bb[(size_t)row * 8 + tid] = 1.f / (1.f + __expf(-bv));
    }
}

__global__ void __launch_bounds__(128) gdn_rec(const float* qn, const float* kn, const float* vv, const float* gg, const float* bb,
                                               const float* S0  , const float* normg, float* Ob  , float* Sout  , int T) {
    const int b = blockIdx.x / BH, h = blockIdx.x % BH, j = threadIdx.x;
    __shared__ float qs[128], ks[128], red[2];
    float S[128];
#pragma unroll
    for (int i = 0; i < 128; ++i) S[i] = S0 ? S0[(((size_t)b * BH + h) * 128 + i) * 128 + j] : 0.f;
    for (int t = 0; t < T; ++t) {
        const size_t row = (size_t)b * T + t;
        __syncthreads();
        qs[j] = qn[row * 1024 + h * 128 + j]; ks[j] = kn[row * 1024 + h * 128 + j];
        const float v = vv[row * 1024 + h * 128 + j];
        const float g = gg[row * 8 + h], beta = bb[row * 8 + h];
        __syncthreads();
        const float eg = __expf(g);
        float kS = 0.f;
#pragma unroll
        for (int i = 0; i < 128; ++i) kS += ks[i] * S[i];
        const float c1 = beta * (v - eg * kS);
        float o = 0.f;
#pragma unroll
        for (int i = 0; i < 128; ++i) { S[i] = eg * S[i] + ks[i] * c1; o += qs[i] * S[i]; }
        float ss = wave_sum(o * o);
        __syncthreads();
        if ((j & 63) == 0) red[j >> 6] = ss;
        __syncthreads();
        const float ms = (red[0] + red[1]) * (1.f / 128.f);
        Ob[row * 1024 + h * 128 + j] = o * rsqrtf(ms + RMS_EPS) * normg[j];
    }
#pragma unroll
    for (int i = 0; i < 128; ++i) Sout[(((size_t)b * BH + h) * 128 + i) * 128 + j] = S[i];
}

__global__ void __launch_bounds__(256) merge_gate(const float* Z, const float* oa, const float* ob, const float* oc, float* mg, long n  ) {
    const long i = (long)blockIdx.x * 256 + threadIdx.x; if (i >= n) return;
    const long r = i >> 10; const int c = (int)(i & 1023);
    const float* z = Z + r * ZW + ZG;
    const float ga = 1.f / (1.f + __expf(-z[c])), gb = 1.f / (1.f + __expf(-z[1024 + c])), gc = 1.f / (1.f + __expf(-z[2048 + c]));
    mg[i] = ga * oa[i] + gb * ob[i] + gc * oc[i];
}
__global__ void __launch_bounds__(256) ln_rows(const float* res, const float* tt, const float* g, const float* bta, float* out, long nrows) {
    const long r = (long)blockIdx.x * 4 + (threadIdx.x >> 6); const int lane = threadIdx.x & 63;
    if (r >= nrows) return;
    float v[16]; float s = 0.f;
#pragma unroll
    for (int i = 0; i < 16; ++i) { const int c = lane + 64 * i; v[i] = DN_ALPHA * res[r * 1024 + c] + tt[r * 1024 + c]; s += v[i]; }
    const float mean = wave_sum(s) * (1.f / 1024.f); float q = 0.f;
#pragma unroll
    for (int i = 0; i < 16; ++i) { v[i] -= mean; q += v[i] * v[i]; }
    const float rstd = rsqrtf(wave_sum(q) * (1.f / 1024.f) + LN_EPS);
#pragma unroll
    for (int i = 0; i < 16; ++i) { const int c = lane + 64 * i; out[r * 1024 + c] = v[i] * rstd * g[c] + bta[c]; }
}
__global__ void __launch_bounds__(256) copy_rows(const float* src, float* dst, int w, int rpb, long sbs, long sld, long soff, long dbs, long dld, long doff, long total) {
    const long i = (long)blockIdx.x * 256 + threadIdx.x; if (i >= total) return;
    const long r = i / w; const int c = (int)(i % w);
    const long bb = r / rpb, rr = r % rpb;
    dst[bb * dbs + rr * dld + doff + c] = src[bb * sbs + rr * sld + soff + c];
}
static void copyrows(hipStream_t st, const float* src, float* dst, int w, int rpb, int nb, long sbs, long sld, long soff, long dbs, long dld, long doff) {
    const long total = (long)nb * rpb * w;
    copy_rows<<<(unsigned)((total + 255) / 256), 256, 0, st>>>(src, dst, w, rpb, sbs, sld, soff, dbs, dld, doff, total);
}

extern "C" void kernel_launch(void* const* d_in, const int* in_sizes, int n_in, void* d_out, int out_size, void* d_ws, size_t ws_size, hipStream_t stream) {
    const float* x_prompt = (const float*)d_in[0]; const float* x_sample = (const float*)d_in[1];
    const float* cache_a_k = (const float*)d_in[2]; const float* cache_a_v = (const float*)d_in[3];
    const float* state_conv = (const float*)d_in[4]; const float* state_ssm = (const float*)d_in[5];
    const float* cache_mk = (const float*)d_in[6]; const float* cache_mv = (const float*)d_in[7];
    const float* mem_prompt = (const float*)d_in[8]; const float* w_in = (const float*)d_in[9];
    const float* w_conv = (const float*)d_in[10]; const float* a_log = (const float*)d_in[11]; const float* dt_bias = (const float*)d_in[12];
    const float* norm_g = (const float*)d_in[13]; const float* rel_bias = (const float*)d_in[14]; const float* w_mem_kv = (const float*)d_in[15];
    const float* w_out = (const float*)d_in[16]; const float* ln1_g = (const float*)d_in[17]; const float* ln1_b = (const float*)d_in[18];
    const float* w_ff1 = (const float*)d_in[19]; const float* b_ff1 = (const float*)d_in[20]; const float* w_ff2 = (const float*)d_in[21];
    const float* b_ff2 = (const float*)d_in[22]; const float* ln2_g = (const float*)d_in[23]; const float* ln2_b = (const float*)d_in[24];
    float* out = (float*)d_out;
    if (ws_size < (size_t)500 * 1024 * 1024) { fprintf(stderr, "ws too small: %zu\n", ws_size); return; }
    fprintf(stderr, "ws_size = %zu\n", ws_size);

    constexpr int GB = 2; constexpr int GR = GB * SEQ;
    float* ws = (float*)d_ws; size_t off = 0;
    auto carve = [&](size_t n) { float* p = ws + off; off += (n + 63) & ~(size_t)63; return p; };
    float* Z = carve((size_t)GR * ZW);
    float* oa = carve((size_t)GR * 1024); float* ob = carve((size_t)GR * 1024); float* oc = carve((size_t)GR * 1024);
    float* qn = carve((size_t)GR * 1024); float* kn = carve((size_t)GR * 1024); float* vv = carve((size_t)GR * 1024);
    float* gg = carve((size_t)GR * 8); float* bb = carve((size_t)GR * 8);
    float* scr = carve((size_t)GR * CH * 256);
    float* mg = carve((size_t)GR * 1024); float* t1 = carve((size_t)GR * 1024); float* hbuf = carve((size_t)GR * 1024);
    float* ff = carve((size_t)GR * DFF);
    float* mkv = carve((size_t)GB * MEMT * 2048);
    (void)in_sizes; (void)n_in; (void)out_size;

    for (int pass = 0; pass <= BATCH / GB; ++pass) {
        const bool sample = (pass == BATCH / GB);
        const int nb = sample ? DEC_B : GB, T = sample ? DEC_T : SEQ, rows = nb * T, b0 = sample ? 0 : pass * GB;
        const float* x = sample ? x_sample : x_prompt + (size_t)b0 * SEQ * DM;
        float* y = sample ? out + O_YS : out + O_YP + (size_t)b0 * SEQ * DM;
        gemm(stream, 0, x, DM, w_in, ZW, Z, ZW, rows, ZW, DM);
        attnA_naive<<<(rows * AH + 3) / 4, 256, 0, stream>>>(Z, cache_a_k, cache_a_v, rel_bias, oa, rows, T, sample ? 1 : 0);
        gdn_prep<<<rows, 256, 0, stream>>>(Z, sample ? state_conv : nullptr, w_conv, a_log, dt_bias, qn, kn, vv, gg, bb, T);
        gdn_rec<<<nb * BH, 128, 0, stream>>>(qn, kn, vv, gg, bb, sample ? state_ssm : nullptr, norm_g, ob,
                                             sample ? out + O_SSMS : out + O_SSMP + (size_t)b0 * BH * 128 * 128, T);
        const float *mk, *mv; int ldm;
        if (sample) { mk = cache_mk; mv = cache_mv; ldm = 1024; }
        else {
            gemm(stream, 0, mem_prompt + (size_t)b0 * MEMT * DM, DM, w_mem_kv, 2048, mkv, 2048, GB * MEMT, 2048, DM);
            mk = mkv; mv = mkv + 1024; ldm = 2048;
            copyrows(stream, mkv, out + O_MKP + (size_t)b0 * MEMT * 1024, 1024, GB * MEMT, 1, 0, 2048, 0, 0, 1024, 0);
            copyrows(stream, mkv, out + O_MVP + (size_t)b0 * MEMT * 1024, 1024, GB * MEMT, 1, 0, 2048, 1024, 0, 1024, 0);
        }
        gemm(stream, 1, Z + ZQ_C, ZW, mk, ldm, scr, 256, T, MEMT, CHD, nullptr, 0, 0.0625f, nb, CH,
             (long)T * ZW, CHD, (long)MEMT * ldm, CHD, (long)CH * T * 256, (long)T * 256);
        softmax256<<<(unsigned)(((long)nb * CH * T + 3) / 4), 256, 0, stream>>>(scr, (long)nb * CH * T);
        gemm(stream, 0, scr, 256, mv, ldm, oc, 1024, T, CHD, MEMT, nullptr, 0, 1.f, nb, CH,
             (long)CH * T * 256, (long)T * 256, (long)MEMT * ldm, CHD, (long)T * 1024, CHD);
        merge_gate<<<(unsigned)(((long)rows * 1024 + 255) / 256), 256, 0, stream>>>(Z, oa, ob, oc, mg, (long)rows * 1024);
        gemm(stream, 0, mg, 1024, w_out, 1024, t1, 1024, rows, 1024, 1024);
        ln_rows<<<(rows + 3) / 4, 256, 0, stream>>>(x, t1, ln1_g, ln1_b, hbuf, rows);
        gemm(stream, 0, hbuf, 1024, w_ff1, DFF, ff, DFF, rows, DFF, 1024, b_ff1, 1);
        gemm(stream, 0, ff, DFF, w_ff2, 1024, t1, 1024, rows, 1024, DFF, b_ff2, 0);
        ln_rows<<<(rows + 3) / 4, 256, 0, stream>>>(hbuf, t1, ln2_g, ln2_b, y, rows);
        if (!sample) {
            copyrows(stream, Z, out + O_AKP + (size_t)b0 * 512 * 1024, 1024, 512, GB, (long)SEQ * ZW, ZW, (long)1536 * ZW + ZK_A, (long)512 * 1024, 1024, 0);
            copyrows(stream, Z, out + O_AVP + (size_t)b0 * 512 * 1024, 1024, 512, GB, (long)SEQ * ZW, ZW, (long)1536 * ZW + ZV_A, (long)512 * 1024, 1024, 0);
            copyrows(stream, Z, out + O_CONVP + (size_t)b0 * 3 * 3072, 3072, 3, GB, (long)SEQ * ZW, ZW, (long)(SEQ - 3) * ZW + ZB, (long)3 * 3072, 3072, 0);
        } else {
            copyrows(stream, cache_a_k, out + O_AKS, 1024, 496, DEC_B, (long)512 * 1024, 1024, (long)16 * 1024, (long)512 * 1024, 1024, 0);
            copyrows(stream, cache_a_v, out + O_AVS, 1024, 496, DEC_B, (long)512 * 1024, 1024, (long)16 * 1024, (long)512 * 1024, 1024, 0);
            copyrows(stream, Z, out + O_AKS, 1024, 16, DEC_B, (long)DEC_T * ZW, ZW, ZK_A, (long)512 * 1024, 1024, (long)496 * 1024);
            copyrows(stream, Z, out + O_AVS, 1024, 16, DEC_B, (long)DEC_T * ZW, ZW, ZV_A, (long)512 * 1024, 1024, (long)496 * 1024);
            copyrows(stream, Z, out + O_CONVS, 3072, 3, DEC_B, (long)DEC_T * ZW, ZW, (long)(DEC_T - 3) * ZW + ZB, (long)3 * 3072, 3072, 0);
        }
    }
}
```

```cpp
#include <hip/hip_runtime.h>
#include <cstdio>
#include <cstdint>

constexpr int DM = 1024, BATCH = 16, SEQ = 2048, DEC_B = 32, DEC_T = 16, PAST = 1024;
constexpr int CHUNK = 64, AH = 16, AHD = 64, AWIN = 512, ABAND = 576, ACLIP = 128;
constexpr int BH = 8, BHD = 128, MEMT = 256, CH = 4, CHD = 256, DFF = 4096;
constexpr int ZW = 10256;
constexpr int ZQ_A = 0, ZK_A = 1024, ZV_A = 2048, ZB = 3072, ZQ_C = 6144, ZG = 7168, ZA_B = 10240, ZB_B = 10248;
constexpr float DN_ALPHA = 1.189207115002721f;
constexpr float LN_EPS = 1e-5f, RMS_EPS = 1e-6f, L2_EPS = 1e-6f;

constexpr size_t O_YP = 0, O_YS = 33554432, O_AKP = 34078720, O_AVP = 42467328, O_CONVP = 50855936, O_SSMP = 51003392,
                 O_MKP = 53100544, O_MVP = 57294848, O_AKS = 61489152, O_AVS = 78266368, O_CONVS = 95043584, O_SSMS = 95338496;

namespace pg8 {
#define PG8_LAS __attribute__((address_space(3)))
typedef unsigned short bf16_t;
typedef short bf16x8 __attribute__((ext_vector_type(8)));
typedef float f32x4 __attribute__((ext_vector_type(4)));
typedef unsigned u32x4 __attribute__((ext_vector_type(4)));
constexpr int BM = 256, BK = 64, HALF = 128, HTB = HALF * BK * 2  , STAGE_BYTES = 8 * HTB, NXCD = 8, WGM = 8;

__host__ __device__ __forceinline__ int lds_byte(int r, int c) { const int st = (r >> 4) * 2 + (c >> 5), rr = r & 15, cc = c & 31, ob = rr * 64 + cc * 2; return st * 1024 + (ob ^ (((ob >> 9) & 1) << 5)); }
__host__ __device__ __forceinline__ void stage_rc(int b, int& R, int& C) { const int st = b / 1024, sb = b % 1024, swz = sb ^ (((sb >> 9) & 1) << 5); R = (st >> 1) * 16 + swz / 64; C = (st & 1) * 32 + (swz % 64) / 2; }
__host__ __device__ __forceinline__ int perm32(int rho) { const int n = rho >> 4, i = rho & 15; return 8 * (i >> 2) + 4 * n + (i & 3); }

struct Unit { int pm, pn, job; };
struct Gemm { const bf16_t* A; const bf16_t* Bt; int M, N, K; const bf16_t* A1; const bf16_t* Bt1; };

struct StaticOrder {
    int nM, nN, nwg, G, c;
    __host__ __device__ void init(int M, int N, int G_, int c_) { nM = M / BM; nN = N / BM; nwg = nM * nN; G = G_; c = c_; }
    __host__ __device__ bool next(int i, Unit& u) const {
        const long L = (long)i * G + c; if (L >= nwg) return false;
        int wgid = (int)L; { const int q = nwg / NXCD, r = nwg % NXCD, xcd = wgid % NXCD, off = wgid / NXCD; wgid = (xcd < r ? xcd * (q + 1) : r * (q + 1) + (xcd - r) * q) + off; }
        const int nig = WGM * nN, gid = wgid / nig, fm = gid * WGM, gsz = (nM - fm) < WGM ? (nM - fm) : WGM;
        u.pm = fm + ((wgid % nig) % gsz); u.pn = (wgid % nig) / gsz; u.job = 0; return true;
    }
    __device__ __forceinline__ void a_ready(const Unit&) const {}
    __device__ __forceinline__ void done(const Unit&) const {}
};

__device__ __forceinline__ unsigned cvt_pk_bf16(float lo, float hi) { unsigned r; asm volatile("v_cvt_pk_bf16_f32 %0, %1, %2" : "=v"(r) : "v"(lo), "v"(hi)); return r; }
template <class Epi, class Sched, bool ALIGN_EPI = false, bool SP2 = false, int KC = 0>
__device__ __forceinline__ void gemm_phase(PG8_LAS unsigned char* lds, const Gemm g, const Sched& S, const Epi& E) {
    const int tid = threadIdx.x, wid = __builtin_amdgcn_readfirstlane(tid >> 6), lane = tid & 63, wr = wid >> 2, wc = wid & 3, fr = lane & 15, fq = lane >> 4;
    const int K = KC ? KC : g.K, nt = K / BK;
    unsigned voffA[2], voffB[2];
#pragma unroll
    for (int i = 0; i < 2; ++i) { int R, C; stage_rc(tid * 16 + i * 8192, R, C); const int Rb = Epi::PERM ? ((R & ~31) + perm32(R & 31)) : R;
        voffA[i] = (unsigned)(R * K + C) * 2u; voffB[i] = (unsigned)(Rb * K + C) * 2u; }
    const size_t kstep = (size_t)(BK * 2);
    const size_t hstep = (size_t)HALF * K * 2;
    const size_t tstep = 2 * hstep;
    const unsigned ldsw = (unsigned)wid * 1024u;
    const int aoff = lds_byte(wr * 64 + fr, fq * 8), boff = lds_byte(wc * 32 + fr, fq * 8);
#define PG8_SA(b, h) (((b) * 2 + (h)) * HTB)
#define PG8_SB(b, h) ((4 + (b) * 2 + (h)) * HTB)
#define PG8_STAGE(bufoff, gbase, voff) do { _Pragma("unroll") for (int _i = 0; _i < 2; ++_i) \
        __builtin_amdgcn_global_load_lds((const unsigned*)((const char*)(gbase) + (voff)[_i]), (PG8_LAS unsigned*)(lds + (bufoff) + ldsw + _i * 8192), 16, 0, 0); } while (0)
#define PG8_LDA(dst, b, h) do { _Pragma("unroll") for (int m = 0; m < 4; ++m) _Pragma("unroll") for (int k = 0; k < 2; ++k) dst[m][k] = *(const PG8_LAS bf16x8*)(lds + PG8_SA(b, h) + aoff + m * 2048 + k * 1024); } while (0)
#define PG8_LDB(dst, b, h) do { _Pragma("unroll") for (int n = 0; n < 2; ++n) _Pragma("unroll") for (int k = 0; k < 2; ++k) dst[n][k] = *(const PG8_LAS bf16x8*)(lds + PG8_SB(b, h) + boff + n * 2048 + k * 1024); } while (0)
#define PG8_MMA(ai, bj, At, Bt) do { __builtin_amdgcn_s_setprio(1); _Pragma("unroll") for (int m = 0; m < 4; ++m) _Pragma("unroll") for (int n = 0; n < 2; ++n) _Pragma("unroll") for (int k = 0; k < 2; ++k) \
        acc[ai][bj][m][n] = __builtin_amdgcn_mfma_f32_16x16x32_bf16(Bt[n][k], At[m][k], acc[ai][bj][m][n], 0, 0, 0); __builtin_amdgcn_s_setprio(0); } while (0)
#define PG8_WAIT_V(n) asm volatile("s_waitcnt vmcnt(" #n ")" ::: "memory")
#define PG8_WAIT_L(n) asm volatile("s_waitcnt lgkmcnt(" #n ")" ::: "memory")
#define PG8_BAR __builtin_amdgcn_s_barrier()
#define PG8_SCHED __builtin_amdgcn_sched_barrier(0)
    Unit cur, nxt; int ui = 0;
    if (!S.next(0, cur)) return;
    f32x4 acc[2][2][4][2];
#pragma unroll
    for (int a = 0; a < 2; ++a)
#pragma unroll
        for (int b = 0; b < 2; ++b)
#pragma unroll
            for (int m = 0; m < 4; ++m)
#pragma unroll
                for (int n = 0; n < 2; ++n) acc[a][b][m][n] = (f32x4){0.f, 0.f, 0.f, 0.f};
    bf16x8 At[4][2], B0[2][2], B1[2][2];
    const char* cA = (const char*)(cur.job ? g.A1 : g.A) + (size_t)cur.pm * tstep; const char* cB = (const char*)(cur.job ? g.Bt1 : g.Bt) + (size_t)cur.pn * tstep;
    S.a_ready(cur);
    if constexpr (SP2) {
        PG8_STAGE(PG8_SB(0, 0), cB, voffB); PG8_STAGE(PG8_SB(0, 1), cB + hstep, voffB); PG8_STAGE(PG8_SA(0, 0), cA, voffA); PG8_STAGE(PG8_SA(0, 1), cA + hstep, voffA);
        if (wr == 1) PG8_BAR;
        PG8_WAIT_V(2); PG8_BAR;
        PG8_STAGE(PG8_SB(1, 0), cB + kstep, voffB); PG8_STAGE(PG8_SA(1, 0), cA + kstep, voffA); PG8_STAGE(PG8_SB(1, 1), cB + hstep + kstep, voffB);
        PG8_WAIT_V(6); PG8_BAR;
    } else {
        PG8_STAGE(PG8_SB(0, 0), cB, voffB); PG8_STAGE(PG8_SA(0, 0), cA, voffA); PG8_STAGE(PG8_SB(0, 1), cB + hstep, voffB); PG8_STAGE(PG8_SA(0, 1), cA + hstep, voffA);
        if (wr == 1) PG8_BAR;
        PG8_WAIT_V(4); PG8_BAR;
        PG8_STAGE(PG8_SB(1, 0), cB + kstep, voffB); PG8_STAGE(PG8_SA(1, 0), cA + kstep, voffA); PG8_STAGE(PG8_SB(1, 1), cB + hstep + kstep, voffB);
        PG8_WAIT_V(6); PG8_BAR;
    }
    for (;;) {
        const bool has_next = S.next(ui + 1, nxt);
        const char* nA = has_next ? (const char*)(nxt.job ? g.A1 : g.A) + (size_t)nxt.pm * tstep : cA; const char* nB = has_next ? (const char*)(nxt.job ? g.Bt1 : g.Bt) + (size_t)nxt.pn * tstep : cB;
        for (int t = 0; t < nt; t += 2) {
            const bool last = (t == nt - 2);
            const char* a1 = cA + (size_t)(t + 1) * kstep;
            const char* a2 = last ? nA : cA + (size_t)(t + 2) * kstep; const char* b2 = last ? nB : cB + (size_t)(t + 2) * kstep;
            const char* a3 = a2 + kstep; const char* b3 = b2 + kstep;
            if (last && has_next) S.a_ready(nxt);
            if constexpr (SP2) {
            PG8_LDB(B0, 0, 0); PG8_LDB(B1, 0, 1); PG8_SCHED; PG8_LDA(At, 0, 0); PG8_STAGE(PG8_SA(1, 1), a1 + hstep, voffA);
            PG8_WAIT_V(8); PG8_WAIT_L(0); PG8_BAR; PG8_MMA(0, 0, At, B0); PG8_MMA(0, 1, At, B1); PG8_BAR; PG8_SCHED;
            PG8_LDA(At, 0, 1); PG8_STAGE(PG8_SB(0, 0), b2, voffB); PG8_STAGE(PG8_SB(0, 1), b2 + hstep, voffB); PG8_STAGE(PG8_SA(0, 0), a2, voffA);
            PG8_WAIT_V(8); PG8_WAIT_L(0); PG8_BAR; PG8_MMA(1, 0, At, B0); PG8_MMA(1, 1, At, B1); PG8_BAR; PG8_SCHED;
            PG8_LDB(B0, 1, 0); PG8_LDB(B1, 1, 1); PG8_SCHED; PG8_LDA(At, 1, 0); PG8_STAGE(PG8_SA(0, 1), a2 + hstep, voffA);
            PG8_WAIT_V(8); PG8_WAIT_L(0); PG8_BAR; PG8_MMA(0, 0, At, B0); PG8_MMA(0, 1, At, B1); PG8_BAR; PG8_SCHED;
            PG8_LDA(At, 1, 1); PG8_STAGE(PG8_SB(1, 0), b3, voffB); PG8_STAGE(PG8_SB(1, 1), b3 + hstep, voffB); PG8_STAGE(PG8_SA(1, 0), a3, voffA);
            PG8_WAIT_V(8); PG8_WAIT_L(0); PG8_BAR; PG8_MMA(1, 0, At, B0); PG8_MMA(1, 1, At, B1); PG8_BAR; PG8_SCHED;
            } else {
            PG8_LDB(B0, 0, 0); PG8_SCHED; PG8_LDA(At, 0, 0); PG8_STAGE(PG8_SA(1, 1), a1 + hstep, voffA);
            PG8_WAIT_L(8); PG8_BAR; PG8_WAIT_L(0); PG8_MMA(0, 0, At, B0); PG8_BAR; PG8_SCHED;
            PG8_LDB(B1, 0, 1); PG8_STAGE(PG8_SB(0, 0), b2, voffB);
            PG8_BAR; PG8_WAIT_L(0); PG8_MMA(0, 1, At, B1); PG8_BAR;
            PG8_LDA(At, 0, 1); PG8_STAGE(PG8_SA(0, 0), a2, voffA);
            PG8_BAR; PG8_WAIT_L(0); PG8_MMA(1, 0, At, B0); PG8_BAR; PG8_SCHED;
            PG8_STAGE(PG8_SB(0, 1), b2 + hstep, voffB);
            PG8_WAIT_V(6); PG8_BAR; PG8_MMA(1, 1, At, B1); PG8_BAR;
            PG8_LDB(B0, 1, 0); PG8_SCHED; PG8_LDA(At, 1, 0); PG8_STAGE(PG8_SA(0, 1), a2 + hstep, voffA);
            PG8_WAIT_L(8); PG8_BAR; PG8_WAIT_L(0); PG8_MMA(0, 0, At, B0); PG8_BAR; PG8_SCHED;
            PG8_LDB(B1, 1, 1); PG8_STAGE(PG8_SB(1, 0), b3, voffB);
            PG8_BAR; PG8_WAIT_L(0); PG8_MMA(0, 1, At, B1); PG8_BAR;
            PG8_LDA(At, 1, 1); PG8_STAGE(PG8_SA(1, 0), a3, voffA);
            PG8_BAR; PG8_WAIT_L(0); PG8_MMA(1, 0, At, B0); PG8_BAR; PG8_SCHED;
            PG8_STAGE(PG8_SB(1, 1), b3 + hstep, voffB);
            PG8_WAIT_V(6); PG8_BAR; PG8_MMA(1, 1, At, B1); PG8_BAR;
            }
        }
        if constexpr (ALIGN_EPI) { if (wr == 0) PG8_BAR; }
        if constexpr (!Epi::AFTER_DRAIN) { E(acc, cur, wr, wc, fr, fq); S.done(cur); }
        if (!has_next) break;
#pragma unroll
        for (int a = 0; a < 2; ++a)
#pragma unroll
            for (int b = 0; b < 2; ++b)
#pragma unroll
                for (int m = 0; m < 4; ++m)
#pragma unroll
                    for (int n = 0; n < 2; ++n) acc[a][b][m][n] = (f32x4){0.f, 0.f, 0.f, 0.f};
        cur = nxt; cA = nA; cB = nB; ++ui;
        if constexpr (ALIGN_EPI) { if (wr == 1) PG8_BAR; }
    }
    PG8_WAIT_V(0);
    if constexpr (!ALIGN_EPI) { if (wr == 0) PG8_BAR; }
    PG8_BAR;
    if constexpr (Epi::AFTER_DRAIN) { E.fused(acc, cur, wr, wc, fr, fq, lds, wid, lane); S.done(cur); }
#undef PG8_SA
#undef PG8_SB
#undef PG8_STAGE
#undef PG8_LDA
#undef PG8_LDB
#undef PG8_MMA
#undef PG8_WAIT_V
#undef PG8_WAIT_L
#undef PG8_BAR
#undef PG8_SCHED
}
}
#define GAS __attribute__((address_space(1)))
#define LAS __attribute__((address_space(3)))
typedef unsigned short bf16;
typedef unsigned v4u __attribute__((ext_vector_type(4)));
typedef float f32x4 __attribute__((ext_vector_type(4)));
typedef short bf16x8 __attribute__((ext_vector_type(8)));
typedef GAS unsigned gu32;
typedef GAS unsigned long long gu64;
#define RLX_AGENT __ATOMIC_RELAXED, __HIP_MEMORY_SCOPE_AGENT
#define LDS_WAIT() asm volatile("s_waitcnt lgkmcnt(0)" ::: "memory")
#define VM_WAIT() asm volatile("s_waitcnt vmcnt(0)" ::: "memory")
__device__ __forceinline__ unsigned long long rt() { return __builtin_amdgcn_s_memrealtime(); }
__device__ __forceinline__ unsigned f2bf(float f) { unsigned u = __builtin_bit_cast(unsigned, f); return (u + 0x7fffu + ((u >> 16) & 1u)) >> 16; }
__device__ __forceinline__ unsigned pk2(float lo, float hi) { return f2bf(lo) | (f2bf(hi) << 16); }

#define XB_TMO      128
#define XB_XCNT(j)  (256  + 64 * (j))
#define XB_XSUB(j)  (1280 + 64 * (j))
#define XB_XGEN(j)  (2304 + 64 * (j))
#define XB_TOP      3328
#define XB_TOPGEN   3392
#define XCD_BAR_WORDS 3456
#define XB_SPIN_CAP (1u << 18)

__device__ __forceinline__ unsigned xb_ld(unsigned* p)              { return __hip_atomic_load(p, __ATOMIC_RELAXED, __HIP_MEMORY_SCOPE_AGENT); }
__device__ __forceinline__ unsigned xb_add(unsigned* p, unsigned v) { return __hip_atomic_fetch_add(p, v, __ATOMIC_RELAXED, __HIP_MEMORY_SCOPE_AGENT); }
__device__ __forceinline__ unsigned xb_xcc_id() { return (unsigned)__builtin_amdgcn_s_getreg((3 << 11) | 20) & 0xFu; }
#define XB_SPIN(cond, bar) do { unsigned _sp = 0; while (cond) { __builtin_amdgcn_s_sleep(1); \
    if ((++_sp & 255u) == 0u) { if (xb_ld(&(bar)[XB_TMO])) break; if (_sp > XB_SPIN_CAP) { atomicAdd(&(bar)[XB_TMO], 1u); break; } } } } while (0)

struct XcdBarrier {
    unsigned* bar; unsigned x;
    volatile LAS unsigned* st;
};

__device__ __forceinline__ XcdBarrier xcd_barrier_post(unsigned* bar, volatile LAS unsigned* st) {
    XcdBarrier b; b.bar = bar; b.x = xb_xcc_id(); b.st = st;
    if (threadIdx.x == 0) (void)xb_add(&bar[XB_XCNT(b.x)], 1u);
    return b;
}
__device__ __forceinline__ void xcd_barrier_complete(unsigned* bar, unsigned x, unsigned& nloc, unsigned& nx) {
    const unsigned G = gridDim.x * gridDim.y * gridDim.z;
    unsigned sum, cnt, mine, sp = 0u;
    for (;;) {
        sum = 0u; cnt = 0u; mine = 0u;
#pragma unroll
        for (unsigned j = 0; j < 16; ++j) { const unsigned c = xb_ld(&bar[XB_XCNT(j)]); sum += c; cnt += (c > 0u) ? 1u : 0u; mine = (j == x) ? c : mine; }
        if (sum == G) break;
        __builtin_amdgcn_s_sleep(1);
        if ((++sp & 255u) == 0u) { if (xb_ld(&bar[XB_TMO])) break; if (sp > XB_SPIN_CAP) { atomicAdd(&bar[XB_TMO], 1u); break; } }
    }
    nloc = mine > 0u ? mine : 1u; nx = cnt > 0u ? cnt : 1u;
}

__device__ __forceinline__ void xcd_barrier(const XcdBarrier& b) {
    asm volatile("s_waitcnt vmcnt(0)" ::: "memory");
    __syncthreads();
    if (threadIdx.x == 0) {
        unsigned* bar = b.bar;
        __builtin_amdgcn_s_waitcnt(0);
        unsigned nloc = b.st[0], nx = b.st[1];
        if (nloc == 0u) { xcd_barrier_complete(bar, b.x, nloc, nx); b.st[0] = nloc; b.st[1] = nx; }
        const unsigned old = xb_add(&bar[XB_XSUB(b.x)], 1u);
        const unsigned gen = old / nloc;
        if (old + 1u == (gen + 1u) * nloc) {
            __builtin_amdgcn_fence(__ATOMIC_RELEASE, "agent");
            asm volatile("s_waitcnt vmcnt(0)" ::: "memory");
            const unsigned og = xb_add(&bar[XB_TOP], 1u);
            const unsigned tg = og / nx;
            if (og + 1u == (tg + 1u) * nx) xb_add(&bar[XB_TOPGEN], 1u);
            else XB_SPIN(xb_ld(&bar[XB_TOPGEN]) == tg, bar);
            __builtin_amdgcn_fence(__ATOMIC_ACQUIRE, "agent");
            xb_add(&bar[XB_XGEN(b.x)], 1u);
            asm volatile("s_waitcnt vmcnt(0)" ::: "memory");
        } else {
            XB_SPIN(xb_ld(&bar[XB_XGEN(b.x)]) == gen, bar);
            __builtin_amdgcn_fence(__ATOMIC_ACQUIRE, "agent");
            asm volatile("s_waitcnt vmcnt(0)" ::: "memory");
        }
    }
    __syncthreads();
}
constexpr float C2A = 0.125f * 1.4426950408889634f, C2C = 0.0625f * 1.4426950408889634f, LOG2E = 1.4426950408889634f;
namespace att {
typedef short bf16x8 __attribute__((ext_vector_type(8)));
typedef short s16x4 __attribute__((ext_vector_type(4)));
typedef float f32x16 __attribute__((ext_vector_type(16)));
typedef unsigned u32x4 __attribute__((ext_vector_type(4)));
typedef LAS const char* lds_cptr;
#define ATT_SBAR() __builtin_amdgcn_sched_barrier(0)
#define ATT_WAIT_BAR(N) asm volatile("s_waitcnt vmcnt(" #N ") lgkmcnt(0)\n\ts_barrier" ::: "memory")
__device__ __forceinline__ int crow(int r, int hi) { return (r & 3) + 8 * (r >> 2) + 4 * hi; }
__device__ __forceinline__ void glds16(const void* gsrc, unsigned lds_dst) { unsigned keep;
    asm volatile("s_mov_b32 %0, m0\n\ts_mov_b32 m0, %2\n\ts_nop 0\n\tglobal_load_lds_dwordx4 %1, off\n\ts_mov_b32 m0, %0" : "=&s"(keep) : "v"(gsrc), "s"(lds_dst) : "memory"); }
__device__ __forceinline__ float max3f(float a, float b, float c) { float r; asm("v_max3_f32 %0, %1, %2, %3" : "=v"(r) : "v"(a), "v"(b), "v"(c)); return r; }
typedef float f32x2_t __attribute__((ext_vector_type(2))); typedef __bf16 bf16x2_t __attribute__((ext_vector_type(2)));
__device__ __forceinline__ unsigned cvtpk_s(float lo, float hi) { f32x2_t v = {lo, hi}; bf16x2_t b = __builtin_convertvector(v, bf16x2_t); return __builtin_bit_cast(unsigned, b); }
template <int NKS, int CHUNK_STRIDE>
__device__ __forceinline__ void qkt(f32x16& p0, f32x16& p1, lds_cptr Kslot, const bf16x8* qr, const f32x16& c0, int r32, int hi) {
    lds_cptr kb = Kslot + hi * CHUNK_STRIDE + r32 * 16;
    p0 = c0; p1 = c0;
#pragma unroll
    for (int d0 = 0; d0 < NKS; ++d0) {
        const bf16x8 b0 = *(const LAS bf16x8*)(kb + d0 * 2 * CHUNK_STRIDE);
        const bf16x8 b1 = *(const LAS bf16x8*)(kb + d0 * 2 * CHUNK_STRIDE + 512);
        p0 = __builtin_amdgcn_mfma_f32_32x32x16_bf16(b0, qr[d0], p0, 0, 0, 0);
        p1 = __builtin_amdgcn_mfma_f32_32x32x16_bf16(b1, qr[d0], p1, 0, 0, 0);
    }
}
__device__ __forceinline__ float rowmax(const f32x16& p0, const f32x16& p1) {
    float a = max3f(p0[0], p0[1], p1[0]), b = max3f(p0[2], p0[3], p1[1]); a = max3f(a, p1[2], p1[3]);
#pragma unroll
    for (int r = 4; r < 16; r += 4) { a = max3f(a, p0[r], p0[r + 1]); b = max3f(b, p0[r + 2], p0[r + 3]); a = max3f(a, p1[r], p1[r + 1]); b = max3f(b, p1[r + 2], p1[r + 3]); }
    const float m = fmaxf(a, b);
    auto rr = __builtin_amdgcn_permlane32_swap(__float_as_uint(m), __float_as_uint(m), false, false);
    return fmaxf(__uint_as_float(rr[0]), __uint_as_float(rr[1]));
}
template <int ND>
__device__ __forceinline__ void pv(f32x16* o, int vb, bf16x8 pa0, bf16x8 pa1, bf16x8 pa2, bf16x8 pa3) {
#pragma unroll
    for (int d0 = 0; d0 < ND; ++d0) { s16x4 lo[4], hi[4];
#pragma unroll
        for (int ks = 0; ks < 4; ++ks) {
            asm volatile("ds_read_b64_tr_b16 %0,%1 offset:%c2" : "=&v"(lo[ks]) : "v"(vb), "i"(d0 * 4096 + ks * 1024) : "memory");
            asm volatile("ds_read_b64_tr_b16 %0,%1 offset:%c2" : "=&v"(hi[ks]) : "v"(vb), "i"(d0 * 4096 + ks * 1024 + 512) : "memory"); }
        asm volatile("s_waitcnt lgkmcnt(0)" ::: "memory"); ATT_SBAR();
#define ATT_PK(k) (bf16x8){lo[k][0], lo[k][1], lo[k][2], lo[k][3], hi[k][0], hi[k][1], hi[k][2], hi[k][3]}
        o[d0] = __builtin_amdgcn_mfma_f32_32x32x16_bf16(pa0, ATT_PK(0), o[d0], 0, 0, 0);
        o[d0] = __builtin_amdgcn_mfma_f32_32x32x16_bf16(pa1, ATT_PK(1), o[d0], 0, 0, 0);
        o[d0] = __builtin_amdgcn_mfma_f32_32x32x16_bf16(pa2, ATT_PK(2), o[d0], 0, 0, 0);
        o[d0] = __builtin_amdgcn_mfma_f32_32x32x16_bf16(pa3, ATT_PK(3), o[d0], 0, 0, 0);
#undef ATT_PK
    }
}
constexpr int A_K = 0, A_V = 16384, A_WS = 32768, A_BT = 34816, A_OST = 36864, A_BYTES = A_OST + 8 * 4096;
__device__ __forceinline__ void attnA_unit(int b, int h, int qb, bf16* QO, const bf16* KA, const bf16* VA, const float* relb, LAS unsigned char* L) {
    int tid = threadIdx.x; asm volatile("" : "+v"(tid));
    const int lane = tid & 63, r32 = lane & 31, hi = lane >> 5; const int wid = __builtin_amdgcn_readfirstlane(tid >> 6);
    const long rowbase = (long)b * 2048; const int q0 = qb * 256;
    bf16* Qw = QO + (rowbase + q0 + wid * 32) * 1024 + h * 64;
    const bf16 *Kh = KA + rowbase * 1024 + h * 64, *Vh = VA + rowbase * 1024 + h * 64;
    const unsigned lds0 = (unsigned)(uintptr_t)L;
    LAS float* wsf = (LAS float*)(L + A_WS) + wid * 64;
    LAS float* btab = (LAS float*)(L + A_BT);
    const bf16* ksrc = Kh + (long)lane * 1024 + wid * 8;
    const bf16* vsrc = Vh + (long)(16 * (wid & 3) + (lane >> 2)) * 1024 + (wid >> 2) * 32 + (lane & 3) * 8;
    const unsigned kdst = lds0 + A_K + wid * 1024, vdst = lds0 + A_V + wid * 1024;
#define DMA_K(t, slot) glds16(ksrc + (long)(t) * 64 * 1024, (unsigned)__builtin_amdgcn_readfirstlane(kdst + (slot)))
#define DMA_V(t, slot) glds16(vsrc + (long)(t) * 64 * 1024, (unsigned)__builtin_amdgcn_readfirstlane(vdst + (slot)))
    const int vb0 = (int)(lds0 + A_V) + ((lane >> 4) & 1) * 32 + (lane & 3) * 8 + (4 * hi + ((lane & 15) >> 2)) * 64;
    lds_cptr Kbase = (lds_cptr)(L + A_K);
    const int cq = 4 * qb + (wid >> 1), qi = 32 * (wid & 1) + r32;
    const int kc0 = (4 * qb - 8) > 0 ? (4 * qb - 8) : 0, kc1 = 4 * qb + 3;
    for (int i = tid; i < 257; i += 512) btab[i] = relb[h * 257 + i] * LOG2E;
    DMA_K(kc0, 0); DMA_V(kc0, 0);
    bf16x8 qr[4];
#pragma unroll
    for (int d0 = 0; d0 < 4; ++d0) qr[d0] = *reinterpret_cast<const bf16x8*>(&Qw[(long)r32 * 1024 + d0 * 16 + hi * 8]);
    float m_run = -1e30f, l_run = 0.f; f32x16 o[2]; o[0] = f32x16{}; o[1] = f32x16{};
    const f32x16 zero = f32x16{};
    ATT_WAIT_BAR(0);
    for (int kc = kc0; kc <= kc1; ++kc) {
        const int sl = ((kc - kc0) & 1) * 8192;
        if (kc < kc1) { DMA_K(kc + 1, sl ^ 8192); DMA_V(kc + 1, sl ^ 8192); }
        const int dC = cq - kc;
        if (dC >= 0 && dC <= 8) {
            f32x16 p0, p1;
            qkt<4, 1024>(p0, p1, Kbase + sl, qr, zero, r32, hi);
            if (dC >= 3) { const float bfar = btab[256];
#pragma unroll
                for (int r = 0; r < 16; ++r) { p0[r] += bfar; p1[r] += bfar; }
            } else { const int base = 64 * dC + qi + 128;
#pragma unroll
                for (int r = 0; r < 16; ++r) { const int kj = crow(r, hi); int i0 = base - kj, i1 = base - kj - 32; i0 = i0 > 256 ? 256 : i0; i1 = i1 > 256 ? 256 : i1; p0[r] += btab[i0]; p1[r] += btab[i1]; }
            }
            const float rm = rowmax(p0, p1);
            const float mn = fmaxf(m_run, rm);
            const float alpha = __builtin_amdgcn_exp2f(m_run - mn);
            float s = 0.f;
#pragma unroll
            for (int r = 0; r < 16; ++r) { p0[r] = __builtin_amdgcn_exp2f(p0[r] - mn); p1[r] = __builtin_amdgcn_exp2f(p1[r] - mn); s += p0[r] + p1[r]; }
            l_run = l_run * alpha + s; m_run = mn;
            if (__any(alpha != 1.f)) {
                if (hi == 0) wsf[r32] = alpha;
                asm volatile("s_waitcnt lgkmcnt(0)" ::: "memory");
#pragma unroll
                for (int r = 0; r < 16; ++r) { const float f = wsf[crow(r, hi)]; o[0][r] *= f; o[1][r] *= f; }
            }
            u32x4 pw0, pw1, pw2, pw3;
            pw0 = (u32x4){cvtpk_s(p0[0], p0[1]), cvtpk_s(p0[2], p0[3]), cvtpk_s(p0[4], p0[5]), cvtpk_s(p0[6], p0[7])};
            pw1 = (u32x4){cvtpk_s(p0[8], p0[9]), cvtpk_s(p0[10], p0[11]), cvtpk_s(p0[12], p0[13]), cvtpk_s(p0[14], p0[15])};
            pw2 = (u32x4){cvtpk_s(p1[0], p1[1]), cvtpk_s(p1[2], p1[3]), cvtpk_s(p1[4], p1[5]), cvtpk_s(p1[6], p1[7])};
            pw3 = (u32x4){cvtpk_s(p1[8], p1[9]), cvtpk_s(p1[10], p1[11]), cvtpk_s(p1[12], p1[13]), cvtpk_s(p1[14], p1[15])};
            ATT_SBAR();
            pv<2>(o, vb0 + sl, __builtin_bit_cast(bf16x8, pw0), __builtin_bit_cast(bf16x8, pw1), __builtin_bit_cast(bf16x8, pw2), __builtin_bit_cast(bf16x8, pw3));
        }
        ATT_WAIT_BAR(0);
    }
    { auto rr = __builtin_amdgcn_permlane32_swap(__float_as_uint(l_run), __float_as_uint(l_run), false, false); l_run = __uint_as_float(rr[0]) + __uint_as_float(rr[1]); }
    if (hi == 0) wsf[32 + r32] = l_run;
    asm volatile("s_waitcnt lgkmcnt(0)" ::: "memory");
    float rli[16];
#pragma unroll
    for (int r = 0; r < 16; ++r) rli[r] = __builtin_amdgcn_rcpf(wsf[32 + crow(r, hi)]);
    { LAS unsigned short* stg = (LAS unsigned short*)(L + A_OST) + wid * 2048;
#pragma unroll
        for (int r = 0; r < 16; ++r) { const int orow = crow(r, hi);
#pragma unroll
            for (int d0 = 0; d0 < 2; ++d0) stg[orow * 64 + d0 * 32 + r32] = (unsigned short)f2bf(o[d0][r] * rli[r]); }
        asm volatile("s_waitcnt lgkmcnt(0)" ::: "memory");
#pragma unroll
        for (int i = 0; i < 4; ++i) { const int row = i * 8 + (lane >> 3), ch = lane & 7; const u32x4 v = *(const LAS u32x4*)(stg + row * 64 + ch * 8); *(u32x4*)(Qw + (long)row * 1024 + ch * 8) = v; } }
    asm volatile("s_waitcnt lgkmcnt(0)\n\ts_barrier" ::: "memory");
#undef DMA_K
#undef DMA_V
}

constexpr int C_WS = 131072 + 1024;
__device__ __forceinline__ void attnC_unit(int b, int h, int qb, bf16* QO, const bf16* MK, const bf16* MV, LAS unsigned char* L) {
    int tid = threadIdx.x; asm volatile("" : "+v"(tid));
    const int lane = tid & 63, r32 = lane & 31, hi = lane >> 5; const int wid = __builtin_amdgcn_readfirstlane(tid >> 6);
    bf16* Qw = QO + ((long)b * 2048 + qb * 256 + wid * 32) * 1024 + h * 256;
    const bf16 *Kh = MK + (long)b * 256 * 1024 + h * 256, *Vh = MV + (long)b * 256 * 1024 + h * 256;
    const unsigned lds0 = (unsigned)(uintptr_t)L;
    LAS float* wsf = (LAS float*)(L + C_WS) + wid * 64;
#pragma unroll
    for (int j = 0; j < 16; ++j) { const int p = wid * 16 + j;
        glds16(Kh + (long)(64 * (p & 3) + lane) * 1024 + (p >> 2) * 8, (unsigned)__builtin_amdgcn_readfirstlane(lds0 + p * 1024)); }
    const bf16* qp = &Qw[(long)r32 * 1024 + hi * 8];
    bf16x8 qa[4], qb4[4];
#pragma unroll
    for (int i = 0; i < 4; ++i) qa[i] = *reinterpret_cast<const bf16x8*>(qp + i * 16);
    f32x16 S[8];
#pragma unroll
    for (int kt = 0; kt < 8; ++kt) S[kt] = f32x16{};
    ATT_WAIT_BAR(0);
    { lds_cptr kb = (lds_cptr)L + hi * 4096 + r32 * 16;
#define C_GROUP(QF, g) do { _Pragma("unroll") for (int i = 0; i < 4; ++i) { _Pragma("unroll") for (int kt = 0; kt < 8; ++kt) { \
            const bf16x8 kf = *(const LAS bf16x8*)(kb + ((g) * 4 + i) * 8192 + kt * 512); S[kt] = __builtin_amdgcn_mfma_f32_32x32x16_bf16(kf, QF[i], S[kt], 0, 0, 0); } } } while (0)
#pragma unroll
        for (int i = 0; i < 4; ++i) qb4[i] = *reinterpret_cast<const bf16x8*>(qp + (4 + i) * 16);
        C_GROUP(qa, 0);
#pragma unroll
        for (int i = 0; i < 4; ++i) qa[i] = *reinterpret_cast<const bf16x8*>(qp + (8 + i) * 16);
        C_GROUP(qb4, 1);
#pragma unroll
        for (int i = 0; i < 4; ++i) qb4[i] = *reinterpret_cast<const bf16x8*>(qp + (12 + i) * 16);
        C_GROUP(qa, 2);
        C_GROUP(qb4, 3);
#undef C_GROUP
    }
    float mx = -1e30f;
#pragma unroll
    for (int kt = 0; kt < 8; ++kt)
#pragma unroll
        for (int r = 0; r < 16; ++r) mx = fmaxf(mx, S[kt][r]);
    { auto rr = __builtin_amdgcn_permlane32_swap(__float_as_uint(mx), __float_as_uint(mx), false, false); mx = fmaxf(__uint_as_float(rr[0]), __uint_as_float(rr[1])); }
    float l_run = 0.f; bf16x8 pa[16];
#pragma unroll
    for (int kt = 0; kt < 8; ++kt) {
#pragma unroll
        for (int r = 0; r < 16; ++r) { S[kt][r] = __builtin_amdgcn_exp2f(S[kt][r] - mx); l_run += S[kt][r]; }
        const u32x4 w0 = (u32x4){cvtpk_s(S[kt][0], S[kt][1]), cvtpk_s(S[kt][2], S[kt][3]), cvtpk_s(S[kt][4], S[kt][5]), cvtpk_s(S[kt][6], S[kt][7])};
        const u32x4 w1 = (u32x4){cvtpk_s(S[kt][8], S[kt][9]), cvtpk_s(S[kt][10], S[kt][11]), cvtpk_s(S[kt][12], S[kt][13]), cvtpk_s(S[kt][14], S[kt][15])};
        pa[2 * kt] = __builtin_bit_cast(bf16x8, w0); pa[2 * kt + 1] = __builtin_bit_cast(bf16x8, w1);
    }
    ATT_WAIT_BAR(0);
#pragma unroll
    for (int j = 0; j < 16; ++j) { const int p = wid * 16 + j;
        glds16(Vh + (long)(16 * (p & 15) + (lane >> 2)) * 1024 + (p >> 4) * 32 + (lane & 3) * 8, (unsigned)__builtin_amdgcn_readfirstlane(lds0 + p * 1024)); }
    f32x16 o[8];
#pragma unroll
    for (int d0 = 0; d0 < 8; ++d0) o[d0] = f32x16{};
    ATT_WAIT_BAR(0);
    { const int vbA = (int)lds0 + ((lane >> 4) & 1) * 32 + (lane & 3) * 8 + (4 * hi + ((lane & 15) >> 2)) * 64, vbB = vbA + 65536;
#pragma unroll
        for (int s = 0; s < 16; ++s) {
#pragma unroll
            for (int d0 = 0; d0 < 8; ++d0) { s16x4 lo, hh;
                if (d0 < 4) { asm volatile("ds_read_b64_tr_b16 %0,%1 offset:%c2" : "=&v"(lo) : "v"(vbA), "i"((d0 & 3) * 16384 + s * 1024) : "memory");
                              asm volatile("ds_read_b64_tr_b16 %0,%1 offset:%c2" : "=&v"(hh) : "v"(vbA), "i"((d0 & 3) * 16384 + s * 1024 + 512) : "memory"); }
                else        { asm volatile("ds_read_b64_tr_b16 %0,%1 offset:%c2" : "=&v"(lo) : "v"(vbB), "i"((d0 & 3) * 16384 + s * 1024) : "memory");
                              asm volatile("ds_read_b64_tr_b16 %0,%1 offset:%c2" : "=&v"(hh) : "v"(vbB), "i"((d0 & 3) * 16384 + s * 1024 + 512) : "memory"); }
                asm volatile("s_waitcnt lgkmcnt(0)" : "+v"(lo), "+v"(hh) :: "memory"); ATT_SBAR();
                const bf16x8 vf = (bf16x8){lo[0], lo[1], lo[2], lo[3], hh[0], hh[1], hh[2], hh[3]};
                o[d0] = __builtin_amdgcn_mfma_f32_32x32x16_bf16(pa[s], vf, o[d0], 0, 0, 0); } } }
    { auto rr = __builtin_amdgcn_permlane32_swap(__float_as_uint(l_run), __float_as_uint(l_run), false, false); l_run = __uint_as_float(rr[0]) + __uint_as_float(rr[1]); }
    if (hi == 0) wsf[r32] = l_run;
    asm volatile("s_waitcnt lgkmcnt(0)" ::: "memory");
    float rli[16];
#pragma unroll
    for (int r = 0; r < 16; ++r) rli[r] = __builtin_amdgcn_rcpf(wsf[crow(r, hi)]);
    ATT_WAIT_BAR(0);
    { LAS unsigned short* stg = (LAS unsigned short*)L + wid * 8192;
#pragma unroll
        for (int r = 0; r < 16; ++r) { const int orow = crow(r, hi);
#pragma unroll
            for (int d0 = 0; d0 < 8; ++d0) stg[orow * 256 + d0 * 32 + r32] = (unsigned short)f2bf(o[d0][r] * rli[r]); }
        asm volatile("s_waitcnt lgkmcnt(0)" ::: "memory");
#pragma unroll
        for (int i = 0; i < 16; ++i) { const int row = i * 2 + (lane >> 5), ch = lane & 31; const u32x4 v = *(const LAS u32x4*)(stg + row * 256 + ch * 8); *(u32x4*)(Qw + (long)row * 1024 + ch * 8) = v; } }
    asm volatile("s_waitcnt lgkmcnt(0)\n\ts_barrier" ::: "memory");
}
}
namespace satt {
template <int D, int KT>
__device__ __forceinline__ void sattn_unit(LAS unsigned char* L, bf16* QO  , const float* Kc, const float* Vc  , int ncache,
                                           const bf16* Kn, const bf16* Vn  , int nnew, const float* btab  , float* copyK, float* copyV) {
    int tid = threadIdx.x; asm volatile("" : "+v"(tid));
    const int t = tid >> 5, jj = tid & 31;
    LAS float* Ks = (LAS float*)L; LAS float* Vs = Ks + KT * (D + 1); LAS float* Qs = Vs + KT * D; LAS float* Ps = Qs + 16 * D;
    const int nkeys = ncache + nnew, ntiles = (nkeys + KT - 1) / KT;
    __syncthreads();
    for (int i = tid; i < 16 * D; i += 512) Qs[i] = __uint_as_float(((unsigned)QO[(i / D) * 1024 + (i % D)]) << 16);
    float m_run = -1e30f, l_run = 0.f; float o[D / 32];
#pragma unroll
    for (int i = 0; i < D / 32; ++i) o[i] = 0.f;
    for (int tile = 0; tile < ntiles; ++tile) {
        __syncthreads();
        for (int idx = tid; idx < KT * D / 4; idx += 512) {
            const int j = idx / (D / 4), c4 = (idx % (D / 4)) * 4, key = tile * KT + j;
            float4 kv = make_float4(0.f, 0.f, 0.f, 0.f), vv = kv;
            if (key < ncache) { kv = *(const float4*)(Kc + (size_t)key * 1024 + c4); vv = *(const float4*)(Vc + (size_t)key * 1024 + c4);
                if (copyK && key >= 16) { *(float4*)(copyK + (size_t)(key - 16) * 1024 + c4) = kv; *(float4*)(copyV + (size_t)(key - 16) * 1024 + c4) = vv; } }
            else if (key < nkeys) { const uint2 a = *(const uint2*)(Kn + (size_t)(key - ncache) * 1024 + c4), b = *(const uint2*)(Vn + (size_t)(key - ncache) * 1024 + c4);
                kv = make_float4(__uint_as_float(a.x << 16), __uint_as_float(a.x & 0xffff0000u), __uint_as_float(a.y << 16), __uint_as_float(a.y & 0xffff0000u));
                vv = make_float4(__uint_as_float(b.x << 16), __uint_as_float(b.x & 0xffff0000u), __uint_as_float(b.y << 16), __uint_as_float(b.y & 0xffff0000u)); }
            LAS float* kd = Ks + j * (D + 1) + c4; kd[0] = kv.x; kd[1] = kv.y; kd[2] = kv.z; kd[3] = kv.w;
            *(LAS f32x4*)(Vs + j * D + c4) = (f32x4){vv.x, vv.y, vv.z, vv.w};
        }
        __syncthreads();
        float sc[KT / 32]; float tmax = -1e30f;
#pragma unroll
        for (int kk = 0; kk < KT / 32; ++kk) {
            const int j = jj + 32 * kk, key = tile * KT + j; float s = 0.f;
            const LAS float* qp = Qs + t * D; const LAS float* kp = Ks + j * (D + 1);
#pragma unroll 8
            for (int d = 0; d < D; ++d) s += qp[d] * kp[d];
            if (key >= nkeys) s = -1e30f;
            else if (btab) { int dd = 512 + t - key; dd = dd > 128 ? 128 : dd; s += btab[dd + 128] * LOG2E; }
            sc[kk] = s; tmax = fmaxf(tmax, s);
        }
#pragma unroll
        for (int o_ = 1; o_ < 32; o_ <<= 1) tmax = fmaxf(tmax, __shfl_xor(tmax, o_));
        const float mn = fmaxf(m_run, tmax), alpha = __builtin_amdgcn_exp2f(m_run - mn);
        float ps = 0.f;
#pragma unroll
        for (int kk = 0; kk < KT / 32; ++kk) { const float p = (sc[kk] <= -1e29f) ? 0.f : __builtin_amdgcn_exp2f(sc[kk] - mn); Ps[t * KT + jj + 32 * kk] = p; ps += p; }
#pragma unroll
        for (int o_ = 1; o_ < 32; o_ <<= 1) ps += __shfl_xor(ps, o_);
        l_run = l_run * alpha + ps; m_run = mn;
#pragma unroll
        for (int i = 0; i < D / 32; ++i) o[i] *= alpha;
        __syncthreads();
        for (int j = 0; j < KT; ++j) { const float pj = Ps[t * KT + j];
#pragma unroll
            for (int i = 0; i < D / 32; ++i) o[i] += pj * Vs[j * D + jj + 32 * i]; }
    }
    const float rl = 1.f / l_run;
#pragma unroll
    for (int i = 0; i < D / 32; ++i) QO[t * 1024 + jj + 32 * i] = (bf16)f2bf(o[i] * rl);
    __syncthreads();
}
}
namespace gdn {
typedef short bf16x8 __attribute__((ext_vector_type(8)));
typedef short s16x4 __attribute__((ext_vector_type(4)));
typedef float f32x4 __attribute__((ext_vector_type(4)));
typedef unsigned u32x2 __attribute__((ext_vector_type(2)));
typedef unsigned u32x4 __attribute__((ext_vector_type(4)));
constexpr int QN = 0, KN = 17408  , KNT = 34816, VT = 53248  , ABF = 71680, AQK = 80896, DBF = 90112, AD = 92160, ST = 96512,
              GV = 131328, BETA = GV + 256, EGT = GV + 512, EGR = GV + 768, BEG = GV + 1024, CARRY = GV + 1280, RMS = CARRY + 4608, G_END = RMS + 1024;
constexpr int S272 = 272, S144 = 144;
__device__ __forceinline__ float bf2f(short s) { return __uint_as_float(((unsigned)(unsigned short)s) << 16); }
__device__ __forceinline__ unsigned pk(float lo, float hi) { return att::cvtpk_s(lo, hi); }
__device__ __forceinline__ s16x4 pk4(const f32x4& v) { u32x2 w; w.x = pk(v[0], v[1]); w.y = pk(v[2], v[3]); return __builtin_bit_cast(s16x4, w); }
__device__ __forceinline__ s16x4 pk4n(const f32x4& v) { u32x2 w; w.x = pk(-v[0], -v[1]); w.y = pk(-v[2], -v[3]); return __builtin_bit_cast(s16x4, w); }
#define G_MMA32(a, b, c) __builtin_amdgcn_mfma_f32_16x16x32_bf16(a, b, c, 0, 0, 0)
#define G_MMA16(a, b, c) __builtin_amdgcn_mfma_f32_16x16x16bf16_1k(a, b, c, 0, 0, 0)
#define G_FRAG8(base, stride, row, kb) (*(const LAS bf16x8*)((base) + (row) * (stride) + (kb)))

#if defined(GDN_DBG) && GDN_DBG == 2
#define DBG_BADF(x) (!(__builtin_fabsf(x) < 1e30f))
#define DBG_FLAG(k, cond) do { if (cond) atomicOr((unsigned*)(LAS unsigned*)(L + G_END), 1u << (k)); } while (0)
#define DBG_X(k) do { bool bad_ = false; _Pragma("unroll") for (int i_ = 0; i_ < 4; ++i_) _Pragma("unroll") for (int c_ = 0; c_ < 2; ++c_) _Pragma("unroll") for (int e_ = 0; e_ < 4; ++e_) bad_ |= DBG_BADF(X[i_][c_][e_]); DBG_FLAG(k, bad_); } while (0)
#else
#define DBG_FLAG(k, cond) do {} while (0)
#define DBG_X(k) do {} while (0)
#endif
__device__ __forceinline__ void gdn_unit(LAS unsigned char* L, const bf16* QKVB, bf16* OB, const float* AB, long row0, int h, int nchunks, int nvalid,
                                         const float* wconv, const float* alog, const float* dtb, const float* normg, const float* convst, const float* S0, float* Sout) {
    int tid0 = threadIdx.x; asm volatile("" : "+v"(tid0));
    const int wave = __builtin_amdgcn_readfirstlane(tid0 >> 6), wq = wave & 3; const bool grpA = wave < 4;
    const float alog_h = alog[h], dtb_h = dtb[h];
    LAS float* fGV = (LAS float*)(L + GV); LAS float* fBETA = (LAS float*)(L + BETA); LAS float* fEGT = (LAS float*)(L + EGT); LAS float* fEGR = (LAS float*)(L + EGR); LAS float* fBEG = (LAS float*)(L + BEG);
    LAS float* fRMS = (LAS float*)(L + RMS); LAS float* fAD = (LAS float*)(L + AD);
    f32x4 Sreg[8][2];
    {
    const int tid = tid0, lane = tid & 63, lr = lane & 15, lg = lane >> 4;
    for (int i = tid; i < 9216 / 4; i += 512) ((LAS unsigned*)(L + AQK))[i] = 0u;
    for (int i = tid; i < 3 * 384; i += 512) { float v = 0.f; if (convst) { const int r = i / 384, cc = i % 384; v = convst[r * 3072 + (cc >> 7) * 1024 + h * 128 + (cc & 127)]; } ((LAS unsigned short*)(L + CARRY))[i] = (unsigned short)f2bf(v); }
    if (grpA) {
#pragma unroll
        for (int j = 0; j < 8; ++j)
#pragma unroll
            for (int ct = 0; ct < 2; ++ct) { f32x4 v = (f32x4){0.f, 0.f, 0.f, 0.f};
                if (S0) {
#pragma unroll
                    for (int e = 0; e < 4; ++e) v[e] = S0[(size_t)(16 * j + 4 * lg + e) * 128 + 32 * wq + 16 * ct + lr]; }
                Sreg[j][ct] = v;
                *(LAS s16x4*)(L + ST + (32 * wq + 16 * ct + lr) * S272 + (16 * j + 4 * lg) * 2) = pk4(v); }
    }
    }
    __syncthreads();
    for (int c = 0; c < nchunks; ++c) {
        const long crow0 = row0 + (long)c * 64;
        int tid = threadIdx.x; asm volatile("" : "+v"(tid));
        const int lane = tid & 63, lr = lane & 15, lg = lane >> 4, t = tid >> 3, sub = tid & 7, d0 = sub * 16;
#if defined(GDN_DBG) && GDN_DBG == 2
        if (tid == 0) *(LAS unsigned*)(L + G_END) = 0u;
#endif
        if (wave == 0) {
            float g = 0.f, beta = 0.f;
            if (lane < nvalid) { const float* ab = AB + (crow0 + lane) * 16; const float a = ab[h] + dtb_h; const float sp = a > 20.f ? a : log1pf(__expf(a)); g = -__expf(alog_h) * sp; beta = 1.f / (1.f + __expf(-ab[8 + h])); }
            float G = g;
#pragma unroll
            for (int o = 1; o < 64; o <<= 1) { const float n = __shfl_up(G, o); if (lane >= o) G += n; }
            const float G63 = __shfl(G, 63);
            fGV[lane] = G; fBETA[lane] = beta; fEGT[lane] = __expf(G); fEGR[lane] = __expf(G63 - G); fBEG[lane] = beta * __expf(G);
        }
        {
            const bool valid = t < nvalid;
            LAS const unsigned char* cin = L + CARRY + (c & 1) * 2304;
            LAS unsigned char* cout = L + CARRY + ((c + 1) & 1) * 2304;
#pragma unroll 1
            for (int op = 0; op < 3; ++op) {
                float y[16];
#pragma unroll
                for (int hf = 0; hf < 2; ++hf) {
                    const int col = op * 1024 + h * 128 + d0 + hf * 8;
                    float acc[8];
#pragma unroll
                    for (int e = 0; e < 8; ++e) acc[e] = 0.f;
#pragma unroll
                    for (int j = 0; j < 4; ++j) {
                        const int tt = t + j - 3; bf16x8 x = (bf16x8){0, 0, 0, 0, 0, 0, 0, 0};
                        if (valid) { if (tt >= 0) x = *(const bf16x8*)(QKVB + (crow0 + tt) * 3072 + col); else x = *(const LAS bf16x8*)(cin + ((tt + 3) * 384 + op * 128 + d0 + hf * 8) * 2); }
                        const f32x4 w0 = *(const f32x4*)(wconv + j * 3072 + col), w1 = *(const f32x4*)(wconv + j * 3072 + col + 4);
                        acc[0] += w0[0] * bf2f(x[0]); acc[1] += w0[1] * bf2f(x[1]); acc[2] += w0[2] * bf2f(x[2]); acc[3] += w0[3] * bf2f(x[3]);
                        acc[4] += w1[0] * bf2f(x[4]); acc[5] += w1[1] * bf2f(x[5]); acc[6] += w1[2] * bf2f(x[6]); acc[7] += w1[3] * bf2f(x[7]);
                        if (j == 3 && t >= 61) *(LAS bf16x8*)(cout + ((t - 61) * 384 + op * 128 + d0 + hf * 8) * 2) = x;
                    }
#pragma unroll
                    for (int e = 0; e < 8; ++e) y[hf * 8 + e] = acc[e] / (1.f + __expf(-acc[e]));
                }
                float r = 1.f;
                if (op < 2) { float sq = 0.f;
#pragma unroll
                    for (int e = 0; e < 16; ++e) sq += y[e] * y[e];
                    sq += __shfl_xor(sq, 1); sq += __shfl_xor(sq, 2); sq += __shfl_xor(sq, 4);
                    r = rsqrtf(sq + 1e-6f); if (op == 0) r *= 0.08838834764831845f; }
                if (!valid) r = 0.f;
#pragma unroll
                for (int e = 0; e < 16; ++e) y[e] *= r;
                if (op < 2) {
                    const u32x4 w0 = (u32x4){pk(y[0], y[1]), pk(y[2], y[3]), pk(y[4], y[5]), pk(y[6], y[7])}, w1 = (u32x4){pk(y[8], y[9]), pk(y[10], y[11]), pk(y[12], y[13]), pk(y[14], y[15])};
                    LAS unsigned char* dst = L + (op == 0 ? QN : KN) + t * S272 + d0 * 2;
                    *(LAS u32x4*)dst = w0; *(LAS u32x4*)(dst + 16) = w1; }
                if (op >= 1) {
                    LAS unsigned char* dst = L + (op == 1 ? KNT : VT) + d0 * S144 + t * 2;
#pragma unroll
                    for (int e = 0; e < 16; ++e) *(LAS unsigned short*)(dst + e * S144) = (unsigned short)f2bf(y[e]); }
            }
        }
        __syncthreads();
#if defined(GDN_DBG) && GDN_DBG == 1
        {
            for (int i = tid; i < 64 * 128; i += 512) { const int tt = i >> 7, d = i & 127; if (tt < nvalid) OB[(crow0 + tt) * 3072 + h * 128 + d] = *(LAS unsigned short*)(L + QN + tt * S272 + d * 2); }
            __syncthreads(); continue;
        }
#endif
        {
            const int nt = (wave < 3) ? 2 : (wave == 3 ? 4 : (wave < 6 ? 3 : 2));
            for (int it = 0; it < nt; ++it) {
                int ri, cj; bool isqk = false;
                if (wave < 3) { const int idx = 2 * wave + it; ri = idx < 1 ? 1 : (idx < 3 ? 2 : 3); cj = idx < 1 ? 0 : (idx < 3 ? idx - 1 : idx - 3); }
                else if (wave == 3) { ri = it; cj = it; }
                else { const int idx = (wave - 4) + 4 * it; ri = idx < 1 ? 0 : (idx < 3 ? 1 : (idx < 6 ? 2 : 3)); cj = idx < 1 ? 0 : (idx < 3 ? idx - 1 : (idx < 6 ? idx - 3 : idx - 6)); isqk = true; }
                f32x4 acc = (f32x4){0.f, 0.f, 0.f, 0.f};
                LAS const unsigned char* Abase = L + (isqk ? QN : KN);
#pragma unroll
                for (int ks = 0; ks < 4; ++ks) { const bf16x8 a = G_FRAG8(Abase, S272, 16 * ri + lr, ks * 64 + lg * 16), b = G_FRAG8(L + KN, S272, 16 * cj + lr, ks * 64 + lg * 16); acc = G_MMA32(a, b, acc); }
                const int s = 16 * cj + lr; const float Gs = fGV[s];
                const f32x4 Gt = *(const LAS f32x4*)(fGV + 16 * ri + 4 * lg), Bt = *(const LAS f32x4*)(fBETA + 16 * ri + 4 * lg);
#pragma unroll
                for (int e = 0; e < 4; ++e) { const int tt = 16 * ri + 4 * lg + e;
                    if (isqk) { const float v = (s <= tt) ? acc[e] * __expf(Gt[e] - Gs) : 0.f; *(LAS unsigned short*)(L + AQK + tt * S144 + s * 2) = (unsigned short)f2bf(v); }
                    else { const float v = (s < tt) ? acc[e] * Bt[e] * __expf(Gt[e] - Gs) : 0.f;
                        if (ri == cj) fAD[ri * 272 + (4 * lg + e) * 17 + lr] = v; else *(LAS unsigned short*)(L + ABF + tt * S144 + s * 2) = (unsigned short)f2bf(-v); } }
            }
            if (wave == 3) {
                asm volatile("s_waitcnt lgkmcnt(0)" ::: "memory");
                float x[16];
#pragma unroll
                for (int i = 0; i < 16; ++i) { float sacc = (i == lr) ? 1.f : 0.f;
#pragma unroll
                    for (int j = 0; j < i; ++j) sacc -= fAD[lg * 272 + i * 17 + j] * x[j];
                    x[i] = sacc; }
#pragma unroll
                for (int i = 0; i < 16; ++i) *(LAS unsigned short*)(L + DBF + (16 * lg + i) * 32 + lr * 2) = (unsigned short)f2bf(x[i]);
            }
        }
        __syncthreads();
#if defined(GDN_DBG) && GDN_DBG == 2
        { bool bad = false;
          for (int i = tid; i < 64 * 64; i += 512) { const int r = i >> 6, cc = i & 63; const unsigned short a = *(LAS unsigned short*)(L + AQK + r * S144 + cc * 2); bad |= (a & 0x7f80) == 0x7f80;
              if ((cc >> 4) < (r >> 4)) { const unsigned short b2 = *(LAS unsigned short*)(L + ABF + r * S144 + cc * 2); bad |= (b2 & 0x7f80) == 0x7f80; } }
          for (int i = tid; i < 64 * 16; i += 512) { const unsigned short a = *(LAS unsigned short*)(L + DBF + i * 2); bad |= (a & 0x7f80) == 0x7f80; }
          DBG_FLAG(1, bad); }
#endif
        f32x4 X[4][2];
        {
            LAS const unsigned char* SRC = L + (grpA ? VT : KNT); LAS const float* SCL = grpA ? fBETA : fBEG;
            s16x4 Xb[4][2];
#pragma unroll
            for (int i = 0; i < 4; ++i) {
                const f32x4 sc = *(const LAS f32x4*)(SCL + 16 * i + 4 * lg);
#pragma unroll
                for (int ct = 0; ct < 2; ++ct) { const s16x4 raw = *(const LAS s16x4*)(SRC + (32 * wq + 16 * ct + lr) * S144 + (16 * i + 4 * lg) * 2);
                    X[i][ct] = (f32x4){bf2f(raw[0]) * sc[0], bf2f(raw[1]) * sc[1], bf2f(raw[2]) * sc[2], bf2f(raw[3]) * sc[3]}; }
            }
#pragma unroll
            for (int i = 0; i < 4; ++i) {
#pragma unroll
                for (int k = 0; k < i; ++k) { const s16x4 a = *(const LAS s16x4*)(L + ABF + (16 * i + lr) * S144 + (16 * k + 4 * lg) * 2);
#pragma unroll
                    for (int ct = 0; ct < 2; ++ct) X[i][ct] = G_MMA16(a, Xb[k][ct], X[i][ct]); }
                const s16x4 d = *(const LAS s16x4*)(L + DBF + (16 * i + lr) * 32 + (4 * lg) * 2);
#pragma unroll
                for (int ct = 0; ct < 2; ++ct) { const s16x4 tb = pk4(X[i][ct]); X[i][ct] = G_MMA16(d, tb, ((f32x4){0.f, 0.f, 0.f, 0.f})); Xb[i][ct] = pk4(X[i][ct]); }
            }
            if (!grpA) {
#pragma unroll
                for (int i = 0; i < 4; ++i)
#pragma unroll
                    for (int ct = 0; ct < 2; ++ct)
#pragma unroll
                        for (int e = 0; e < 4; ++e) *(LAS unsigned short*)(L + KN + (16 * i + 4 * lg + e) * S272 + (32 * wq + 16 * ct + lr) * 2) = (unsigned short)f2bf(-X[i][ct][e]);
            }
        }
        DBG_X(2);
        __syncthreads();
        {
            bf16x8 bS[2][4];
#pragma unroll
            for (int ct = 0; ct < 2; ++ct)
#pragma unroll
                for (int ks = 0; ks < 4; ++ks) bS[ct][ks] = G_FRAG8(L + ST, S272, 32 * wq + 16 * ct + lr, ks * 64 + lg * 16);
            LAS const unsigned char* Abase = L + (grpA ? KN : QN);
            if (!grpA) {
#pragma unroll
                for (int i = 0; i < 4; ++i) { X[i][0] = (f32x4){0.f, 0.f, 0.f, 0.f}; X[i][1] = (f32x4){0.f, 0.f, 0.f, 0.f}; } }
#pragma unroll
            for (int i = 0; i < 4; ++i)
#pragma unroll
                for (int ks = 0; ks < 4; ++ks) { const bf16x8 a = G_FRAG8(Abase, S272, 16 * i + lr, ks * 64 + lg * 16);
#pragma unroll
                    for (int ct = 0; ct < 2; ++ct) X[i][ct] = G_MMA32(a, bS[ct][ks], X[i][ct]); }
            if (grpA) {
#pragma unroll
                for (int i = 0; i < 4; ++i)
#pragma unroll
                    for (int ct = 0; ct < 2; ++ct) *(LAS s16x4*)(L + VT + (32 * wq + 16 * ct + lr) * S144 + (16 * i + 4 * lg) * 2) = pk4(X[i][ct]);
            }
        }
        DBG_X(3);
        __syncthreads();
        if (grpA) {
            const float eg63 = fEGT[63];
            bf16x8 bsc[2][2];
#pragma unroll
            for (int ct = 0; ct < 2; ++ct)
#pragma unroll
                for (int ks = 0; ks < 2; ++ks) { const bf16x8 raw = G_FRAG8(L + VT, S144, 32 * wq + 16 * ct + lr, ks * 64 + lg * 16);
                    const f32x4 e0 = *(const LAS f32x4*)(fEGR + 32 * ks + 8 * lg), e1 = *(const LAS f32x4*)(fEGR + 32 * ks + 8 * lg + 4);
                    const u32x4 w = (u32x4){pk(bf2f(raw[0]) * e0[0], bf2f(raw[1]) * e0[1]), pk(bf2f(raw[2]) * e0[2], bf2f(raw[3]) * e0[3]), pk(bf2f(raw[4]) * e1[0], bf2f(raw[5]) * e1[1]), pk(bf2f(raw[6]) * e1[2], bf2f(raw[7]) * e1[3])};
                    bsc[ct][ks] = __builtin_bit_cast(bf16x8, w); }
#pragma unroll
            for (int j = 0; j < 8; ++j) {
#pragma unroll
                for (int ct = 0; ct < 2; ++ct) Sreg[j][ct] = Sreg[j][ct] * eg63;
#pragma unroll
                for (int ks = 0; ks < 2; ++ks) { const bf16x8 a = G_FRAG8(L + KNT, S144, 16 * j + lr, ks * 64 + lg * 16);
#pragma unroll
                    for (int ct = 0; ct < 2; ++ct) Sreg[j][ct] = G_MMA32(a, bsc[ct][ks], Sreg[j][ct]); }
#pragma unroll
                for (int ct = 0; ct < 2; ++ct) *(LAS s16x4*)(L + ST + (32 * wq + 16 * ct + lr) * S272 + (16 * j + 4 * lg) * 2) = pk4(Sreg[j][ct]);
            }
            { bool bad_ = false;
#pragma unroll
              for (int j = 0; j < 8; ++j)
#pragma unroll
                  for (int ct = 0; ct < 2; ++ct)
#pragma unroll
                      for (int e = 0; e < 4; ++e) bad_ |= !(__builtin_fabsf(Sreg[j][ct][e]) < 1e30f);
              DBG_FLAG(5, bad_); }
            __syncthreads();
        } else {
            f32x4 O2[4][2];
#pragma unroll
            for (int i = 0; i < 4; ++i) { O2[i][0] = (f32x4){0.f, 0.f, 0.f, 0.f}; O2[i][1] = (f32x4){0.f, 0.f, 0.f, 0.f}; }
            bf16x8 bW[2][2];
#pragma unroll
            for (int ct = 0; ct < 2; ++ct)
#pragma unroll
                for (int ks = 0; ks < 2; ++ks) bW[ct][ks] = G_FRAG8(L + VT, S144, 32 * wq + 16 * ct + lr, ks * 64 + lg * 16);
#pragma unroll
            for (int i = 0; i < 4; ++i)
#pragma unroll
                for (int ks = 0; ks < 2; ++ks) { const bf16x8 a = G_FRAG8(L + AQK, S144, 16 * i + lr, ks * 64 + lg * 16);
#pragma unroll
                    for (int ct = 0; ct < 2; ++ct) O2[i][ct] = G_MMA32(a, bW[ct][ks], O2[i][ct]); }
#pragma unroll
            for (int i = 0; i < 4; ++i) { const f32x4 eg = *(const LAS f32x4*)(fEGT + 16 * i + 4 * lg);
#pragma unroll
                for (int ct = 0; ct < 2; ++ct) X[i][ct] = X[i][ct] * eg + O2[i][ct];
                f32x4 p = X[i][0] * X[i][0] + X[i][1] * X[i][1];
#pragma unroll
                for (int e = 0; e < 4; ++e) { float v = p[e]; v += __shfl_xor(v, 1); v += __shfl_xor(v, 2); v += __shfl_xor(v, 4); v += __shfl_xor(v, 8); p[e] = v; }
                if (lr == 0) {
#pragma unroll
                    for (int e = 0; e < 4; ++e) fRMS[(16 * i + 4 * lg + e) * 4 + wq] = p[e]; } }
            DBG_X(4);
            __syncthreads();
            const float ng0 = normg[32 * wq + lr], ng1 = normg[32 * wq + 16 + lr];
#pragma unroll
            for (int i = 0; i < 4; ++i)
#pragma unroll
                for (int e = 0; e < 4; ++e) { const int tt = 16 * i + 4 * lg + e;
                    const f32x4 pr = *(const LAS f32x4*)(fRMS + tt * 4); const float rstd = rsqrtf((pr[0] + pr[1] + pr[2] + pr[3]) * (1.f / 128.f) + 1e-6f);
                    if (tt < nvalid) { bf16* orow = OB + (crow0 + tt) * 3072 + h * 128 + 32 * wq + lr;
                        orow[0] = (bf16)f2bf(X[i][0][e] * rstd * ng0); orow[16] = (bf16)f2bf(X[i][1][e] * rstd * ng1); } }
        }
#if defined(GDN_DBG) && GDN_DBG == 2
        __syncthreads();
        { const unsigned bits = *(LAS unsigned*)(L + G_END); int kf = 0; for (int k = 5; k >= 1; --k) if (bits & (1u << k)) kf = k;
          const float scl = 1.f + 0.01f * (float)kf;
          for (int i = tid; i < 64 * 128; i += 512) { const int tt = i >> 7, d = i & 127; if (tt < nvalid) OB[(crow0 + tt) * 3072 + h * 128 + d] = (bf16)f2bf(scl * bf2f((short)*(LAS unsigned short*)(L + QN + tt * S272 + d * 2))); } }
        __syncthreads();
#endif
    }
    if (grpA) {
        const int lane = tid0 & 63, lr = lane & 15, lg = lane >> 4;
#pragma unroll
        for (int j = 0; j < 8; ++j)
#pragma unroll
            for (int ct = 0; ct < 2; ++ct)
#pragma unroll
                for (int e = 0; e < 4; ++e) Sout[(size_t)(16 * j + 4 * lg + e) * 128 + 32 * wq + 16 * ct + lr] = Sreg[j][ct][e];
    }
    __syncthreads();
}
#undef G_MMA32
#undef G_MMA16
#undef G_FRAG8
}
constexpr int NWAVES = 8;
constexpr int R_P = 32768, R_S = 512, R_ALL = 33280;
constexpr size_t MiB = 1u << 20;
constexpr size_t WS_CTL = 0, CTL_ZERO_BYTES = 1 * MiB;
constexpr size_t WS_WIN = 1 * MiB;
constexpr size_t WS_WG = 16 * MiB;
constexpr size_t WS_WMEM = 22 * MiB;
constexpr size_t WS_WOUT = 26 * MiB;
constexpr size_t WS_WFF1 = 28 * MiB;
constexpr size_t WS_WFF2 = 36 * MiB;
constexpr size_t WS_AB = 44 * MiB;
constexpr size_t WS_MK = 47 * MiB, WS_MV = 55 * MiB, WS_MB = 63 * MiB;
constexpr size_t WS_QA = 72 * MiB, WS_KA = 138 * MiB, WS_VA = 204 * MiB;
constexpr size_t WS_QKVB = 270 * MiB;
constexpr size_t WS_END = 466 * MiB;
constexpr size_t DO_XB = 0, DO_QC = 65 * MiB;
constexpr int CW_BAR = 4096;
constexpr int CW_CHK = 1024;
constexpr int CW_QUEUE = 2048;
constexpr int LDS_BYTES = 147456, RING_BYTES = 131072, MISC_OFF = LDS_BYTES - 256;

struct Args { const float* in[25]; float* out; unsigned char* ws; int ph_lo, ph_hi; };

__device__ __forceinline__ void p0_transpose_item(const float* W, int K, int N, int col_off, int nvalid, bf16* WT, int row_off, int nblk, LAS float* scr, int item, int lane) {
    const int kb = item / nblk, nb = item % nblk, k0 = 64 * kb, n0 = 32 * nb;
    const bool ok = (n0 + (lane & 31)) < nvalid;
#pragma unroll 8
    for (int i = 0; i < 32; ++i) { const int kk = 2 * i + (lane >> 5); scr[kk * 33 + (lane & 31)] = ok ? W[(size_t)(k0 + kk) * N + col_off + n0 + (lane & 31)] : 0.f; }
    LDS_WAIT(); asm volatile("" ::: "memory");
    const int c = lane & 7;
#pragma unroll
    for (int j = 0; j < 4; ++j) { const int n = (lane >> 3) + 8 * j; const LAS float* s = scr + (8 * c) * 33 + n;
        v4u o; o.x = pk2(s[0 * 33], s[1 * 33]); o.y = pk2(s[2 * 33], s[3 * 33]); o.z = pk2(s[4 * 33], s[5 * 33]); o.w = pk2(s[6 * 33], s[7 * 33]);
        *(GAS v4u*)(WT + (size_t)(row_off + n0 + n) * K + k0 + 8 * c) = o; }
    LDS_WAIT(); asm volatile("" ::: "memory");
}
__device__ __forceinline__ void cvt_row_bf16(const float* xrow, bf16* orow, int lane) {
    const GAS f32x4* xr = (const GAS f32x4*)xrow + lane;
    GAS unsigned long long* o8 = (GAS unsigned long long*)orow + lane;
    f32x4 v[4];
#pragma unroll
    for (int j = 0; j < 4; ++j) v[j] = xr[64 * j];
#pragma unroll
    for (int j = 0; j < 4; ++j) o8[64 * j] = (unsigned long long)pk2(v[j].x, v[j].y) | ((unsigned long long)pk2(v[j].z, v[j].w) << 32);
}

struct P1Order {
    int G, c;
    static constexpr int nM0 = 130, nN0 = 29, nwg0 = nM0 * nN0, nM1 = 16, nN1 = 8, nwg1 = nM1 * nN1, nwg = nwg0 + nwg1;
    __device__ bool next(int i, pg8::Unit& u) const {
        const long L = (long)i * G + c; if (L >= nwg) return false;
        int wgid = (int)L; { const int q = nwg / 8, r = nwg % 8, xcd = wgid % 8, off = wgid / 8; wgid = (xcd < r ? xcd * (q + 1) : r * (q + 1) + (xcd - r) * q) + off; }
        if (wgid < nwg0) { const int nig = 8 * nN0, gid = wgid / nig, fm = gid * 8, gsz = (nM0 - fm) < 8 ? (nM0 - fm) : 8;
            u.pm = fm + ((wgid % nig) % gsz); u.pn = (wgid % nig) / gsz; u.job = 0; }
        else { const int w = wgid - nwg0; u.pm = w % nM1; u.pn = w / nM1; u.job = 1; }
        return true;
    }
    __device__ __forceinline__ void a_ready(const pg8::Unit&) const {}
    __device__ __forceinline__ void done(const pg8::Unit&) const {}
};

typedef pg8::f32x4 acc_t[2][2][4][2];
struct EpiP1 {
    static constexpr bool PERM = true, AFTER_DRAIN = false;
    unsigned char* ws; float* out;
    __device__ __forceinline__ void operator()(const acc_t& acc, const pg8::Unit& u, int wr, int wc, int fr, int fq) const {
        int lr0 = wr * 64 + fr, cl0 = wc * 32 + 8 * fq; const int pm = u.pm, pn = u.pn;
        asm volatile("" : "+v"(lr0), "+v"(cl0));
        if (u.job == 0 && pn == 28) {
            if (wc == 0 && fq < 2) {
                float* AB = (float*)(ws + WS_AB);
#pragma unroll
                for (int ai = 0; ai < 2; ++ai)
#pragma unroll
                    for (int m = 0; m < 4; ++m) { float* d = AB + (size_t)(pm * 256 + lr0 + ai * 128 + m * 16) * 16 + 8 * fq;
                        *(pg8::f32x4*)d = acc[ai][0][m][0]; *(pg8::f32x4*)(d + 4) = acc[ai][0][m][1]; }
            }
            return;
        }
        bf16* tile; int ld = 1024; float sc = 1.f; int fmode = 0; size_t fbase = 0; int fld = 1024;
        if (u.job == 0) {
            if (pn < 12) { const int which = pn >> 2, colt = (pn & 3) * 256;
                tile = (bf16*)(ws + (which == 0 ? WS_QA : (which == 1 ? WS_KA : WS_VA))) + (size_t)pm * 256 * 1024 + colt; if (which == 0) sc = C2A;
                if (which != 0) { const bool smp = pm >= 128;
                    if (smp) { fmode = 2; fbase = (which == 1 ? O_AKS : O_AVS) + colt; }
                    else if ((pm & 7) >= 6) { fmode = 1; fbase = (which == 1 ? O_AKP : O_AVP) + ((size_t)(pm >> 3) * 512 + ((pm & 7) - 6) * 256) * 1024 + colt; } }
            } else if (pn < 24) { const int c3t = (pn - 12) * 256; ld = 3072; fld = 3072;
                tile = (bf16*)(ws + WS_QKVB) + (size_t)pm * 256 * 3072 + c3t;
                if (pm >= 128) { fmode = 4; fbase = O_CONVS + c3t; } else if ((pm & 7) == 7) { fmode = 3; fbase = O_CONVP + (size_t)(pm >> 3) * 3 * 3072 + c3t; }
            } else { tile = (bf16*)((unsigned char*)out + DO_QC) + (size_t)pm * 256 * 1024 + (pn - 24) * 256; sc = C2C; }
        } else { const int isv = pn >> 2, colt = (pn & 3) * 256;
            tile = (bf16*)(ws + (isv ? WS_MV : WS_MK)) + (size_t)pm * 256 * 1024 + colt; fmode = 5; fbase = (isv ? O_MVP : O_MKP) + (size_t)pm * 256 * 1024 + colt; }
#pragma unroll
        for (int ai = 0; ai < 2; ++ai)
#pragma unroll
            for (int m = 0; m < 4; ++m) {
                const int lr = lr0 + ai * 128 + m * 16;
                bf16* rowp = tile + (size_t)lr * ld + cl0;
#pragma unroll
                for (int bj = 0; bj < 2; ++bj) { const pg8::f32x4 v0 = acc[ai][bj][m][0] * sc, v1 = acc[ai][bj][m][1] * sc;
                    pg8::u32x4 w; w.x = pg8::cvt_pk_bf16(v0[0], v0[1]); w.y = pg8::cvt_pk_bf16(v0[2], v0[3]); w.z = pg8::cvt_pk_bf16(v1[0], v1[1]); w.w = pg8::cvt_pk_bf16(v1[2], v1[3]);
                    *(pg8::u32x4*)(rowp + bj * 128) = w; }
                if (fmode) {
                    long drow = -1;
                    if (fmode == 1 || fmode == 5) drow = lr;
                    else if (fmode == 2) { const int rs = (pm - 128) * 256 + lr; drow = (long)(rs >> 4) * 512 + 496 + (rs & 15); }
                    else if (fmode == 3) { if (lr >= 253) drow = lr - 253; }
                    else { const int rs = (pm - 128) * 256 + lr; if ((rs & 15) >= 13) drow = (long)(rs >> 4) * 3 + (rs & 15) - 13; }
                    if (drow >= 0) { float* d = out + fbase + (size_t)drow * fld + cl0;
#pragma unroll
                        for (int bj = 0; bj < 2; ++bj) { *(pg8::f32x4*)(d + bj * 128) = acc[ai][bj][m][0]; *(pg8::f32x4*)(d + bj * 128 + 4) = acc[ai][bj][m][1]; } }
                }
                asm volatile("" ::: "memory");
            }
    }
};

struct P3Order {
    int G, c;
    static constexpr int nM = 130, nP = 4, npair = nM * nP;
    __device__ bool next(int i, pg8::Unit& u) const {
        const int tr = i / 3, br = i - 3 * tr; const long L = (long)tr * G + c; if (L >= npair) return false;
        int wgid = (int)L; { const int q = npair / 8, r = npair % 8, xcd = wgid % 8, off = wgid / 8; wgid = (xcd < r ? xcd * (q + 1) : r * (q + 1) + (xcd - r) * q) + off; }
        const int nig = 8 * nP, gid = wgid / nig, fm = gid * 8, gsz = (nM - fm) < 8 ? (nM - fm) : 8;
        u.pm = fm + ((wgid % nig) % gsz); u.pn = br * 4 + (wgid % nig) / gsz; u.job = 0; return true;
    }
    __device__ __forceinline__ void a_ready(const pg8::Unit&) const {}
    __device__ __forceinline__ void done(const pg8::Unit&) const {}
};
__device__ __forceinline__ float bflo(unsigned w) { return __uint_as_float(w << 16); }
__device__ __forceinline__ float bfhi(unsigned w) { return __uint_as_float(w & 0xffff0000u); }
__device__ __forceinline__ float sigmoid_f(float g) { return __builtin_amdgcn_rcpf(1.f + __builtin_amdgcn_exp2f(-g * LOG2E)); }
struct EpiGate {
    static constexpr bool PERM = true, AFTER_DRAIN = false;
    unsigned char* ws; float* out;
    __device__ __forceinline__ void operator()(const acc_t& acc, const pg8::Unit& u, int wr, int wc, int fr, int fq) const {
        int lr0 = wr * 64 + fr, cl0 = wc * 32 + 8 * fq; const int pm = u.pm, br = u.pn >> 2, pc = u.pn & 3;
        asm volatile("" : "+v"(lr0), "+v"(cl0));
        const bf16* ob; int ldo = 1024;
        if (br == 0) ob = (const bf16*)(ws + WS_QA); else if (br == 1) { ob = (const bf16*)(ws + WS_QKVB); ldo = 3072; } else ob = (const bf16*)((unsigned char*)out + DO_QC);
        ob += (size_t)pm * 256 * ldo + pc * 256 + cl0;
        bf16* mg = (bf16*)(ws + WS_KA) + (size_t)pm * 256 * 1024 + pc * 256 + cl0;
#pragma unroll
        for (int ai = 0; ai < 2; ++ai)
#pragma unroll
            for (int m = 0; m < 4; ++m) {
                const int lr = lr0 + ai * 128 + m * 16;
#pragma unroll
                for (int bj = 0; bj < 2; ++bj) {
                    const pg8::u32x4 ov = *(const pg8::u32x4*)(ob + (size_t)lr * ldo + bj * 128);
                    const pg8::f32x4 g0 = acc[ai][bj][m][0], g1 = acc[ai][bj][m][1];
                    float v[8];
                    v[0] = sigmoid_f(g0[0]) * bflo(ov.x); v[1] = sigmoid_f(g0[1]) * bfhi(ov.x); v[2] = sigmoid_f(g0[2]) * bflo(ov.y); v[3] = sigmoid_f(g0[3]) * bfhi(ov.y);
                    v[4] = sigmoid_f(g1[0]) * bflo(ov.z); v[5] = sigmoid_f(g1[1]) * bfhi(ov.z); v[6] = sigmoid_f(g1[2]) * bflo(ov.w); v[7] = sigmoid_f(g1[3]) * bfhi(ov.w);
                    pg8::u32x4* mp = (pg8::u32x4*)(mg + (size_t)lr * 1024 + bj * 128);
                    if (br != 0) { const pg8::u32x4 pv = *mp;
                        v[0] += bflo(pv.x); v[1] += bfhi(pv.x); v[2] += bflo(pv.y); v[3] += bfhi(pv.y); v[4] += bflo(pv.z); v[5] += bfhi(pv.z); v[6] += bflo(pv.w); v[7] += bfhi(pv.w); }
                    pg8::u32x4 w; w.x = pg8::cvt_pk_bf16(v[0], v[1]); w.y = pg8::cvt_pk_bf16(v[2], v[3]); w.z = pg8::cvt_pk_bf16(v[4], v[5]); w.w = pg8::cvt_pk_bf16(v[6], v[7]);
                    *mp = w;
                }
                asm volatile("" ::: "memory");
            }
    }
};
struct EpiResF32 {
    static constexpr bool PERM = false, AFTER_DRAIN = false;
    const float* res_p; const float* res_s; float* dst; const float* bias;
    __device__ __forceinline__ void operator()(const acc_t& acc, const pg8::Unit& u, int wr, int wc, int fr, int fq) const {
        int lr0 = wr * 64 + fr, cl0 = u.pn * 256 + wc * 32 + 4 * fq;
        asm volatile("" : "+v"(lr0), "+v"(cl0));
        const float* rb = (u.pm < 128) ? res_p + (size_t)u.pm * 256 * 1024 : res_s + (size_t)(u.pm - 128) * 256 * 1024;
        float* db = dst + (size_t)u.pm * 256 * 1024;
        pg8::f32x4 bv[2][2];
#pragma unroll
        for (int bj = 0; bj < 2; ++bj)
#pragma unroll
            for (int n = 0; n < 2; ++n) bv[bj][n] = bias ? *(const pg8::f32x4*)(bias + cl0 + bj * 128 + n * 16) : (pg8::f32x4){0.f, 0.f, 0.f, 0.f};
#pragma unroll
        for (int ai = 0; ai < 2; ++ai)
#pragma unroll
            for (int m = 0; m < 4; ++m) { const size_t off = (size_t)(lr0 + ai * 128 + m * 16) * 1024 + cl0;
#pragma unroll
                for (int bj = 0; bj < 2; ++bj)
#pragma unroll
                    for (int n = 0; n < 2; ++n) { const pg8::f32x4 rv = *(const pg8::f32x4*)(rb + off + bj * 128 + n * 16);
                        *(pg8::f32x4*)(db + off + bj * 128 + n * 16) = rv * DN_ALPHA + acc[ai][bj][m][n] + bv[bj][n]; }
                asm volatile("" ::: "memory"); }
    }
};
struct EpiFf1 {
    static constexpr bool PERM = true, AFTER_DRAIN = false;
    bf16* FF; const float* bias;
    __device__ __forceinline__ void operator()(const acc_t& acc, const pg8::Unit& u, int wr, int wc, int fr, int fq) const {
        int lr0 = wr * 64 + fr, cl0 = u.pn * 256 + wc * 32 + 8 * fq;
        asm volatile("" : "+v"(lr0), "+v"(cl0));
        bf16* tile = FF + (size_t)u.pm * 256 * 4096 + cl0;
        pg8::f32x4 bv[2][2];
#pragma unroll
        for (int bj = 0; bj < 2; ++bj)
#pragma unroll
            for (int n = 0; n < 2; ++n) bv[bj][n] = *(const pg8::f32x4*)(bias + cl0 + bj * 128 + 4 * n);
#pragma unroll
        for (int ai = 0; ai < 2; ++ai)
#pragma unroll
            for (int m = 0; m < 4; ++m) { bf16* rowp = tile + (size_t)(lr0 + ai * 128 + m * 16) * 4096;
#pragma unroll
                for (int bj = 0; bj < 2; ++bj) { pg8::f32x4 v0 = acc[ai][bj][m][0] + bv[bj][0], v1 = acc[ai][bj][m][1] + bv[bj][1];
#pragma unroll
                    for (int e = 0; e < 4; ++e) { v0[e] = fmaxf(v0[e], 0.f); v0[e] *= v0[e]; v1[e] = fmaxf(v1[e], 0.f); v1[e] *= v1[e]; }
                    pg8::u32x4 w; w.x = pg8::cvt_pk_bf16(v0[0], v0[1]); w.y = pg8::cvt_pk_bf16(v0[2], v0[3]); w.z = pg8::cvt_pk_bf16(v1[0], v1[1]); w.w = pg8::cvt_pk_bf16(v1[2], v1[3]);
                    *(pg8::u32x4*)(rowp + bj * 128) = w; }
                asm volatile("" ::: "memory"); }
    }
};
__device__ __forceinline__ float wsum64(float v) {
#pragma unroll
    for (int o = 1; o < 64; o <<= 1) v += __shfl_xor(v, o);
    return v;
}
__device__ __forceinline__ void ln_row(float* row, const float* g, const float* b, bf16* hb, int lane) {
    GAS f32x4* xr = (GAS f32x4*)row + lane;
    f32x4 v[4]; float s = 0.f;
#pragma unroll
    for (int j = 0; j < 4; ++j) { v[j] = xr[64 * j]; s += (v[j].x + v[j].y) + (v[j].z + v[j].w); }
    const float mean = wsum64(s) * (1.f / 1024.f); float s2 = 0.f;
#pragma unroll
    for (int j = 0; j < 4; ++j) { v[j] = v[j] - mean; s2 += (v[j].x * v[j].x + v[j].y * v[j].y) + (v[j].z * v[j].z + v[j].w * v[j].w); }
    const float rstd = 1.f / sqrtf(wsum64(s2) * (1.f / 1024.f) + LN_EPS);
#pragma unroll
    for (int j = 0; j < 4; ++j) { const f32x4 gv = *((const GAS f32x4*)g + lane + 64 * j), bv = *((const GAS f32x4*)b + lane + 64 * j);
        v[j] = v[j] * rstd * gv + bv; xr[64 * j] = v[j];
        if (hb) ((GAS unsigned long long*)hb + lane)[64 * j] = (unsigned long long)pk2(v[j].x, v[j].y) | ((unsigned long long)pk2(v[j].z, v[j].w) << 32); }
}

__global__ void __launch_bounds__(NWAVES * 64, 2) mega_fwd(Args args) {
    extern __shared__ __attribute__((aligned(16))) unsigned char lds[];
    LAS unsigned char* L = (LAS unsigned char*)lds;
    volatile LAS unsigned* MISC = (volatile LAS unsigned*)(L + MISC_OFF);
    const int tid = threadIdx.x, lane = tid & 63, wave = __builtin_amdgcn_readfirstlane(tid >> 6);
#define GRID_N ((int)gridDim.x)
#define BLK_X ((int)blockIdx.x)
#define VCU ((BLK_X % 8) * (GRID_N / 8) + BLK_X / 8)
    unsigned char* ws = args.ws; float* out = args.out; unsigned char* outb = (unsigned char*)args.out;
    gu32* ctl = (gu32*)(ws + WS_CTL);
    for (int u = tid; u < (LDS_BYTES - RING_BYTES) / 4; u += NWAVES * 64) ((LAS unsigned*)(L + RING_BYTES))[u] = 0u;
    __syncthreads();
    (void)xcd_barrier_post((unsigned*)(ctl + CW_BAR), MISC + 8);
#define GRIDBAR() do { XcdBarrier bar_; bar_.bar = (unsigned*)(ws + WS_CTL) + CW_BAR; bar_.x = xb_xcc_id(); bar_.st = (volatile LAS unsigned*)(L + MISC_OFF) + 8; xcd_barrier(bar_); } while (0)
#define IN(k) (args.ph_lo <= (k) && (k) < args.ph_hi)
#define BOTH(k) (IN(k) && IN((k) + 1))
#define XB ((bf16*)(outb + DO_XB))
#define QC ((bf16*)(outb + DO_QC))
#define WinT ((bf16*)(ws + WS_WIN))
#define WgT ((bf16*)(ws + WS_WG))
#define WmemT ((bf16*)(ws + WS_WMEM))
#define WoutT ((bf16*)(ws + WS_WOUT))
#define Wff1T ((bf16*)(ws + WS_WFF1))
#define Wff2T ((bf16*)(ws + WS_WFF2))
#define MB ((bf16*)(ws + WS_MB))
#define HB ((bf16*)(ws + WS_QKVB + 130 * MiB))
#define FF ((bf16*)(ws + WS_QA))
    if (IN(0)) {
        LAS float* scr = (LAS float*)(L + wave * 16384);
        const int gw = VCU * NWAVES + wave, NGW = GRID_N * NWAVES;
        const float *w_in = args.in[9], *w_mem = args.in[15], *w_out = args.in[16], *w_ff1 = args.in[19], *w_ff2 = args.in[21];
        constexpr int I_IN = 16 * 224, I_AB = 16 * 8, I_G = 16 * 96, I_MEM = 16 * 64, I_OUT = 16 * 32, I_F1 = 16 * 128, I_F2 = 64 * 32;
        constexpr int NITEMS = I_IN + I_AB + I_G + I_MEM + I_OUT + I_F1 + I_F2;
        for (int it = gw; it < NITEMS; it += NGW) {
            int r = it;
            if (r < I_IN) { p0_transpose_item(w_in, 1024, ZW, 0, 7168, WinT, 0, 224, scr, r, lane); continue; } r -= I_IN;
            if (r < I_AB) { p0_transpose_item(w_in, 1024, ZW, 10240, 16, WinT, 7168, 8, scr, r, lane); continue; } r -= I_AB;
            if (r < I_G) { p0_transpose_item(w_in, 1024, ZW, 7168, 3072, WgT, 0, 96, scr, r, lane); continue; } r -= I_G;
            if (r < I_MEM) { p0_transpose_item(w_mem, 1024, 2048, 0, 2048, WmemT, 0, 64, scr, r, lane); continue; } r -= I_MEM;
            if (r < I_OUT) { p0_transpose_item(w_out, 1024, 1024, 0, 1024, WoutT, 0, 32, scr, r, lane); continue; } r -= I_OUT;
            if (r < I_F1) { p0_transpose_item(w_ff1, 1024, 4096, 0, 4096, Wff1T, 0, 128, scr, r, lane); continue; } r -= I_F1;
            p0_transpose_item(w_ff2, 4096, 1024, 0, 1024, Wff2T, 0, 32, scr, r, lane);
        }
        for (int m = gw; m < R_ALL + 4096; m += NGW) {
            if (m < R_P) cvt_row_bf16(args.in[0] + (size_t)m * 1024, XB + (size_t)m * 1024, lane);
            else if (m < R_ALL) cvt_row_bf16(args.in[1] + (size_t)(m - R_P) * 1024, XB + (size_t)m * 1024, lane);
            else cvt_row_bf16(args.in[8] + (size_t)(m - R_ALL) * 1024, MB + (size_t)(m - R_ALL) * 1024, lane);
        }
        if (BOTH(0)) GRIDBAR();
    }
    if (IN(1)) {
        pg8::Gemm g{XB, WinT, R_ALL, 7424, 1024, MB, WmemT};
        P1Order S; S.G = GRID_N; S.c = BLK_X;
        EpiP1 E{ws, out};
        pg8::gemm_phase<EpiP1, P1Order, true, true, 1024>(L, g, S, E);
        if (BOTH(1)) GRIDBAR();
    }
    if (IN(2)) {
        constexpr int Q_GP = 128, Q_C = Q_GP + 512, Q_A = Q_C + 2048, Q_GS = Q_A + 256, Q_SA = Q_GS + 512, Q_SC = Q_SA + 128;
        volatile LAS int* qslot = (volatile LAS int*)(L + MISC_OFF);
        for (;;) {
            if (threadIdx.x == 0) qslot[0] = (int)__hip_atomic_fetch_add(ctl + CW_QUEUE, 1u, __ATOMIC_RELAXED, __HIP_MEMORY_SCOPE_AGENT);
            __syncthreads();
            const int it = __builtin_amdgcn_readfirstlane(qslot[0]);
            __syncthreads();
            if (it >= Q_SC) break;
            if (it < Q_GP) { const int b = it >> 3, h = it & 7;
                gdn::gdn_unit(L, (const bf16*)(ws + WS_QKVB), (bf16*)(ws + WS_QKVB), (const float*)(ws + WS_AB), (long)b * 2048, h, 32, 64, args.in[10], args.in[11], args.in[12], args.in[13], nullptr, nullptr,
                              out + O_SSMP + ((size_t)b * 8 + h) * 16384);
            } else if (it < Q_C) { const int u = it - Q_GP;
                att::attnC_unit(u >> 5, (u >> 3) & 3, u & 7, (bf16*)(outb + DO_QC), (const bf16*)(ws + WS_MK), (const bf16*)(ws + WS_MV), L);
            } else if (it < Q_A) { const int u = it - Q_C, bh = u >> 3;
                att::attnA_unit(bh >> 4, bh & 15, u & 7, (bf16*)(ws + WS_QA), (const bf16*)(ws + WS_KA), (const bf16*)(ws + WS_VA), args.in[14], L);
            } else if (it < Q_GS) { const int u = it - Q_A, b = u >> 3, h = u & 7;
                gdn::gdn_unit(L, (const bf16*)(ws + WS_QKVB), (bf16*)(ws + WS_QKVB), (const float*)(ws + WS_AB), (long)R_P + b * 16, h, 1, 16, args.in[10], args.in[11], args.in[12], args.in[13],
                              args.in[4] + (size_t)b * 3 * 3072, args.in[5] + ((size_t)b * 8 + h) * 16384, out + O_SSMS + ((size_t)b * 8 + h) * 16384);
            } else if (it < Q_SA) { const int u = it - Q_GS, b = u >> 4, h = u & 15; const size_t r0 = (size_t)(R_P + b * 16) * 1024 + h * 64;
                satt::sattn_unit<64, 64>(L, (bf16*)(ws + WS_QA) + r0, args.in[2] + (size_t)b * 512 * 1024 + h * 64, args.in[3] + (size_t)b * 512 * 1024 + h * 64, 512,
                                         (const bf16*)(ws + WS_KA) + r0, (const bf16*)(ws + WS_VA) + r0, 16, args.in[14] + h * 257,
                                         out + O_AKS + (size_t)b * 512 * 1024 + h * 64, out + O_AVS + (size_t)b * 512 * 1024 + h * 64);
            } else { const int u = it - Q_SA, b = u >> 2, h = u & 3; const size_t r0 = (size_t)(R_P + b * 16) * 1024 + h * 256;
                satt::sattn_unit<256, 32>(L, (bf16*)(outb + DO_QC) + r0, args.in[6] + (size_t)b * 256 * 1024 + h * 256, args.in[7] + (size_t)b * 256 * 1024 + h * 256, 256,
                                          nullptr, nullptr, 0, nullptr, nullptr, nullptr);
            }
        }
        if (BOTH(2)) GRIDBAR();
    }
    if (IN(3)) {
        pg8::Gemm g{XB, WgT, R_ALL, 3072, 1024, XB, WgT};
        P3Order S; S.G = GRID_N; S.c = BLK_X;
        EpiGate E{ws, out};
        pg8::gemm_phase<EpiGate, P3Order, true, true, 1024>(L, g, S, E);
        if (BOTH(3)) GRIDBAR();
    }
    if (IN(4)) {
        pg8::Gemm g{(const bf16*)(ws + WS_KA), WoutT, R_ALL, 1024, 1024, (const bf16*)(ws + WS_KA), WoutT};
        pg8::StaticOrder S; S.init(R_ALL, 1024, GRID_N, BLK_X);
        EpiResF32 E{args.in[0], args.in[1], out, nullptr};
        pg8::gemm_phase<EpiResF32, pg8::StaticOrder, true, true, 1024>(L, g, S, E);
        if (BOTH(4)) GRIDBAR();
    }
    if (IN(5)) {
        const int gw = VCU * NWAVES + wave, NGW = GRID_N * NWAVES;
        for (int m = gw; m < R_ALL; m += NGW) ln_row(out + (size_t)m * 1024, args.in[17], args.in[18], HB + (size_t)m * 1024, lane);
        if (BOTH(5)) GRIDBAR();
    }
    if (IN(6)) {
        pg8::Gemm g{HB, Wff1T, R_ALL, 4096, 1024, HB, Wff1T};
        pg8::StaticOrder S; S.init(R_ALL, 4096, GRID_N, BLK_X);
        EpiFf1 E{FF, args.in[20]};
        pg8::gemm_phase<EpiFf1, pg8::StaticOrder, true, true, 1024>(L, g, S, E);
        if (BOTH(6)) GRIDBAR();
    }
    if (IN(7)) {
        pg8::Gemm g{FF, Wff2T, R_ALL, 1024, 4096, FF, Wff2T};
        pg8::StaticOrder S; S.init(R_ALL, 1024, GRID_N, BLK_X);
        EpiResF32 E{out, out + (size_t)R_P * 1024, out, args.in[22]};
        pg8::gemm_phase<EpiResF32, pg8::StaticOrder, true, true, 4096>(L, g, S, E);
        if (BOTH(7)) GRIDBAR();
    }
    if (IN(8)) {
        const int gw = VCU * NWAVES + wave, NGW = GRID_N * NWAVES;
        for (int m = gw; m < R_ALL; m += NGW) ln_row(out + (size_t)m * 1024, args.in[23], args.in[24], nullptr, lane);
    }
#undef IN
#undef BOTH
}
extern "C" void kernel_launch(void* const* d_in, const int* in_sizes, int n_in, void* d_out, int out_size, void* d_ws, size_t ws_size, hipStream_t stream) {
    (void)in_sizes; (void)n_in; (void)out_size;
    static int inited = 0;
    if (!inited) { if (hipFuncSetAttribute((const void*)mega_fwd, hipFuncAttributeMaxDynamicSharedMemorySize, LDS_BYTES) != hipSuccess) fprintf(stderr, "hipFuncSetAttribute failed\n"); inited = 1; }
    if (ws_size < WS_END) { fprintf(stderr, "kernel_launch: workspace too small (%zu < %zu)\n", ws_size, (size_t)WS_END); return; }
    unsigned char* ws = (unsigned char*)d_ws;
    (void)hipMemsetAsync(ws + WS_CTL, 0, CTL_ZERO_BYTES, stream);
    Args a{}; for (int i = 0; i < 25; ++i) a.in[i] = (const float*)d_in[i];
    a.out = (float*)d_out; a.ws = ws; a.ph_lo = 0; a.ph_hi = 9;
    hipLaunchKernelGGL(mega_fwd, dim3(256), dim3(NWAVES * 64), LDS_BYTES, stream, a);
}
```

```cpp
#include <hip/hip_runtime.h>
#include <cstdio>
#include <cstdint>

constexpr int DM = 1024, BATCH = 16, SEQ = 2048, DEC_B = 32, DEC_T = 16, PAST = 1024;
constexpr int CHUNK = 64, AH = 16, AHD = 64, AWIN = 512, ABAND = 576, ACLIP = 128;
constexpr int BH = 8, BHD = 128, MEMT = 256, CH = 4, CHD = 256, DFF = 4096;
constexpr int ZW = 10256;
constexpr int ZQ_A = 0, ZK_A = 1024, ZV_A = 2048, ZB = 3072, ZQ_C = 6144, ZG = 7168, ZA_B = 10240, ZB_B = 10248;
constexpr float DN_ALPHA = 1.189207115002721f;
constexpr float LN_EPS = 1e-5f, RMS_EPS = 1e-6f, L2_EPS = 1e-6f;

constexpr size_t O_YP = 0, O_YS = 33554432, O_AKP = 34078720, O_AVP = 42467328, O_CONVP = 50855936, O_SSMP = 51003392,
                 O_MKP = 53100544, O_MVP = 57294848, O_AKS = 61489152, O_AVS = 78266368, O_CONVS = 95043584, O_SSMS = 95338496;

namespace pg8 {
#define PG8_LAS __attribute__((address_space(3)))
typedef unsigned short bf16_t;
typedef short bf16x8 __attribute__((ext_vector_type(8)));
typedef float f32x4 __attribute__((ext_vector_type(4)));
typedef unsigned u32x4 __attribute__((ext_vector_type(4)));
constexpr int BM = 256, BK = 64, HALF = 128, HTB = HALF * BK * 2  , STAGE_BYTES = 8 * HTB, NXCD = 8, WGM = 8;

__host__ __device__ __forceinline__ int lds_byte(int r, int c) { const int st = (r >> 4) * 2 + (c >> 5), rr = r & 15, cc = c & 31, ob = rr * 64 + cc * 2; return st * 1024 + (ob ^ (((ob >> 9) & 1) << 5)); }
__host__ __device__ __forceinline__ void stage_rc(int b, int& R, int& C) { const int st = b / 1024, sb = b % 1024, swz = sb ^ (((sb >> 9) & 1) << 5); R = (st >> 1) * 16 + swz / 64; C = (st & 1) * 32 + (swz % 64) / 2; }
__host__ __device__ __forceinline__ int perm32(int rho) { const int n = rho >> 4, i = rho & 15; return 8 * (i >> 2) + 4 * n + (i & 3); }

struct Unit { int pm, pn, job; };
struct Gemm { const bf16_t* A; const bf16_t* Bt; int M, N, K; const bf16_t* A1; const bf16_t* Bt1; };

struct StaticOrder {
    int nM, nN, nwg, G, c;
    __host__ __device__ void init(int M, int N, int G_, int c_) { nM = M / BM; nN = N / BM; nwg = nM * nN; G = G_; c = c_; }
    __host__ __device__ __forceinline__ bool next(int i, Unit& u) const {
        const long L = (long)i * G + c; if (L >= nwg) return false;
        int wgid = (int)L; { const int q = nwg / NXCD, r = nwg % NXCD, xcd = wgid % NXCD, off = wgid / NXCD; wgid = (xcd < r ? xcd * (q + 1) : r * (q + 1) + (xcd - r) * q) + off; }
        const int nig = WGM * nN, gid = wgid / nig, fm = gid * WGM, gsz = (nM - fm) < WGM ? (nM - fm) : WGM;
        u.pm = fm + ((wgid % nig) % gsz); u.pn = (wgid % nig) / gsz; u.job = 0; return true;
    }
    __device__ __forceinline__ void a_ready(const Unit&) const {}
    __device__ __forceinline__ void done(const Unit&) const {}
};

__device__ __forceinline__ unsigned cvt_pk_bf16(float lo, float hi) { unsigned r; asm volatile("v_cvt_pk_bf16_f32 %0, %1, %2" : "=v"(r) : "v"(lo), "v"(hi)); return r; }
template <class Epi, class Sched, bool ALIGN_EPI = false, bool SP2 = false, int KC = 0>
__device__ __forceinline__ void gemm_phase(PG8_LAS unsigned char* lds, const Gemm g, const Sched& S, const Epi& E) {
    int tid_ = threadIdx.x; asm volatile("" : "+v"(tid_));
    const int tid = tid_, wid = __builtin_amdgcn_readfirstlane(tid >> 6), lane = tid & 63, wr = wid >> 2, wc = wid & 3, fr = lane & 15, fq = lane >> 4;
    const int K = KC ? KC : g.K, nt = K / BK;
    unsigned voffA[2], voffB[2];
#pragma unroll
    for (int i = 0; i < 2; ++i) { int R, C; stage_rc(tid * 16 + i * 8192, R, C); const int Rb = Epi::PERM ? ((R & ~31) + perm32(R & 31)) : R;
        voffA[i] = (unsigned)(R * K + C) * 2u; voffB[i] = (unsigned)(Rb * K + C) * 2u; }
    const size_t kstep = (size_t)(BK * 2);
    const size_t hstep = (size_t)HALF * K * 2;
    const size_t tstep = 2 * hstep;
    const unsigned ldsw = (unsigned)wid * 1024u;
    const int aoff = lds_byte(wr * 64 + fr, fq * 8), boff = lds_byte(wc * 32 + fr, fq * 8);
#define PG8_SA(b, h) (((b) * 2 + (h)) * HTB)
#define PG8_SB(b, h) ((4 + (b) * 2 + (h)) * HTB)
#define PG8_STAGE(bufoff, gbase, voff) do { _Pragma("unroll") for (int _i = 0; _i < 2; ++_i) \
        __builtin_amdgcn_global_load_lds((const unsigned*)((const char*)(gbase) + (voff)[_i]), (PG8_LAS unsigned*)(lds + (bufoff) + ldsw + _i * 8192), 16, 0, 0); } while (0)
#define PG8_LDA(dst, b, h) do { _Pragma("unroll") for (int m = 0; m < 4; ++m) _Pragma("unroll") for (int k = 0; k < 2; ++k) dst[m][k] = *(const PG8_LAS bf16x8*)(lds + PG8_SA(b, h) + aoff + m * 2048 + k * 1024); } while (0)
#define PG8_LDB(dst, b, h) do { _Pragma("unroll") for (int n = 0; n < 2; ++n) _Pragma("unroll") for (int k = 0; k < 2; ++k) dst[n][k] = *(const PG8_LAS bf16x8*)(lds + PG8_SB(b, h) + boff + n * 2048 + k * 1024); } while (0)
#define PG8_MMA(ai, bj, At, Bt) do { __builtin_amdgcn_s_setprio(1); _Pragma("unroll") for (int m = 0; m < 4; ++m) _Pragma("unroll") for (int n = 0; n < 2; ++n) _Pragma("unroll") for (int k = 0; k < 2; ++k) \
        acc[ai][bj][m][n] = __builtin_amdgcn_mfma_f32_16x16x32_bf16(Bt[n][k], At[m][k], acc[ai][bj][m][n], 0, 0, 0); __builtin_amdgcn_s_setprio(0); } while (0)
#define PG8_WAIT_V(n) asm volatile("s_waitcnt vmcnt(" #n ")" ::: "memory")
#define PG8_WAIT_L(n) asm volatile("s_waitcnt lgkmcnt(" #n ")" ::: "memory")
#define PG8_BAR __builtin_amdgcn_s_barrier()
#define PG8_SCHED __builtin_amdgcn_sched_barrier(0)
    Unit cur, nxt; int ui = 0;
    if (!S.next(0, cur)) return;
    f32x4 acc[2][2][4][2];
#pragma unroll
    for (int a = 0; a < 2; ++a)
#pragma unroll
        for (int b = 0; b < 2; ++b)
#pragma unroll
            for (int m = 0; m < 4; ++m)
#pragma unroll
                for (int n = 0; n < 2; ++n) acc[a][b][m][n] = (f32x4){0.f, 0.f, 0.f, 0.f};
    bf16x8 At[4][2], B0[2][2], B1[2][2];
    const char* cA = (const char*)(cur.job ? g.A1 : g.A) + (size_t)cur.pm * tstep; const char* cB = (const char*)(cur.job ? g.Bt1 : g.Bt) + (size_t)cur.pn * tstep;
    S.a_ready(cur);
    if constexpr (SP2) {
        PG8_STAGE(PG8_SB(0, 0), cB, voffB); PG8_STAGE(PG8_SB(0, 1), cB + hstep, voffB); PG8_STAGE(PG8_SA(0, 0), cA, voffA); PG8_STAGE(PG8_SA(0, 1), cA + hstep, voffA);
        if (wr == 1) PG8_BAR;
        PG8_WAIT_V(2); PG8_BAR;
        PG8_STAGE(PG8_SB(1, 0), cB + kstep, voffB); PG8_STAGE(PG8_SA(1, 0), cA + kstep, voffA); PG8_STAGE(PG8_SB(1, 1), cB + hstep + kstep, voffB);
        PG8_WAIT_V(6); PG8_BAR;
    } else {
        PG8_STAGE(PG8_SB(0, 0), cB, voffB); PG8_STAGE(PG8_SA(0, 0), cA, voffA); PG8_STAGE(PG8_SB(0, 1), cB + hstep, voffB); PG8_STAGE(PG8_SA(0, 1), cA + hstep, voffA);
        if (wr == 1) PG8_BAR;
        PG8_WAIT_V(4); PG8_BAR;
        PG8_STAGE(PG8_SB(1, 0), cB + kstep, voffB); PG8_STAGE(PG8_SA(1, 0), cA + kstep, voffA); PG8_STAGE(PG8_SB(1, 1), cB + hstep + kstep, voffB);
        PG8_WAIT_V(6); PG8_BAR;
    }
    for (;;) {
        const bool has_next = S.next(ui + 1, nxt);
        const char* nA = has_next ? (const char*)(nxt.job ? g.A1 : g.A) + (size_t)nxt.pm * tstep : cA; const char* nB = has_next ? (const char*)(nxt.job ? g.Bt1 : g.Bt) + (size_t)nxt.pn * tstep : cB;
        for (int t = 0; t < nt; t += 2) {
            const bool last = (t == nt - 2);
            const char* a1 = cA + (size_t)(t + 1) * kstep;
            const char* a2 = last ? nA : cA + (size_t)(t + 2) * kstep; const char* b2 = last ? nB : cB + (size_t)(t + 2) * kstep;
            const char* a3 = a2 + kstep; const char* b3 = b2 + kstep;
            if (last && has_next) S.a_ready(nxt);
            if constexpr (SP2) {
            PG8_LDB(B0, 0, 0); PG8_LDB(B1, 0, 1); PG8_SCHED; PG8_LDA(At, 0, 0); PG8_STAGE(PG8_SA(1, 1), a1 + hstep, voffA);
            PG8_WAIT_V(8); PG8_WAIT_L(0); PG8_BAR; PG8_MMA(0, 0, At, B0); PG8_MMA(0, 1, At, B1); PG8_BAR; PG8_SCHED;
            PG8_LDA(At, 0, 1); PG8_STAGE(PG8_SB(0, 0), b2, voffB); PG8_STAGE(PG8_SB(0, 1), b2 + hstep, voffB); PG8_STAGE(PG8_SA(0, 0), a2, voffA);
            PG8_WAIT_V(8); PG8_WAIT_L(0); PG8_BAR; PG8_MMA(1, 0, At, B0); PG8_MMA(1, 1, At, B1); PG8_BAR; PG8_SCHED;
            PG8_LDB(B0, 1, 0); PG8_LDB(B1, 1, 1); PG8_SCHED; PG8_LDA(At, 1, 0); PG8_STAGE(PG8_SA(0, 1), a2 + hstep, voffA);
            PG8_WAIT_V(8); PG8_WAIT_L(0); PG8_BAR; PG8_MMA(0, 0, At, B0); PG8_MMA(0, 1, At, B1); PG8_BAR; PG8_SCHED;
            PG8_LDA(At, 1, 1); PG8_STAGE(PG8_SB(1, 0), b3, voffB); PG8_STAGE(PG8_SB(1, 1), b3 + hstep, voffB); PG8_STAGE(PG8_SA(1, 0), a3, voffA);
            PG8_WAIT_V(8); PG8_WAIT_L(0); PG8_BAR; PG8_MMA(1, 0, At, B0); PG8_MMA(1, 1, At, B1); PG8_BAR; PG8_SCHED;
            } else {
            PG8_LDB(B0, 0, 0); PG8_SCHED; PG8_LDA(At, 0, 0); PG8_STAGE(PG8_SA(1, 1), a1 + hstep, voffA);
            PG8_WAIT_L(8); PG8_BAR; PG8_WAIT_L(0); PG8_MMA(0, 0, At, B0); PG8_BAR; PG8_SCHED;
            PG8_LDB(B1, 0, 1); PG8_STAGE(PG8_SB(0, 0), b2, voffB);
            PG8_BAR; PG8_WAIT_L(0); PG8_MMA(0, 1, At, B1); PG8_BAR;
            PG8_LDA(At, 0, 1); PG8_STAGE(PG8_SA(0, 0), a2, voffA);
            PG8_BAR; PG8_WAIT_L(0); PG8_MMA(1, 0, At, B0); PG8_BAR; PG8_SCHED;
            PG8_STAGE(PG8_SB(0, 1), b2 + hstep, voffB);
            PG8_WAIT_V(6); PG8_BAR; PG8_MMA(1, 1, At, B1); PG8_BAR;
            PG8_LDB(B0, 1, 0); PG8_SCHED; PG8_LDA(At, 1, 0); PG8_STAGE(PG8_SA(0, 1), a2 + hstep, voffA);
            PG8_WAIT_L(8); PG8_BAR; PG8_WAIT_L(0); PG8_MMA(0, 0, At, B0); PG8_BAR; PG8_SCHED;
            PG8_LDB(B1, 1, 1); PG8_STAGE(PG8_SB(1, 0), b3, voffB);
            PG8_BAR; PG8_WAIT_L(0); PG8_MMA(0, 1, At, B1); PG8_BAR;
            PG8_LDA(At, 1, 1); PG8_STAGE(PG8_SA(1, 0), a3, voffA);
            PG8_BAR; PG8_WAIT_L(0); PG8_MMA(1, 0, At, B0); PG8_BAR; PG8_SCHED;
            PG8_STAGE(PG8_SB(1, 1), b3 + hstep, voffB);
            PG8_WAIT_V(6); PG8_BAR; PG8_MMA(1, 1, At, B1); PG8_BAR;
            }
        }
        if constexpr (ALIGN_EPI) { if (wr == 0) PG8_BAR; }
        if constexpr (!Epi::AFTER_DRAIN) { E(acc, cur, wr, wc, fr, fq); S.done(cur); }
        if (!has_next) break;
#pragma unroll
        for (int a = 0; a < 2; ++a)
#pragma unroll
            for (int b = 0; b < 2; ++b)
#pragma unroll
                for (int m = 0; m < 4; ++m)
#pragma unroll
                    for (int n = 0; n < 2; ++n) acc[a][b][m][n] = (f32x4){0.f, 0.f, 0.f, 0.f};
        cur = nxt; cA = nA; cB = nB; ++ui;
        if constexpr (ALIGN_EPI) { if (wr == 1) PG8_BAR; }
    }
    PG8_WAIT_V(0);
    if constexpr (!ALIGN_EPI) { if (wr == 0) PG8_BAR; }
    PG8_BAR;
    if constexpr (Epi::AFTER_DRAIN) { E.fused(acc, cur, wr, wc, fr, fq, lds, wid, lane); S.done(cur); }
#undef PG8_SA
#undef PG8_SB
#undef PG8_STAGE
#undef PG8_LDA
#undef PG8_LDB
#undef PG8_MMA
#undef PG8_WAIT_V
#undef PG8_WAIT_L
#undef PG8_BAR
#undef PG8_SCHED
}
}
#define GAS __attribute__((address_space(1)))
#define LAS __attribute__((address_space(3)))
typedef unsigned short bf16;
typedef unsigned v4u __attribute__((ext_vector_type(4)));
typedef float f32x4 __attribute__((ext_vector_type(4)));
typedef short bf16x8 __attribute__((ext_vector_type(8)));
typedef GAS unsigned gu32;
typedef GAS unsigned long long gu64;
#define RLX_AGENT __ATOMIC_RELAXED, __HIP_MEMORY_SCOPE_AGENT
#define LDS_WAIT() asm volatile("s_waitcnt lgkmcnt(0)" ::: "memory")
#define VM_WAIT() asm volatile("s_waitcnt vmcnt(0)" ::: "memory")
__device__ __forceinline__ unsigned long long rt() { return __builtin_amdgcn_s_memrealtime(); }
__device__ __forceinline__ unsigned f2bf(float f) { unsigned u = __builtin_bit_cast(unsigned, f); return (u + 0x7fffu + ((u >> 16) & 1u)) >> 16; }
__device__ __forceinline__ unsigned pk2(float lo, float hi) { return f2bf(lo) | (f2bf(hi) << 16); }

#define XB_TMO      128
#define XB_XCNT(j)  (256  + 64 * (j))
#define XB_XSUB(j)  (1280 + 64 * (j))
#define XB_XGEN(j)  (2304 + 64 * (j))
#define XB_TOP      3328
#define XB_TOPGEN   3392
#define XCD_BAR_WORDS 3456
#define XB_SPIN_CAP (1u << 18)

__device__ __forceinline__ unsigned xb_ld(unsigned* p)              { return __hip_atomic_load(p, __ATOMIC_RELAXED, __HIP_MEMORY_SCOPE_AGENT); }
__device__ __forceinline__ unsigned xb_add(unsigned* p, unsigned v) { return __hip_atomic_fetch_add(p, v, __ATOMIC_RELAXED, __HIP_MEMORY_SCOPE_AGENT); }
__device__ __forceinline__ unsigned xb_xcc_id() { return (unsigned)__builtin_amdgcn_s_getreg((3 << 11) | 20) & 0xFu; }
#define XB_SPIN(cond, bar) do { unsigned _sp = 0; while (cond) { __builtin_amdgcn_s_sleep(1); \
    if ((++_sp & 255u) == 0u) { if (xb_ld(&(bar)[XB_TMO])) break; if (_sp > XB_SPIN_CAP) { atomicAdd(&(bar)[XB_TMO], 1u); break; } } } } while (0)

struct XcdBarrier {
    unsigned* bar; unsigned x;
    volatile LAS unsigned* st;
};

__device__ __forceinline__ XcdBarrier xcd_barrier_post(unsigned* bar, volatile LAS unsigned* st) {
    XcdBarrier b; b.bar = bar; b.x = xb_xcc_id(); b.st = st;
    if (threadIdx.x == 0) (void)xb_add(&bar[XB_XCNT(b.x)], 1u);
    return b;
}
__device__ __forceinline__ void xcd_barrier_complete(unsigned* bar, unsigned x, unsigned& nloc, unsigned& nx) {
    const unsigned G = gridDim.x * gridDim.y * gridDim.z;
    unsigned sum, cnt, mine, sp = 0u;
    for (;;) {
        sum = 0u; cnt = 0u; mine = 0u;
#pragma unroll
        for (unsigned j = 0; j < 16; ++j) { const unsigned c = xb_ld(&bar[XB_XCNT(j)]); sum += c; cnt += (c > 0u) ? 1u : 0u; mine = (j == x) ? c : mine; }
        if (sum == G) break;
        __builtin_amdgcn_s_sleep(1);
        if ((++sp & 255u) == 0u) { if (xb_ld(&bar[XB_TMO])) break; if (sp > XB_SPIN_CAP) { atomicAdd(&bar[XB_TMO], 1u); break; } }
    }
    nloc = mine > 0u ? mine : 1u; nx = cnt > 0u ? cnt : 1u;
}

__device__ __forceinline__ void xcd_barrier(const XcdBarrier& b) {
    asm volatile("s_waitcnt vmcnt(0)" ::: "memory");
    __syncthreads();
    if (threadIdx.x == 0) {
        unsigned* bar = b.bar;
        __builtin_amdgcn_s_waitcnt(0);
        unsigned nloc = b.st[0], nx = b.st[1];
        if (nloc == 0u) { xcd_barrier_complete(bar, b.x, nloc, nx); b.st[0] = nloc; b.st[1] = nx; }
        const unsigned old = xb_add(&bar[XB_XSUB(b.x)], 1u);
        const unsigned gen = old / nloc;
        if (old + 1u == (gen + 1u) * nloc) {
            __builtin_amdgcn_fence(__ATOMIC_RELEASE, "agent");
            asm volatile("s_waitcnt vmcnt(0)" ::: "memory");
            const unsigned og = xb_add(&bar[XB_TOP], 1u);
            const unsigned tg = og / nx;
            if (og + 1u == (tg + 1u) * nx) xb_add(&bar[XB_TOPGEN], 1u);
            else XB_SPIN(xb_ld(&bar[XB_TOPGEN]) == tg, bar);
            __builtin_amdgcn_fence(__ATOMIC_ACQUIRE, "agent");
            xb_add(&bar[XB_XGEN(b.x)], 1u);
            asm volatile("s_waitcnt vmcnt(0)" ::: "memory");
        } else {
            XB_SPIN(xb_ld(&bar[XB_XGEN(b.x)]) == gen, bar);
            __builtin_amdgcn_fence(__ATOMIC_ACQUIRE, "agent");
            asm volatile("s_waitcnt vmcnt(0)" ::: "memory");
        }
    }
    __syncthreads();
}
constexpr float C2A = 0.125f * 1.4426950408889634f, C2C = 0.0625f * 1.4426950408889634f, LOG2E = 1.4426950408889634f;
namespace att {
typedef short bf16x8 __attribute__((ext_vector_type(8)));
typedef short s16x4 __attribute__((ext_vector_type(4)));
typedef float f32x16 __attribute__((ext_vector_type(16)));
typedef unsigned u32x4 __attribute__((ext_vector_type(4)));
typedef LAS const char* lds_cptr;
#define ATT_SBAR() __builtin_amdgcn_sched_barrier(0)
#define ATT_WAIT_BAR(N) asm volatile("s_waitcnt vmcnt(" #N ") lgkmcnt(0)\n\ts_barrier" ::: "memory")
__device__ __forceinline__ int crow(int r, int hi) { return (r & 3) + 8 * (r >> 2) + 4 * hi; }
__device__ __forceinline__ void glds16(const void* gsrc, unsigned lds_dst) { unsigned keep;
    asm volatile("s_mov_b32 %0, m0\n\ts_mov_b32 m0, %2\n\ts_nop 0\n\tglobal_load_lds_dwordx4 %1, off\n\ts_mov_b32 m0, %0" : "=&s"(keep) : "v"(gsrc), "s"(lds_dst) : "memory"); }
__device__ __forceinline__ float max3f(float a, float b, float c) { float r; asm("v_max3_f32 %0, %1, %2, %3" : "=v"(r) : "v"(a), "v"(b), "v"(c)); return r; }
typedef float f32x2_t __attribute__((ext_vector_type(2))); typedef __bf16 bf16x2_t __attribute__((ext_vector_type(2)));
__device__ __forceinline__ unsigned cvtpk_s(float lo, float hi) { f32x2_t v = {lo, hi}; bf16x2_t b = __builtin_convertvector(v, bf16x2_t); return __builtin_bit_cast(unsigned, b); }
template <int NKS, int CHUNK_STRIDE>
__device__ __forceinline__ void qkt(f32x16& p0, f32x16& p1, lds_cptr Kslot, const bf16x8* qr, const f32x16& c0, int r32, int hi) {
    lds_cptr kb = Kslot + hi * CHUNK_STRIDE + r32 * 16;
    p0 = c0; p1 = c0;
#pragma unroll
    for (int d0 = 0; d0 < NKS; ++d0) {
        const bf16x8 b0 = *(const LAS bf16x8*)(kb + d0 * 2 * CHUNK_STRIDE);
        const bf16x8 b1 = *(const LAS bf16x8*)(kb + d0 * 2 * CHUNK_STRIDE + 512);
        p0 = __builtin_amdgcn_mfma_f32_32x32x16_bf16(b0, qr[d0], p0, 0, 0, 0);
        p1 = __builtin_amdgcn_mfma_f32_32x32x16_bf16(b1, qr[d0], p1, 0, 0, 0);
    }
}
__device__ __forceinline__ float rowmax(const f32x16& p0, const f32x16& p1) {
    float a = max3f(p0[0], p0[1], p1[0]), b = max3f(p0[2], p0[3], p1[1]); a = max3f(a, p1[2], p1[3]);
#pragma unroll
    for (int r = 4; r < 16; r += 4) { a = max3f(a, p0[r], p0[r + 1]); b = max3f(b, p0[r + 2], p0[r + 3]); a = max3f(a, p1[r], p1[r + 1]); b = max3f(b, p1[r + 2], p1[r + 3]); }
    const float m = fmaxf(a, b);
    auto rr = __builtin_amdgcn_permlane32_swap(__float_as_uint(m), __float_as_uint(m), false, false);
    return fmaxf(__uint_as_float(rr[0]), __uint_as_float(rr[1]));
}
template <int ND>
__device__ __forceinline__ void pv(f32x16* o, int vb, bf16x8 pa0, bf16x8 pa1, bf16x8 pa2, bf16x8 pa3) {
#pragma unroll
    for (int d0 = 0; d0 < ND; ++d0) { s16x4 lo[4], hi[4];
#pragma unroll
        for (int ks = 0; ks < 4; ++ks) {
            asm volatile("ds_read_b64_tr_b16 %0,%1 offset:%c2" : "=&v"(lo[ks]) : "v"(vb), "i"(d0 * 4096 + ks * 1024) : "memory");
            asm volatile("ds_read_b64_tr_b16 %0,%1 offset:%c2" : "=&v"(hi[ks]) : "v"(vb), "i"(d0 * 4096 + ks * 1024 + 512) : "memory"); }
        asm volatile("s_waitcnt lgkmcnt(0)" ::: "memory"); ATT_SBAR();
#define ATT_PK(k) (bf16x8){lo[k][0], lo[k][1], lo[k][2], lo[k][3], hi[k][0], hi[k][1], hi[k][2], hi[k][3]}
        o[d0] = __builtin_amdgcn_mfma_f32_32x32x16_bf16(pa0, ATT_PK(0), o[d0], 0, 0, 0);
        o[d0] = __builtin_amdgcn_mfma_f32_32x32x16_bf16(pa1, ATT_PK(1), o[d0], 0, 0, 0);
        o[d0] = __builtin_amdgcn_mfma_f32_32x32x16_bf16(pa2, ATT_PK(2), o[d0], 0, 0, 0);
        o[d0] = __builtin_amdgcn_mfma_f32_32x32x16_bf16(pa3, ATT_PK(3), o[d0], 0, 0, 0);
#undef ATT_PK
    }
}
constexpr int A_K = 0, A_V = 16384, A_WS = 32768, A_BT = 34816, A_OST = 36864, A_BYTES = A_OST + 8 * 4096;
__device__ __forceinline__ void attnA_unit(int b, int h, int qb, bf16* QO, const bf16* KA, const bf16* VA, const float* relb, LAS unsigned char* L) {
    int tid = threadIdx.x; asm volatile("" : "+v"(tid));
    const int lane = tid & 63, r32 = lane & 31, hi = lane >> 5; const int wid = __builtin_amdgcn_readfirstlane(tid >> 6);
    const long rowbase = (long)b * 2048; const int q0 = qb * 256;
    bf16* Qw = QO + (rowbase + q0 + wid * 32) * 1024 + h * 64;
    const bf16 *Kh = KA + rowbase * 1024 + h * 64, *Vh = VA + rowbase * 1024 + h * 64;
    const unsigned lds0 = (unsigned)(uintptr_t)L;
    LAS float* wsf = (LAS float*)(L + A_WS) + wid * 64;
    LAS float* btab = (LAS float*)(L + A_BT);
    const bf16* ksrc = Kh + (long)lane * 1024 + wid * 8;
    const bf16* vsrc = Vh + (long)(16 * (wid & 3) + (lane >> 2)) * 1024 + (wid >> 2) * 32 + (lane & 3) * 8;
    const unsigned kdst = lds0 + A_K + wid * 1024, vdst = lds0 + A_V + wid * 1024;
#define DMA_K(t, slot) glds16(ksrc + (long)(t) * 64 * 1024, (unsigned)__builtin_amdgcn_readfirstlane(kdst + (slot)))
#define DMA_V(t, slot) glds16(vsrc + (long)(t) * 64 * 1024, (unsigned)__builtin_amdgcn_readfirstlane(vdst + (slot)))
    const int vb0 = (int)(lds0 + A_V) + ((lane >> 4) & 1) * 32 + (lane & 3) * 8 + (4 * hi + ((lane & 15) >> 2)) * 64;
    lds_cptr Kbase = (lds_cptr)(L + A_K);
    const int cq = 4 * qb + (wid >> 1), qi = 32 * (wid & 1) + r32;
    const int kc0 = (4 * qb - 8) > 0 ? (4 * qb - 8) : 0, kc1 = 4 * qb + 3;
    for (int i = tid; i < 257; i += 512) btab[i] = relb[h * 257 + i] * LOG2E;
    DMA_K(kc0, 0); DMA_V(kc0, 0);
    bf16x8 qr[4];
#pragma unroll
    for (int d0 = 0; d0 < 4; ++d0) qr[d0] = *reinterpret_cast<const bf16x8*>(&Qw[(long)r32 * 1024 + d0 * 16 + hi * 8]);
    float m_run = -1e30f, l_run = 0.f; f32x16 o[2]; o[0] = f32x16{}; o[1] = f32x16{};
    const f32x16 zero = f32x16{};
    ATT_WAIT_BAR(0);
    for (int kc = kc0; kc <= kc1; ++kc) {
        const int sl = ((kc - kc0) & 1) * 8192;
        if (kc < kc1) { DMA_K(kc + 1, sl ^ 8192); DMA_V(kc + 1, sl ^ 8192); }
        const int dC = cq - kc;
        if (dC >= 0 && dC <= 8) {
            f32x16 p0, p1;
            qkt<4, 1024>(p0, p1, Kbase + sl, qr, zero, r32, hi);
            if (dC >= 3) { const float bfar = btab[256];
#pragma unroll
                for (int r = 0; r < 16; ++r) { p0[r] += bfar; p1[r] += bfar; }
            } else { const int base = 64 * dC + qi + 128;
#pragma unroll
                for (int r = 0; r < 16; ++r) { const int kj = crow(r, hi); int i0 = base - kj, i1 = base - kj - 32; i0 = i0 > 256 ? 256 : i0; i1 = i1 > 256 ? 256 : i1; p0[r] += btab[i0]; p1[r] += btab[i1]; }
            }
            const float rm = rowmax(p0, p1);
            const float mn = fmaxf(m_run, rm);
            const float alpha = __builtin_amdgcn_exp2f(m_run - mn);
            float s = 0.f;
#pragma unroll
            for (int r = 0; r < 16; ++r) { p0[r] = __builtin_amdgcn_exp2f(p0[r] - mn); p1[r] = __builtin_amdgcn_exp2f(p1[r] - mn); s += p0[r] + p1[r]; }
            l_run = l_run * alpha + s; m_run = mn;
            if (__any(alpha != 1.f)) {
                if (hi == 0) wsf[r32] = alpha;
                asm volatile("s_waitcnt lgkmcnt(0)" ::: "memory");
#pragma unroll
                for (int r = 0; r < 16; ++r) { const float f = wsf[crow(r, hi)]; o[0][r] *= f; o[1][r] *= f; }
            }
            u32x4 pw0, pw1, pw2, pw3;
            pw0 = (u32x4){cvtpk_s(p0[0], p0[1]), cvtpk_s(p0[2], p0[3]), cvtpk_s(p0[4], p0[5]), cvtpk_s(p0[6], p0[7])};
            pw1 = (u32x4){cvtpk_s(p0[8], p0[9]), cvtpk_s(p0[10], p0[11]), cvtpk_s(p0[12], p0[13]), cvtpk_s(p0[14], p0[15])};
            pw2 = (u32x4){cvtpk_s(p1[0], p1[1]), cvtpk_s(p1[2], p1[3]), cvtpk_s(p1[4], p1[5]), cvtpk_s(p1[6], p1[7])};
            pw3 = (u32x4){cvtpk_s(p1[8], p1[9]), cvtpk_s(p1[10], p1[11]), cvtpk_s(p1[12], p1[13]), cvtpk_s(p1[14], p1[15])};
            ATT_SBAR();
            pv<2>(o, vb0 + sl, __builtin_bit_cast(bf16x8, pw0), __builtin_bit_cast(bf16x8, pw1), __builtin_bit_cast(bf16x8, pw2), __builtin_bit_cast(bf16x8, pw3));
        }
        ATT_WAIT_BAR(0);
    }
    { auto rr = __builtin_amdgcn_permlane32_swap(__float_as_uint(l_run), __float_as_uint(l_run), false, false); l_run = __uint_as_float(rr[0]) + __uint_as_float(rr[1]); }
    if (hi == 0) wsf[32 + r32] = l_run;
    asm volatile("s_waitcnt lgkmcnt(0)" ::: "memory");
    float rli[16];
#pragma unroll
    for (int r = 0; r < 16; ++r) rli[r] = __builtin_amdgcn_rcpf(wsf[32 + crow(r, hi)]);
    { LAS unsigned short* stg = (LAS unsigned short*)(L + A_OST) + wid * 2048;
#pragma unroll
        for (int r = 0; r < 16; ++r) { const int orow = crow(r, hi);
#pragma unroll
            for (int d0 = 0; d0 < 2; ++d0) stg[orow * 64 + d0 * 32 + r32] = (unsigned short)f2bf(o[d0][r] * rli[r]); }
        asm volatile("s_waitcnt lgkmcnt(0)" ::: "memory");
#pragma unroll
        for (int i = 0; i < 4; ++i) { const int row = i * 8 + (lane >> 3), ch = lane & 7; const u32x4 v = *(const LAS u32x4*)(stg + row * 64 + ch * 8); *(u32x4*)(Qw + (long)row * 1024 + ch * 8) = v; } }
    asm volatile("s_waitcnt lgkmcnt(0)\n\ts_barrier" ::: "memory");
#undef DMA_K
#undef DMA_V
}

constexpr int C_WS = 131072 + 1024;
__device__ __forceinline__ void attnC_unit(int b, int h, int qb, bf16* QO, const bf16* MK, const bf16* MV, LAS unsigned char* L) {
    int tid = threadIdx.x; asm volatile("" : "+v"(tid));
    const int lane = tid & 63, r32 = lane & 31, hi = lane >> 5; const int wid = __builtin_amdgcn_readfirstlane(tid >> 6);
    bf16* Qw = QO + ((long)b * 2048 + qb * 256 + wid * 32) * 1024 + h * 256;
    const bf16 *Kh = MK + (long)b * 256 * 1024 + h * 256, *Vh = MV + (long)b * 256 * 1024 + h * 256;
    const unsigned lds0 = (unsigned)(uintptr_t)L;
    LAS float* wsf = (LAS float*)(L + C_WS) + wid * 64;
#pragma unroll
    for (int j = 0; j < 16; ++j) { const int p = wid * 16 + j;
        glds16(Kh + (long)(64 * (p & 3) + lane) * 1024 + (p >> 2) * 8, (unsigned)__builtin_amdgcn_readfirstlane(lds0 + p * 1024)); }
    const bf16* qp = &Qw[(long)r32 * 1024 + hi * 8];
    bf16x8 qa[4], qb4[4];
#pragma unroll
    for (int i = 0; i < 4; ++i) qa[i] = *reinterpret_cast<const bf16x8*>(qp + i * 16);
    f32x16 S[8];
#pragma unroll
    for (int kt = 0; kt < 8; ++kt) S[kt] = f32x16{};
    ATT_WAIT_BAR(0);
    { lds_cptr kb = (lds_cptr)L + hi * 4096 + r32 * 16;
#define C_GROUP(QF, g) do { _Pragma("unroll") for (int i = 0; i < 4; ++i) { _Pragma("unroll") for (int kt = 0; kt < 8; ++kt) { \
            const bf16x8 kf = *(const LAS bf16x8*)(kb + ((g) * 4 + i) * 8192 + kt * 512); S[kt] = __builtin_amdgcn_mfma_f32_32x32x16_bf16(kf, QF[i], S[kt], 0, 0, 0); } } } while (0)
#pragma unroll
        for (int i = 0; i < 4; ++i) qb4[i] = *reinterpret_cast<const bf16x8*>(qp + (4 + i) * 16);
        C_GROUP(qa, 0);
#pragma unroll
        for (int i = 0; i < 4; ++i) qa[i] = *reinterpret_cast<const bf16x8*>(qp + (8 + i) * 16);
        C_GROUP(qb4, 1);
#pragma unroll
        for (int i = 0; i < 4; ++i) qb4[i] = *reinterpret_cast<const bf16x8*>(qp + (12 + i) * 16);
        C_GROUP(qa, 2);
        C_GROUP(qb4, 3);
#undef C_GROUP
    }
    float mx = -1e30f;
#pragma unroll
    for (int kt = 0; kt < 8; ++kt)
#pragma unroll
        for (int r = 0; r < 16; ++r) mx = fmaxf(mx, S[kt][r]);
    { auto rr = __builtin_amdgcn_permlane32_swap(__float_as_uint(mx), __float_as_uint(mx), false, false); mx = fmaxf(__uint_as_float(rr[0]), __uint_as_float(rr[1])); }
    float l_run = 0.f; bf16x8 pa[16];
#pragma unroll
    for (int kt = 0; kt < 8; ++kt) {
#pragma unroll
        for (int r = 0; r < 16; ++r) { S[kt][r] = __builtin_amdgcn_exp2f(S[kt][r] - mx); l_run += S[kt][r]; }
        const u32x4 w0 = (u32x4){cvtpk_s(S[kt][0], S[kt][1]), cvtpk_s(S[kt][2], S[kt][3]), cvtpk_s(S[kt][4], S[kt][5]), cvtpk_s(S[kt][6], S[kt][7])};
        const u32x4 w1 = (u32x4){cvtpk_s(S[kt][8], S[kt][9]), cvtpk_s(S[kt][10], S[kt][11]), cvtpk_s(S[kt][12], S[kt][13]), cvtpk_s(S[kt][14], S[kt][15])};
        pa[2 * kt] = __builtin_bit_cast(bf16x8, w0); pa[2 * kt + 1] = __builtin_bit_cast(bf16x8, w1);
    }
    ATT_WAIT_BAR(0);
#pragma unroll
    for (int j = 0; j < 16; ++j) { const int p = wid * 16 + j;
        glds16(Vh + (long)(16 * (p & 15) + (lane >> 2)) * 1024 + (p >> 4) * 32 + (lane & 3) * 8, (unsigned)__builtin_amdgcn_readfirstlane(lds0 + p * 1024)); }
    f32x16 o[8];
#pragma unroll
    for (int d0 = 0; d0 < 8; ++d0) o[d0] = f32x16{};
    ATT_WAIT_BAR(0);
    { const int vbA = (int)lds0 + ((lane >> 4) & 1) * 32 + (lane & 3) * 8 + (4 * hi + ((lane & 15) >> 2)) * 64, vbB = vbA + 65536;
#pragma unroll
        for (int s = 0; s < 16; ++s) {
#pragma unroll
            for (int d0 = 0; d0 < 8; ++d0) { s16x4 lo, hh;
                if (d0 < 4) { asm volatile("ds_read_b64_tr_b16 %0,%1 offset:%c2" : "=&v"(lo) : "v"(vbA), "i"((d0 & 3) * 16384 + s * 1024) : "memory");
                              asm volatile("ds_read_b64_tr_b16 %0,%1 offset:%c2" : "=&v"(hh) : "v"(vbA), "i"((d0 & 3) * 16384 + s * 1024 + 512) : "memory"); }
                else        { asm volatile("ds_read_b64_tr_b16 %0,%1 offset:%c2" : "=&v"(lo) : "v"(vbB), "i"((d0 & 3) * 16384 + s * 1024) : "memory");
                              asm volatile("ds_read_b64_tr_b16 %0,%1 offset:%c2" : "=&v"(hh) : "v"(vbB), "i"((d0 & 3) * 16384 + s * 1024 + 512) : "memory"); }
                asm volatile("s_waitcnt lgkmcnt(0)" : "+v"(lo), "+v"(hh) :: "memory"); ATT_SBAR();
                const bf16x8 vf = (bf16x8){lo[0], lo[1], lo[2], lo[3], hh[0], hh[1], hh[2], hh[3]};
                o[d0] = __builtin_amdgcn_mfma_f32_32x32x16_bf16(pa[s], vf, o[d0], 0, 0, 0); } } }
    { auto rr = __builtin_amdgcn_permlane32_swap(__float_as_uint(l_run), __float_as_uint(l_run), false, false); l_run = __uint_as_float(rr[0]) + __uint_as_float(rr[1]); }
    if (hi == 0) wsf[r32] = l_run;
    asm volatile("s_waitcnt lgkmcnt(0)" ::: "memory");
    float rli[16];
#pragma unroll
    for (int r = 0; r < 16; ++r) rli[r] = __builtin_amdgcn_rcpf(wsf[crow(r, hi)]);
    ATT_WAIT_BAR(0);
    { LAS unsigned short* stg = (LAS unsigned short*)L + wid * 8192;
#pragma unroll
        for (int r = 0; r < 16; ++r) { const int orow = crow(r, hi);
#pragma unroll
            for (int d0 = 0; d0 < 8; ++d0) stg[orow * 256 + d0 * 32 + r32] = (unsigned short)f2bf(o[d0][r] * rli[r]); }
        asm volatile("s_waitcnt lgkmcnt(0)" ::: "memory");
#pragma unroll
        for (int i = 0; i < 16; ++i) { const int row = i * 2 + (lane >> 5), ch = lane & 31; const u32x4 v = *(const LAS u32x4*)(stg + row * 256 + ch * 8); *(u32x4*)(Qw + (long)row * 1024 + ch * 8) = v; } }
    asm volatile("s_waitcnt lgkmcnt(0)\n\ts_barrier" ::: "memory");
}
}
namespace satt {
template <int D, int KT>
__device__ __forceinline__ void sattn_unit(LAS unsigned char* L, bf16* QO  , const float* Kc, const float* Vc  , int ncache,
                                           const bf16* Kn, const bf16* Vn  , int nnew, const float* btab  , float* copyK, float* copyV) {
    int tid = threadIdx.x; asm volatile("" : "+v"(tid));
    const int t = tid >> 5, jj = tid & 31;
    LAS float* Ks = (LAS float*)L; LAS float* Vs = Ks + KT * (D + 1); LAS float* Qs = Vs + KT * D; LAS float* Ps = Qs + 16 * D;
    const int nkeys = ncache + nnew, ntiles = (nkeys + KT - 1) / KT;
    __syncthreads();
    for (int i = tid; i < 16 * D; i += 512) Qs[i] = __uint_as_float(((unsigned)QO[(i / D) * 1024 + (i % D)]) << 16);
    float m_run = -1e30f, l_run = 0.f; float o[D / 32];
#pragma unroll
    for (int i = 0; i < D / 32; ++i) o[i] = 0.f;
    for (int tile = 0; tile < ntiles; ++tile) {
        __syncthreads();
        for (int idx = tid; idx < KT * D / 4; idx += 512) {
            const int j = idx / (D / 4), c4 = (idx % (D / 4)) * 4, key = tile * KT + j;
            float4 kv = make_float4(0.f, 0.f, 0.f, 0.f), vv = kv;
            if (key < ncache) { kv = *(const float4*)(Kc + (size_t)key * 1024 + c4); vv = *(const float4*)(Vc + (size_t)key * 1024 + c4);
                if (copyK && key >= 16) { *(float4*)(copyK + (size_t)(key - 16) * 1024 + c4) = kv; *(float4*)(copyV + (size_t)(key - 16) * 1024 + c4) = vv; } }
            else if (key < nkeys) { const uint2 a = *(const uint2*)(Kn + (size_t)(key - ncache) * 1024 + c4), b = *(const uint2*)(Vn + (size_t)(key - ncache) * 1024 + c4);
                kv = make_float4(__uint_as_float(a.x << 16), __uint_as_float(a.x & 0xffff0000u), __uint_as_float(a.y << 16), __uint_as_float(a.y & 0xffff0000u));
                vv = make_float4(__uint_as_float(b.x << 16), __uint_as_float(b.x & 0xffff0000u), __uint_as_float(b.y << 16), __uint_as_float(b.y & 0xffff0000u)); }
            LAS float* kd = Ks + j * (D + 1) + c4; kd[0] = kv.x; kd[1] = kv.y; kd[2] = kv.z; kd[3] = kv.w;
            *(LAS f32x4*)(Vs + j * D + c4) = (f32x4){vv.x, vv.y, vv.z, vv.w};
        }
        __syncthreads();
        float sc[KT / 32]; float tmax = -1e30f;
#pragma unroll
        for (int kk = 0; kk < KT / 32; ++kk) {
            const int j = jj + 32 * kk, key = tile * KT + j; float s = 0.f;
            const LAS float* qp = Qs + t * D; const LAS float* kp = Ks + j * (D + 1);
#pragma unroll 8
            for (int d = 0; d < D; ++d) s += qp[d] * kp[d];
            if (key >= nkeys) s = -1e30f;
            else if (btab) { int dd = 512 + t - key; dd = dd > 128 ? 128 : dd; s += btab[dd + 128] * LOG2E; }
            sc[kk] = s; tmax = fmaxf(tmax, s);
        }
#pragma unroll
        for (int o_ = 1; o_ < 32; o_ <<= 1) tmax = fmaxf(tmax, __shfl_xor(tmax, o_));
        const float mn = fmaxf(m_run, tmax), alpha = __builtin_amdgcn_exp2f(m_run - mn);
        float ps = 0.f;
#pragma unroll
        for (int kk = 0; kk < KT / 32; ++kk) { const float p = (sc[kk] <= -1e29f) ? 0.f : __builtin_amdgcn_exp2f(sc[kk] - mn); Ps[t * KT + jj + 32 * kk] = p; ps += p; }
#pragma unroll
        for (int o_ = 1; o_ < 32; o_ <<= 1) ps += __shfl_xor(ps, o_);
        l_run = l_run * alpha + ps; m_run = mn;
#pragma unroll
        for (int i = 0; i < D / 32; ++i) o[i] *= alpha;
        __syncthreads();
        for (int j = 0; j < KT; ++j) { const float pj = Ps[t * KT + j];
#pragma unroll
            for (int i = 0; i < D / 32; ++i) o[i] += pj * Vs[j * D + jj + 32 * i]; }
    }
    const float rl = 1.f / l_run;
#pragma unroll
    for (int i = 0; i < D / 32; ++i) QO[t * 1024 + jj + 32 * i] = (bf16)f2bf(o[i] * rl);
    __syncthreads();
}
}
namespace gdn {
typedef short bf16x8 __attribute__((ext_vector_type(8)));
typedef short s16x4 __attribute__((ext_vector_type(4)));
typedef float f32x4 __attribute__((ext_vector_type(4)));
typedef unsigned u32x2 __attribute__((ext_vector_type(2)));
typedef unsigned u32x4 __attribute__((ext_vector_type(4)));
constexpr int QN = 0, KN = 17408  , KNT = 34816, VT = 53248  , ABF = 71680, AQK = 80896, DBF = 90112, AD = 92160, ST = 96512,
              GV = 131328, BETA = GV + 256, EGT = GV + 512, EGR = GV + 768, BEG = GV + 1024, CARRY = GV + 1280, RMS = CARRY + 4608, NB = RMS + 1024, G_END = NB + 6144;
constexpr int S272 = 272, S144 = 144;
__device__ __forceinline__ float bf2f(short s) { return __uint_as_float(((unsigned)(unsigned short)s) << 16); }
__device__ __forceinline__ unsigned pk(float lo, float hi) { return att::cvtpk_s(lo, hi); }
__device__ __forceinline__ s16x4 pk4(const f32x4& v) { u32x2 w; w.x = pk(v[0], v[1]); w.y = pk(v[2], v[3]); return __builtin_bit_cast(s16x4, w); }
__device__ __forceinline__ s16x4 pk4n(const f32x4& v) { u32x2 w; w.x = pk(-v[0], -v[1]); w.y = pk(-v[2], -v[3]); return __builtin_bit_cast(s16x4, w); }
#define G_MMA32(a, b, c) __builtin_amdgcn_mfma_f32_16x16x32_bf16(a, b, c, 0, 0, 0)
#define G_MMA16(a, b, c) __builtin_amdgcn_mfma_f32_16x16x16bf16_1k(a, b, c, 0, 0, 0)
#define G_FRAG8(base, stride, row, kb) (*(const LAS bf16x8*)((base) + (row) * (stride) + (kb)))

#define DBG_FLAG(k, cond) do {} while (0)
#define DBG_X(k) do {} while (0)
__device__ __forceinline__ void gdn_unit(LAS unsigned char* L, const bf16* QKVB, bf16* OB, const float* AB, long row0, int h, int nchunks, int nvalid,
                                         const float* alog, const float* dtb, const float* normg, const float* S0, float* Sout, unsigned long long* tsum = nullptr) {
    unsigned long long tacc0 = 0, tacc1 = 0, tacc2 = 0, tacc3 = 0, tacc4 = 0, tlast = 0;
#define GT_MARK(v) do { if (tsum) { const unsigned long long n_ = __builtin_amdgcn_s_memrealtime(); v += n_ - tlast; tlast = n_; } } while (0)
    int tid0 = threadIdx.x; asm volatile("" : "+v"(tid0));
    const int wave = __builtin_amdgcn_readfirstlane(tid0 >> 6), wq = wave & 3; const bool grpA = wave < 4;
    const float alog_h = alog[h], dtb_h = dtb[h];
    LAS float* fGV = (LAS float*)(L + GV); LAS float* fBETA = (LAS float*)(L + BETA); LAS float* fEGT = (LAS float*)(L + EGT); LAS float* fEGR = (LAS float*)(L + EGR); LAS float* fBEG = (LAS float*)(L + BEG);
    LAS float* fRMS = (LAS float*)(L + RMS);
    f32x4 Sreg[8][2];
    u32x4 pfq[2], pfk[2], pfv[2]; float pfa = 0.f, pfb = 0.f;
#define G_ISSUE(cn) do { const long r0_ = row0 + (long)(cn) * 64; _Pragma("unroll") for (int i_ = 0; i_ < 2; ++i_) { const int idx_ = (int)(threadIdx.x) + 512 * i_, row_ = idx_ >> 4, ch_ = idx_ & 15; \
        unsigned z_ = 0u; asm volatile("" : "+v"(z_)); pfq[i_] = (u32x4){z_, z_, z_, z_}; pfk[i_] = pfq[i_]; pfv[i_] = pfq[i_]; \
        if (row_ < nvalid) { const bf16* b_ = QKVB + (r0_ + row_) * 3072 + h * 128 + ch_ * 8; pfq[i_] = *(const u32x4*)b_; pfk[i_] = *(const u32x4*)(b_ + 1024); pfv[i_] = *(const u32x4*)(b_ + 2048); } } \
        if (wave == 0) { const int ln_ = (int)(threadIdx.x) & 63; pfa = 0.f; pfb = 0.f; if (ln_ < nvalid) { const float* ab_ = AB + (r0_ + ln_) * 16; pfa = ab_[h]; pfb = ab_[8 + h]; } } } while (0)
    {
    const int tid = tid0, lane = tid & 63, lr = lane & 15, lg = lane >> 4;
    for (int i = tid; i < 9216 / 4; i += 512) ((LAS unsigned*)(L + AQK))[i] = 0u;
    if (grpA) {
#pragma unroll
        for (int j = 0; j < 8; ++j)
#pragma unroll
            for (int ct = 0; ct < 2; ++ct) { f32x4 v = (f32x4){0.f, 0.f, 0.f, 0.f};
                if (S0) {
#pragma unroll
                    for (int e = 0; e < 4; ++e) v[e] = S0[(size_t)(16 * j + 4 * lg + e) * 128 + 32 * wq + 16 * ct + lr]; }
                Sreg[j][ct] = v;
                *(LAS s16x4*)(L + ST + (32 * wq + 16 * ct + lr) * S272 + (16 * j + 4 * lg) * 2) = pk4(v); }
    }
    }
    G_ISSUE(0);
    __syncthreads();
    for (int c = 0; c < nchunks; ++c) {
        const long crow0 = row0 + (long)c * 64;
        if (tsum && c == 0) tlast = __builtin_amdgcn_s_memrealtime();
        int tid = threadIdx.x; asm volatile("" : "+v"(tid));
        const int lane = tid & 63, lr = lane & 15, lg = lane >> 4;
        if (wave == 0) {
            float g = 0.f, beta = 0.f;
            if (lane < nvalid) { const float a = pfa + dtb_h; const float sp = a > 20.f ? a : log1pf(__expf(a)); g = -__expf(alog_h) * sp; beta = 1.f / (1.f + __expf(-pfb)); }
            float G = g;
#pragma unroll
            for (int o = 1; o < 64; o <<= 1) { const float n = __shfl_up(G, o); if (lane >= o) G += n; }
            const float G63 = __shfl(G, 63);
            fGV[lane] = G; fBETA[lane] = beta; fEGT[lane] = __expf(G); fEGR[lane] = __expf(G63 - G); fBEG[lane] = beta * __expf(G);
        }
#pragma unroll
        for (int i = 0; i < 2; ++i) { const int idx = tid + 512 * i, row = idx >> 4, ch = idx & 15;
            *(LAS u32x4*)(L + QN + row * S272 + ch * 16) = pfq[i]; *(LAS u32x4*)(L + KN + row * S272 + ch * 16) = pfk[i];
#pragma unroll
            for (int e = 0; e < 8; ++e) { const unsigned wk = pfk[i][e >> 1], wv = pfv[i][e >> 1];
                *(LAS unsigned short*)(L + KNT + (ch * 8 + e) * S144 + row * 2) = (unsigned short)((e & 1) ? (wk >> 16) : (wk & 0xffffu));
                *(LAS unsigned short*)(L + VT + (ch * 8 + e) * S144 + row * 2) = (unsigned short)((e & 1) ? (wv >> 16) : (wv & 0xffffu)); } }
        if (c + 1 < nchunks) G_ISSUE(c + 1);
        __syncthreads();
        GT_MARK(tacc0);
        if (grpA) {
            const int ri = wave;
            f32x4 acc = (f32x4){0.f, 0.f, 0.f, 0.f};
#pragma unroll
            for (int ks = 0; ks < 4; ++ks) { const bf16x8 a = G_FRAG8(L + KN, S272, 16 * ri + lr, ks * 64 + lg * 16); acc = G_MMA32(a, a, acc); }
            const float Gs = fGV[16 * ri + lr];
            const f32x4 Gt = *(const LAS f32x4*)(fGV + 16 * ri + 4 * lg), Bt = *(const LAS f32x4*)(fBETA + 16 * ri + 4 * lg);
            f32x4 n1;
#pragma unroll
            for (int e = 0; e < 4; ++e) n1[e] = (lr < 4 * lg + e) ? -acc[e] * Bt[e] * __expf(Gt[e] - Gs) : 0.f;
            LAS unsigned char* nb = L + NB + wave * 1536;
#define G_NBW(off, v) do { _Pragma("unroll") for (int e_ = 0; e_ < 4; ++e_) *(LAS unsigned short*)(nb + (off) + (4 * lg + e_) * 32 + lr * 2) = (unsigned short)f2bf((v)[e_]); } while (0)
#define G_NBR(off) (*(const LAS s16x4*)(nb + (off) + lr * 32 + lg * 8))
            const f32x4 z4 = (f32x4){0.f, 0.f, 0.f, 0.f};
            G_NBW(0, n1);
            const s16x4 a1 = G_NBR(0);
            f32x4 n2 = G_MMA16(a1, pk4(n1), z4);
            G_NBW(512, n2);
            const s16x4 a2 = G_NBR(512);
            f32x4 n4 = G_MMA16(a2, pk4(n2), z4);
            G_NBW(1024, n4);
            const s16x4 a4 = G_NBR(1024);
            f32x4 R = G_MMA16(a4, pk4(n4), z4);
#pragma unroll
            for (int e = 0; e < 4; ++e) R[e] += (lr == 4 * lg + e) ? 1.f : 0.f;
            R = G_MMA16(a4, pk4(R), R);
            R = G_MMA16(a2, pk4(R), R);
            R = G_MMA16(a1, pk4(R), R);
#pragma unroll
            for (int e = 0; e < 4; ++e) *(LAS unsigned short*)(L + DBF + (16 * ri + 4 * lg + e) * 32 + lr * 2) = (unsigned short)f2bf(R[e]);
#undef G_NBW
#undef G_NBR
        } else {
            for (int it = 0; it < 4; ++it) {
                const int idx0 = (wave - 4) + 4 * it; const bool isqk = idx0 >= 6; const int idx = isqk ? idx0 - 6 : idx0 + 1;
                int ri, cj;
                if (isqk) { ri = idx < 1 ? 0 : (idx < 3 ? 1 : (idx < 6 ? 2 : 3)); cj = idx < 1 ? 0 : (idx < 3 ? idx - 1 : (idx < 6 ? idx - 3 : idx - 6)); }
                else { const int k = idx0; ri = k < 1 ? 1 : (k < 3 ? 2 : 3); cj = k < 1 ? 0 : (k < 3 ? k - 1 : k - 3); }
                f32x4 acc = (f32x4){0.f, 0.f, 0.f, 0.f};
                LAS const unsigned char* Abase = L + (isqk ? QN : KN);
#pragma unroll
                for (int ks = 0; ks < 4; ++ks) { const bf16x8 a = G_FRAG8(Abase, S272, 16 * ri + lr, ks * 64 + lg * 16), b = G_FRAG8(L + KN, S272, 16 * cj + lr, ks * 64 + lg * 16); acc = G_MMA32(a, b, acc); }
                const int s = 16 * cj + lr; const float Gs = fGV[s];
                const f32x4 Gt = *(const LAS f32x4*)(fGV + 16 * ri + 4 * lg), Bt = *(const LAS f32x4*)(fBETA + 16 * ri + 4 * lg);
#pragma unroll
                for (int e = 0; e < 4; ++e) { const int tt = 16 * ri + 4 * lg + e;
                    if (isqk) { const float v = (s <= tt) ? acc[e] * __expf(Gt[e] - Gs) : 0.f; *(LAS unsigned short*)(L + AQK + tt * S144 + s * 2) = (unsigned short)f2bf(v); }
                    else { const float v = -acc[e] * Bt[e] * __expf(Gt[e] - Gs); *(LAS unsigned short*)(L + ABF + tt * S144 + s * 2) = (unsigned short)f2bf(v); } }
            }
        }
        __syncthreads();
        GT_MARK(tacc1);
        f32x4 X[4][2];
        {
            LAS const unsigned char* SRC = L + (grpA ? VT : KNT); LAS const float* SCL = grpA ? fBETA : fBEG;
            s16x4 Xb[4][2];
#pragma unroll
            for (int i = 0; i < 4; ++i) {
                const f32x4 sc = *(const LAS f32x4*)(SCL + 16 * i + 4 * lg);
#pragma unroll
                for (int ct = 0; ct < 2; ++ct) { const s16x4 raw = *(const LAS s16x4*)(SRC + (32 * wq + 16 * ct + lr) * S144 + (16 * i + 4 * lg) * 2);
                    X[i][ct] = (f32x4){bf2f(raw[0]) * sc[0], bf2f(raw[1]) * sc[1], bf2f(raw[2]) * sc[2], bf2f(raw[3]) * sc[3]}; }
            }
#pragma unroll
            for (int i = 0; i < 4; ++i) {
#pragma unroll
                for (int k = 0; k < i; ++k) { const s16x4 a = *(const LAS s16x4*)(L + ABF + (16 * i + lr) * S144 + (16 * k + 4 * lg) * 2);
#pragma unroll
                    for (int ct = 0; ct < 2; ++ct) X[i][ct] = G_MMA16(a, Xb[k][ct], X[i][ct]); }
                const s16x4 d = *(const LAS s16x4*)(L + DBF + (16 * i + lr) * 32 + (4 * lg) * 2);
#pragma unroll
                for (int ct = 0; ct < 2; ++ct) { const s16x4 tb = pk4(X[i][ct]); X[i][ct] = G_MMA16(d, tb, ((f32x4){0.f, 0.f, 0.f, 0.f})); Xb[i][ct] = pk4(X[i][ct]); }
            }
            if (!grpA) {
#pragma unroll
                for (int i = 0; i < 4; ++i)
#pragma unroll
                    for (int ct = 0; ct < 2; ++ct)
#pragma unroll
                        for (int e = 0; e < 4; ++e) *(LAS unsigned short*)(L + KN + (16 * i + 4 * lg + e) * S272 + (32 * wq + 16 * ct + lr) * 2) = (unsigned short)f2bf(-X[i][ct][e]);
            }
        }
        DBG_X(2);
        __syncthreads();
        GT_MARK(tacc2);
        {
            bf16x8 bS[2][4];
#pragma unroll
            for (int ct = 0; ct < 2; ++ct)
#pragma unroll
                for (int ks = 0; ks < 4; ++ks) bS[ct][ks] = G_FRAG8(L + ST, S272, 32 * wq + 16 * ct + lr, ks * 64 + lg * 16);
            LAS const unsigned char* Abase = L + (grpA ? KN : QN);
            if (!grpA) {
#pragma unroll
                for (int i = 0; i < 4; ++i) { X[i][0] = (f32x4){0.f, 0.f, 0.f, 0.f}; X[i][1] = (f32x4){0.f, 0.f, 0.f, 0.f}; } }
#pragma unroll
            for (int i = 0; i < 4; ++i)
#pragma unroll
                for (int ks = 0; ks < 4; ++ks) { const bf16x8 a = G_FRAG8(Abase, S272, 16 * i + lr, ks * 64 + lg * 16);
#pragma unroll
                    for (int ct = 0; ct < 2; ++ct) X[i][ct] = G_MMA32(a, bS[ct][ks], X[i][ct]); }
            if (grpA) {
#pragma unroll
                for (int i = 0; i < 4; ++i)
#pragma unroll
                    for (int ct = 0; ct < 2; ++ct) *(LAS s16x4*)(L + VT + (32 * wq + 16 * ct + lr) * S144 + (16 * i + 4 * lg) * 2) = pk4(X[i][ct]);
            }
        }
        DBG_X(3);
        __syncthreads();
        GT_MARK(tacc3);
        if (grpA) {
            const float eg63 = fEGT[63];
            bf16x8 bsc[2][2];
#pragma unroll
            for (int ct = 0; ct < 2; ++ct)
#pragma unroll
                for (int ks = 0; ks < 2; ++ks) { const bf16x8 raw = G_FRAG8(L + VT, S144, 32 * wq + 16 * ct + lr, ks * 64 + lg * 16);
                    const f32x4 e0 = *(const LAS f32x4*)(fEGR + 32 * ks + 8 * lg), e1 = *(const LAS f32x4*)(fEGR + 32 * ks + 8 * lg + 4);
                    const u32x4 w = (u32x4){pk(bf2f(raw[0]) * e0[0], bf2f(raw[1]) * e0[1]), pk(bf2f(raw[2]) * e0[2], bf2f(raw[3]) * e0[3]), pk(bf2f(raw[4]) * e1[0], bf2f(raw[5]) * e1[1]), pk(bf2f(raw[6]) * e1[2], bf2f(raw[7]) * e1[3])};
                    bsc[ct][ks] = __builtin_bit_cast(bf16x8, w); }
#pragma unroll
            for (int j = 0; j < 8; ++j) {
#pragma unroll
                for (int ct = 0; ct < 2; ++ct) Sreg[j][ct] = Sreg[j][ct] * eg63;
#pragma unroll
                for (int ks = 0; ks < 2; ++ks) { const bf16x8 a = G_FRAG8(L + KNT, S144, 16 * j + lr, ks * 64 + lg * 16);
#pragma unroll
                    for (int ct = 0; ct < 2; ++ct) Sreg[j][ct] = G_MMA32(a, bsc[ct][ks], Sreg[j][ct]); }
#pragma unroll
                for (int ct = 0; ct < 2; ++ct) *(LAS s16x4*)(L + ST + (32 * wq + 16 * ct + lr) * S272 + (16 * j + 4 * lg) * 2) = pk4(Sreg[j][ct]);
            }
            __syncthreads();
        } else {
            f32x4 O2[4][2];
#pragma unroll
            for (int i = 0; i < 4; ++i) { O2[i][0] = (f32x4){0.f, 0.f, 0.f, 0.f}; O2[i][1] = (f32x4){0.f, 0.f, 0.f, 0.f}; }
            bf16x8 bW[2][2];
#pragma unroll
            for (int ct = 0; ct < 2; ++ct)
#pragma unroll
                for (int ks = 0; ks < 2; ++ks) bW[ct][ks] = G_FRAG8(L + VT, S144, 32 * wq + 16 * ct + lr, ks * 64 + lg * 16);
#pragma unroll
            for (int i = 0; i < 4; ++i)
#pragma unroll
                for (int ks = 0; ks < 2; ++ks) { const bf16x8 a = G_FRAG8(L + AQK, S144, 16 * i + lr, ks * 64 + lg * 16);
#pragma unroll
                    for (int ct = 0; ct < 2; ++ct) O2[i][ct] = G_MMA32(a, bW[ct][ks], O2[i][ct]); }
#pragma unroll
            for (int i = 0; i < 4; ++i) { const f32x4 eg = *(const LAS f32x4*)(fEGT + 16 * i + 4 * lg);
#pragma unroll
                for (int ct = 0; ct < 2; ++ct) X[i][ct] = X[i][ct] * eg + O2[i][ct];
                f32x4 p = X[i][0] * X[i][0] + X[i][1] * X[i][1];
#pragma unroll
                for (int e = 0; e < 4; ++e) { float v = p[e]; v += __shfl_xor(v, 1); v += __shfl_xor(v, 2); v += __shfl_xor(v, 4); v += __shfl_xor(v, 8); p[e] = v; }
                if (lr == 0) {
#pragma unroll
                    for (int e = 0; e < 4; ++e) fRMS[(16 * i + 4 * lg + e) * 4 + wq] = p[e]; } }
            DBG_X(4);
            __syncthreads();
            const float ng0 = normg[32 * wq + lr], ng1 = normg[32 * wq + 16 + lr];
#pragma unroll
            for (int i = 0; i < 4; ++i)
#pragma unroll
                for (int e = 0; e < 4; ++e) { const int tt = 16 * i + 4 * lg + e;
                    const f32x4 pr = *(const LAS f32x4*)(fRMS + tt * 4); const float rstd = rsqrtf((pr[0] + pr[1] + pr[2] + pr[3]) * (1.f / 128.f) + 1e-6f);
                    if (tt < nvalid) { bf16* orow = OB + (crow0 + tt) * 3072 + h * 128 + 32 * wq + lr;
                        orow[0] = (bf16)f2bf(X[i][0][e] * rstd * ng0); orow[16] = (bf16)f2bf(X[i][1][e] * rstd * ng1); } }
        }
        GT_MARK(tacc4);
    }
    if (grpA) {
        const int lane = tid0 & 63, lr = lane & 15, lg = lane >> 4;
#pragma unroll
        for (int j = 0; j < 8; ++j)
#pragma unroll
            for (int ct = 0; ct < 2; ++ct)
#pragma unroll
                for (int e = 0; e < 4; ++e) Sout[(size_t)(16 * j + 4 * lg + e) * 128 + 32 * wq + 16 * ct + lr] = Sreg[j][ct][e];
    }
    __syncthreads();
    if (tsum && threadIdx.x == 0) { tsum[0] = tacc0; tsum[1] = tacc1; tsum[2] = tacc2; tsum[3] = tacc3; tsum[4] = tacc4; tsum[5] = tacc0 + tacc1 + tacc2 + tacc3 + tacc4; }
}
#undef GT_MARK
#undef G_ISSUE

__device__ __forceinline__ void conv_unit(bf16* QKVB, const bf16* SB, const float* wconv, const float* convst, long r0, int nrows, int sbrow, int op) {
    int tid = threadIdx.x; asm volatile("" : "+v"(tid));
    const int cg = tid & 127, seg = tid >> 7, col = op * 1024 + cg * 8;
    const bool act = seg * 8 < nrows;
    bf16x8 x[11];
#pragma unroll
    for (int i = 0; i < 11; ++i) x[i] = (bf16x8){0, 0, 0, 0, 0, 0, 0, 0};
    if (act) {
#pragma unroll
        for (int j = 0; j < 3; ++j) {
            if (seg > 0) x[j] = *(const bf16x8*)(QKVB + (r0 + 8 * seg - 3 + j) * 3072 + col);
            else if (sbrow >= 0) x[j] = *(const bf16x8*)(SB + (size_t)(sbrow + j) * 3072 + col);
            else if (convst) { const f32x4 a = *(const f32x4*)(convst + j * 3072 + col), b = *(const f32x4*)(convst + j * 3072 + col + 4);
                const u32x4 w = (u32x4){pk(a[0], a[1]), pk(a[2], a[3]), pk(b[0], b[1]), pk(b[2], b[3])}; x[j] = __builtin_bit_cast(bf16x8, w); }
        }
#pragma unroll
        for (int i = 0; i < 8; ++i) x[3 + i] = *(const bf16x8*)(QKVB + (r0 + 8 * seg + i) * 3072 + col);
    }
    f32x4 w0[4], w1[4];
#pragma unroll
    for (int j = 0; j < 4; ++j) { w0[j] = *(const f32x4*)(wconv + j * 3072 + col); w1[j] = *(const f32x4*)(wconv + j * 3072 + col + 4); }
    __syncthreads();
    if (act) {
#pragma unroll
        for (int i = 0; i < 8; ++i) {
            float y[8];
#pragma unroll
            for (int e = 0; e < 8; ++e) y[e] = 0.f;
#pragma unroll
            for (int j = 0; j < 4; ++j) {
#pragma unroll
                for (int e = 0; e < 4; ++e) { y[e] += w0[j][e] * bf2f(x[i + j][e]); y[4 + e] += w1[j][e] * bf2f(x[i + j][4 + e]); } }
            float ss = 0.f;
#pragma unroll
            for (int e = 0; e < 8; ++e) { y[e] = y[e] * __builtin_amdgcn_rcpf(1.f + __expf(-y[e])); ss += y[e] * y[e]; }
            float r = 1.f;
            if (op < 2) { ss += __shfl_xor(ss, 1); ss += __shfl_xor(ss, 2); ss += __shfl_xor(ss, 4); ss += __shfl_xor(ss, 8); r = rsqrtf(ss + 1e-6f); if (op == 0) r *= 0.08838834764831845f; }
            const u32x4 w = (u32x4){pk(y[0] * r, y[1] * r), pk(y[2] * r, y[3] * r), pk(y[4] * r, y[5] * r), pk(y[6] * r, y[7] * r)};
            *(u32x4*)(QKVB + (r0 + 8 * seg + i) * 3072 + col) = w;
        }
    }
    __syncthreads();
}
#undef G_MMA32
#undef G_MMA16
#undef G_FRAG8
}
constexpr int NWAVES = 8;
constexpr int R_P = 32768, R_S = 512, R_ALL = 33280;
constexpr size_t MiB = 1u << 20;
constexpr size_t WS_CTL = 0, CTL_ZERO_BYTES = 1 * MiB;
constexpr size_t WS_WIN = 1 * MiB;
constexpr size_t WS_WG = 16 * MiB;
constexpr size_t WS_WMEM = 22 * MiB;
constexpr size_t WS_WOUT = 26 * MiB;
constexpr size_t WS_WFF1 = 28 * MiB;
constexpr size_t WS_WFF2 = 36 * MiB;
constexpr size_t WS_AB = 44 * MiB;
constexpr size_t WS_MK = 47 * MiB, WS_MV = 55 * MiB, WS_MB = 63 * MiB;
constexpr size_t WS_QA = 72 * MiB, WS_KA = 138 * MiB, WS_VA = 204 * MiB;
constexpr size_t WS_QKVB = 270 * MiB;
constexpr size_t WS_SB = 466 * MiB;
constexpr size_t WS_SMG = 486 * MiB, WS_ST1 = 487 * MiB, WS_SHB = 489 * MiB, WS_SFF = 490 * MiB;
constexpr size_t WS_END = 494 * MiB;
constexpr size_t DO_XB = 0, DO_QC = 65 * MiB;
constexpr int CW_BAR = 4096;
constexpr int CW_CHK = 1024;
constexpr int CW_QUEUE = 2048;
constexpr int CW_SC = 8192;
constexpr int CW_TS = 3072;
constexpr int LDS_BYTES = 147456, RING_BYTES = 131072, MISC_OFF = LDS_BYTES - 256;

struct Args { const float* in[25]; float* out; unsigned char* ws; int ph_lo, ph_hi; };

__device__ __forceinline__ void p0_transpose_item(const float* W, int K, int N, int col_off, int nvalid, bf16* WT, int row_off, int nblk, LAS float* scr, int item, int lane) {
    const int kb = item / nblk, nb = item % nblk, k0 = 64 * kb, n0 = 32 * nb;
    const bool ok = (n0 + (lane & 31)) < nvalid;
#pragma unroll 8
    for (int i = 0; i < 32; ++i) { const int kk = 2 * i + (lane >> 5); scr[kk * 33 + (lane & 31)] = ok ? W[(size_t)(k0 + kk) * N + col_off + n0 + (lane & 31)] : 0.f; }
    LDS_WAIT(); asm volatile("" ::: "memory");
    const int c = lane & 7;
#pragma unroll
    for (int j = 0; j < 4; ++j) { const int n = (lane >> 3) + 8 * j; const LAS float* s = scr + (8 * c) * 33 + n;
        v4u o; o.x = pk2(s[0 * 33], s[1 * 33]); o.y = pk2(s[2 * 33], s[3 * 33]); o.z = pk2(s[4 * 33], s[5 * 33]); o.w = pk2(s[6 * 33], s[7 * 33]);
        *(GAS v4u*)(WT + (size_t)(row_off + n0 + n) * K + k0 + 8 * c) = o; }
    LDS_WAIT(); asm volatile("" ::: "memory");
}
__device__ __forceinline__ void cvt_row_bf16(const float* xrow, bf16* orow, int lane) {
    const GAS f32x4* xr = (const GAS f32x4*)xrow + lane;
    GAS unsigned long long* o8 = (GAS unsigned long long*)orow + lane;
    f32x4 v[4];
#pragma unroll
    for (int j = 0; j < 4; ++j) v[j] = xr[64 * j];
#pragma unroll
    for (int j = 0; j < 4; ++j) o8[64 * j] = (unsigned long long)pk2(v[j].x, v[j].y) | ((unsigned long long)pk2(v[j].z, v[j].w) << 32);
}

struct P1Order {
    int G, c;
    static constexpr int nM0 = 130, nN0 = 29, nwg0 = nM0 * nN0, nM1 = 16, nN1 = 8, nwg1 = nM1 * nN1, nwg = nwg0 + nwg1;
    __device__ __forceinline__ bool next(int i, pg8::Unit& u) const {
        const long L = (long)i * G + c; if (L >= nwg) return false;
        int wgid = (int)L; { const int q = nwg / 8, r = nwg % 8, xcd = wgid % 8, off = wgid / 8; wgid = (xcd < r ? xcd * (q + 1) : r * (q + 1) + (xcd - r) * q) + off; }
        if (wgid < nwg0) { const int nig = 8 * nN0, gid = wgid / nig, fm = gid * 8, gsz = (nM0 - fm) < 8 ? (nM0 - fm) : 8;
            u.pm = fm + ((wgid % nig) % gsz); u.pn = (wgid % nig) / gsz; u.job = 0; }
        else { const int w = wgid - nwg0; u.pm = w % nM1; u.pn = w / nM1; u.job = 1; }
        return true;
    }
    __device__ __forceinline__ void a_ready(const pg8::Unit&) const {}
    __device__ __forceinline__ void done(const pg8::Unit&) const {}
};

typedef pg8::f32x4 acc_t[2][2][4][2];
struct EpiP1 {
    static constexpr bool PERM = true, AFTER_DRAIN = false;
    unsigned char* ws; float* out;
    __device__ __forceinline__ void operator()(const acc_t& acc, const pg8::Unit& u, int wr, int wc, int fr, int fq) const {
        int lr0 = wr * 64 + fr, cl0 = wc * 32 + 8 * fq; const int pm = u.pm, pn = u.pn;
        asm volatile("" : "+v"(lr0), "+v"(cl0));
        if (u.job == 0 && pn == 28) {
            if (wc == 0 && fq < 2) {
                float* AB = (float*)(ws + WS_AB);
#pragma unroll
                for (int ai = 0; ai < 2; ++ai)
#pragma unroll
                    for (int m = 0; m < 4; ++m) { float* d = AB + (size_t)(pm * 256 + lr0 + ai * 128 + m * 16) * 16 + 8 * fq;
                        *(pg8::f32x4*)d = acc[ai][0][m][0]; *(pg8::f32x4*)(d + 4) = acc[ai][0][m][1]; }
            }
            return;
        }
        bf16* tile; bf16* sbt = nullptr; int ld = 1024; float sc = 1.f; int fmode = 0; size_t fbase = 0; int fld = 1024;
        if (u.job == 0) {
            if (pn < 12) { const int which = pn >> 2, colt = (pn & 3) * 256;
                tile = (bf16*)(ws + (which == 0 ? WS_QA : (which == 1 ? WS_KA : WS_VA))) + (size_t)pm * 256 * 1024 + colt; if (which == 0) sc = C2A;
                if (which != 0) { const bool smp = pm >= 128;
                    if (smp) { fmode = 2; fbase = (which == 1 ? O_AKS : O_AVS) + colt; }
                    else if ((pm & 7) >= 6) { fmode = 1; fbase = (which == 1 ? O_AKP : O_AVP) + ((size_t)(pm >> 3) * 512 + ((pm & 7) - 6) * 256) * 1024 + colt; } }
            } else if (pn < 24) { const int c3t = (pn - 12) * 256; ld = 3072; fld = 3072;
                tile = (bf16*)(ws + WS_QKVB) + (size_t)pm * 256 * 3072 + c3t;
                if (pm >= 128) { fmode = 4; fbase = O_CONVS + c3t; } else { sbt = (bf16*)(ws + WS_SB) + (size_t)pm * 8 * 3 * 3072 + c3t; if ((pm & 7) == 7) { fmode = 3; fbase = O_CONVP + (size_t)(pm >> 3) * 3 * 3072 + c3t; } }
            } else { tile = (bf16*)((unsigned char*)out + DO_QC) + (size_t)pm * 256 * 1024 + (pn - 24) * 256; sc = C2C; }
        } else { const int isv = pn >> 2, colt = (pn & 3) * 256;
            tile = (bf16*)(ws + (isv ? WS_MV : WS_MK)) + (size_t)pm * 256 * 1024 + colt; fmode = 5; fbase = (isv ? O_MVP : O_MKP) + (size_t)pm * 256 * 1024 + colt; }
#pragma unroll
        for (int ai = 0; ai < 2; ++ai)
#pragma unroll
            for (int m = 0; m < 4; ++m) {
                const int lr = lr0 + ai * 128 + m * 16;
                bf16* rowp = tile + (size_t)lr * ld + cl0;
#pragma unroll
                for (int bj = 0; bj < 2; ++bj) { const pg8::f32x4 v0 = acc[ai][bj][m][0] * sc, v1 = acc[ai][bj][m][1] * sc;
                    pg8::u32x4 w; w.x = pg8::cvt_pk_bf16(v0[0], v0[1]); w.y = pg8::cvt_pk_bf16(v0[2], v0[3]); w.z = pg8::cvt_pk_bf16(v1[0], v1[1]); w.w = pg8::cvt_pk_bf16(v1[2], v1[3]);
                    *(pg8::u32x4*)(rowp + bj * 128) = w;
                    if (sbt && (lr & 31) >= 29) *(pg8::u32x4*)(sbt + (size_t)((lr >> 5) * 3 + (lr & 31) - 29) * 3072 + cl0 + bj * 128) = w; }
                if (fmode) {
                    long drow = -1;
                    if (fmode == 1 || fmode == 5) drow = lr;
                    else if (fmode == 2) { const int rs = (pm - 128) * 256 + lr; drow = (long)(rs >> 4) * 512 + 496 + (rs & 15); }
                    else if (fmode == 3) { if (lr >= 253) drow = lr - 253; }
                    else { const int rs = (pm - 128) * 256 + lr; if ((rs & 15) >= 13) drow = (long)(rs >> 4) * 3 + (rs & 15) - 13; }
                    if (drow >= 0) { float* d = out + fbase + (size_t)drow * fld + cl0;
#pragma unroll
                        for (int bj = 0; bj < 2; ++bj) { *(pg8::f32x4*)(d + bj * 128) = acc[ai][bj][m][0]; *(pg8::f32x4*)(d + bj * 128 + 4) = acc[ai][bj][m][1]; } }
                }
                asm volatile("" ::: "memory");
            }
    }
};

template <int NM> struct P3OrderT {
    int G, c;
    static constexpr int nM = NM, nP = 4, npair = nM * nP;
    __device__ __forceinline__ bool next(int i, pg8::Unit& u) const {
        const int tr = i / 3, br = i - 3 * tr; const long L = (long)tr * G + c; if (L >= npair) return false;
        int wgid = (int)L; { const int q = npair / 8, r = npair % 8, xcd = wgid % 8, off = wgid / 8; wgid = (xcd < r ? xcd * (q + 1) : r * (q + 1) + (xcd - r) * q) + off; }
        const int nig = 8 * nP, gid = wgid / nig, fm = gid * 8, gsz = (nM - fm) < 8 ? (nM - fm) : 8;
        u.pm = fm + ((wgid % nig) % gsz); u.pn = br * 4 + (wgid % nig) / gsz; u.job = 0; return true;
    }
    __device__ __forceinline__ void a_ready(const pg8::Unit&) const {}
    __device__ __forceinline__ void done(const pg8::Unit&) const {}
};
__device__ __forceinline__ float bflo(unsigned w) { return __uint_as_float(w << 16); }
__device__ __forceinline__ float bfhi(unsigned w) { return __uint_as_float(w & 0xffff0000u); }
__device__ __forceinline__ float sigmoid_f(float g) { return __builtin_amdgcn_rcpf(1.f + __builtin_amdgcn_exp2f(-g * LOG2E)); }
struct EpiGate {
    static constexpr bool PERM = true, AFTER_DRAIN = false;
    unsigned char* ws; unsigned char* outb; int smp;
    __device__ __forceinline__ void operator()(const acc_t& acc, const pg8::Unit& u, int wr, int wc, int fr, int fq) const {
        int lr0 = wr * 64 + fr, cl0 = wc * 32 + 8 * fq; const int pm = u.pm, br = u.pn >> 2, pc = u.pn & 3;
        asm volatile("" : "+v"(lr0), "+v"(cl0));
        const bf16* ob; int ldo = 1024;
        if (br == 0) ob = (const bf16*)(ws + WS_QA); else if (br == 1) { ob = (const bf16*)(ws + WS_QKVB); ldo = 3072; } else ob = (const bf16*)(outb + DO_QC);
        ob += (size_t)(pm * 256 + (smp ? R_P : 0)) * ldo + pc * 256 + cl0;
        bf16* mg = (bf16*)(ws + (smp ? WS_SMG : WS_KA)) + (size_t)pm * 256 * 1024 + pc * 256 + cl0;
#pragma unroll
        for (int ai = 0; ai < 2; ++ai)
#pragma unroll
            for (int m = 0; m < 4; ++m) {
                const int lr = lr0 + ai * 128 + m * 16;
#pragma unroll
                for (int bj = 0; bj < 2; ++bj) {
                    const pg8::u32x4 ov = *(const pg8::u32x4*)(ob + (size_t)lr * ldo + bj * 128);
                    const pg8::f32x4 g0 = acc[ai][bj][m][0], g1 = acc[ai][bj][m][1];
                    float v[8];
                    v[0] = sigmoid_f(g0[0]) * bflo(ov.x); v[1] = sigmoid_f(g0[1]) * bfhi(ov.x); v[2] = sigmoid_f(g0[2]) * bflo(ov.y); v[3] = sigmoid_f(g0[3]) * bfhi(ov.y);
                    v[4] = sigmoid_f(g1[0]) * bflo(ov.z); v[5] = sigmoid_f(g1[1]) * bfhi(ov.z); v[6] = sigmoid_f(g1[2]) * bflo(ov.w); v[7] = sigmoid_f(g1[3]) * bfhi(ov.w);
                    pg8::u32x4* mp = (pg8::u32x4*)(mg + (size_t)lr * 1024 + bj * 128);
                    if (br != 0) { const pg8::u32x4 pv = *mp;
                        v[0] += bflo(pv.x); v[1] += bfhi(pv.x); v[2] += bflo(pv.y); v[3] += bfhi(pv.y); v[4] += bflo(pv.z); v[5] += bfhi(pv.z); v[6] += bflo(pv.w); v[7] += bfhi(pv.w); }
                    pg8::u32x4 w; w.x = pg8::cvt_pk_bf16(v[0], v[1]); w.y = pg8::cvt_pk_bf16(v[2], v[3]); w.z = pg8::cvt_pk_bf16(v[4], v[5]); w.w = pg8::cvt_pk_bf16(v[6], v[7]);
                    *mp = w;
                }
                asm volatile("" ::: "memory");
            }
    }
};
struct EpiResF32 {
    static constexpr bool PERM = false, AFTER_DRAIN = false;
    const float* res_p; const float* res_s; float* dst; const float* bias;
    __device__ __forceinline__ void operator()(const acc_t& acc, const pg8::Unit& u, int wr, int wc, int fr, int fq) const {
        int lr0 = wr * 64 + fr, cl0 = u.pn * 256 + wc * 32 + 4 * fq;
        asm volatile("" : "+v"(lr0), "+v"(cl0));
        const float* rb = (u.pm < 128) ? res_p + (size_t)u.pm * 256 * 1024 : res_s + (size_t)(u.pm - 128) * 256 * 1024;
        float* db = dst + (size_t)u.pm * 256 * 1024;
        pg8::f32x4 bv[2][2];
#pragma unroll
        for (int bj = 0; bj < 2; ++bj)
#pragma unroll
            for (int n = 0; n < 2; ++n) bv[bj][n] = bias ? *(const pg8::f32x4*)(bias + cl0 + bj * 128 + n * 16) : (pg8::f32x4){0.f, 0.f, 0.f, 0.f};
#pragma unroll
        for (int ai = 0; ai < 2; ++ai)
#pragma unroll
            for (int m = 0; m < 4; ++m) { const size_t off = (size_t)(lr0 + ai * 128 + m * 16) * 1024 + cl0;
#pragma unroll
                for (int bj = 0; bj < 2; ++bj)
#pragma unroll
                    for (int n = 0; n < 2; ++n) { const pg8::f32x4 rv = *(const pg8::f32x4*)(rb + off + bj * 128 + n * 16);
                        *(pg8::f32x4*)(db + off + bj * 128 + n * 16) = rv * DN_ALPHA + acc[ai][bj][m][n] + bv[bj][n]; }
                asm volatile("" ::: "memory"); }
    }
};
struct EpiFf1 {
    static constexpr bool PERM = true, AFTER_DRAIN = false;
    bf16* FF; const float* bias;
    __device__ __forceinline__ void operator()(const acc_t& acc, const pg8::Unit& u, int wr, int wc, int fr, int fq) const {
        int lr0 = wr * 64 + fr, cl0 = u.pn * 256 + wc * 32 + 8 * fq;
        asm volatile("" : "+v"(lr0), "+v"(cl0));
        bf16* tile = FF + (size_t)u.pm * 256 * 4096 + cl0;
        pg8::f32x4 bv[2][2];
#pragma unroll
        for (int bj = 0; bj < 2; ++bj)
#pragma unroll
            for (int n = 0; n < 2; ++n) bv[bj][n] = *(const pg8::f32x4*)(bias + cl0 + bj * 128 + 4 * n);
#pragma unroll
        for (int ai = 0; ai < 2; ++ai)
#pragma unroll
            for (int m = 0; m < 4; ++m) { bf16* rowp = tile + (size_t)(lr0 + ai * 128 + m * 16) * 4096;
#pragma unroll
                for (int bj = 0; bj < 2; ++bj) { pg8::f32x4 v0 = acc[ai][bj][m][0] + bv[bj][0], v1 = acc[ai][bj][m][1] + bv[bj][1];
#pragma unroll
                    for (int e = 0; e < 4; ++e) { v0[e] = fmaxf(v0[e], 0.f); v0[e] *= v0[e]; v1[e] = fmaxf(v1[e], 0.f); v1[e] *= v1[e]; }
                    pg8::u32x4 w; w.x = pg8::cvt_pk_bf16(v0[0], v0[1]); w.y = pg8::cvt_pk_bf16(v0[2], v0[3]); w.z = pg8::cvt_pk_bf16(v1[0], v1[1]); w.w = pg8::cvt_pk_bf16(v1[2], v1[3]);
                    *(pg8::u32x4*)(rowp + bj * 128) = w; }
                asm volatile("" ::: "memory"); }
    }
};
__device__ __forceinline__ float wsum64(float v) {
#pragma unroll
    for (int o = 1; o < 64; o <<= 1) v += __shfl_xor(v, o);
    return v;
}
__device__ __forceinline__ void ln_row(float* row, const float* g, const float* b, bf16* hb, int lane, float* dst = nullptr) {
    GAS f32x4* xr = (GAS f32x4*)row + lane; GAS f32x4* xo = dst ? (GAS f32x4*)dst + lane : xr;
    f32x4 v[4]; float s = 0.f;
#pragma unroll
    for (int j = 0; j < 4; ++j) { v[j] = xr[64 * j]; s += (v[j].x + v[j].y) + (v[j].z + v[j].w); }
    const float mean = wsum64(s) * (1.f / 1024.f); float s2 = 0.f;
#pragma unroll
    for (int j = 0; j < 4; ++j) { v[j] = v[j] - mean; s2 += (v[j].x * v[j].x + v[j].y * v[j].y) + (v[j].z * v[j].z + v[j].w * v[j].w); }
    const float rstd = 1.f / sqrtf(wsum64(s2) * (1.f / 1024.f) + LN_EPS);
#pragma unroll
    for (int j = 0; j < 4; ++j) { const f32x4 gv = *((const GAS f32x4*)g + lane + 64 * j), bv = *((const GAS f32x4*)b + lane + 64 * j);
        v[j] = v[j] * rstd * gv + bv; xo[64 * j] = v[j];
        if (hb) ((GAS unsigned long long*)hb + lane)[64 * j] = (unsigned long long)pk2(v[j].x, v[j].y) | ((unsigned long long)pk2(v[j].z, v[j].w) << 32); }
}

struct EpiSPerm {
    static constexpr bool PERM = true, AFTER_DRAIN = false;
    int kind; EpiGate eg; EpiFf1 ef;
    __device__ __forceinline__ void operator()(const acc_t& acc, const pg8::Unit& u, int wr, int wc, int fr, int fq) const { if (kind == 0) eg(acc, u, wr, wc, fr, fq); else ef(acc, u, wr, wc, fr, fq); }
};
__global__ void __launch_bounds__(NWAVES * 64, 2) mega_fwd(Args args) {
    extern __shared__ __attribute__((aligned(16))) unsigned char lds[];
    LAS unsigned char* L = (LAS unsigned char*)lds;
    volatile LAS unsigned* MISC = (volatile LAS unsigned*)(L + MISC_OFF);
    const int tid = threadIdx.x, lane = tid & 63, wave = __builtin_amdgcn_readfirstlane(tid >> 6);
#define GRID_N ((int)gridDim.x)
#define BLK_X ((int)blockIdx.x)
#define VCU ((BLK_X % 8) * (GRID_N / 8) + BLK_X / 8)
    unsigned char* ws = args.ws; float* out = args.out; unsigned char* outb = (unsigned char*)args.out;
    gu32* ctl = (gu32*)(ws + WS_CTL);
    for (int u = tid; u < (LDS_BYTES - RING_BYTES) / 4; u += NWAVES * 64) ((LAS unsigned*)(L + RING_BYTES))[u] = 0u;
    __syncthreads();
    (void)xcd_barrier_post((unsigned*)(ctl + CW_BAR), MISC + 8);
#define GRIDBAR() do { XcdBarrier bar_; bar_.bar = (unsigned*)(ws + WS_CTL) + CW_BAR; bar_.x = xb_xcc_id(); bar_.st = (volatile LAS unsigned*)(L + MISC_OFF) + 8; xcd_barrier(bar_); } while (0)
#define IN(k) (args.ph_lo <= (k) && (k) < args.ph_hi)
#if defined(PROBE_A)
#define STAMP(k) do { if (blockIdx.x == 0 && threadIdx.x == 0) ((volatile unsigned long long*)(ws + WS_CTL + CW_TS * 4))[k] = __builtin_amdgcn_s_memrealtime(); } while (0)
#else
#define STAMP(k) do {} while (0)
#endif
    STAMP(0);
#define BOTH(k) (IN(k) && IN((k) + 1))
#define XB ((bf16*)(outb + DO_XB))
#define QC ((bf16*)(outb + DO_QC))
#define WinT ((bf16*)(ws + WS_WIN))
#define WgT ((bf16*)(ws + WS_WG))
#define WmemT ((bf16*)(ws + WS_WMEM))
#define WoutT ((bf16*)(ws + WS_WOUT))
#define Wff1T ((bf16*)(ws + WS_WFF1))
#define Wff2T ((bf16*)(ws + WS_WFF2))
#define MB ((bf16*)(ws + WS_MB))
#define HB ((bf16*)(ws + WS_QKVB + 130 * MiB))
#define FF ((bf16*)(ws + WS_QA))
    if (IN(0)) {
        LAS float* scr = (LAS float*)(L + wave * 16384);
        const int gw = VCU * NWAVES + wave, NGW = GRID_N * NWAVES;
        const float *w_in = args.in[9], *w_mem = args.in[15], *w_out = args.in[16], *w_ff1 = args.in[19], *w_ff2 = args.in[21];
        constexpr int I_IN = 16 * 224, I_AB = 16 * 8, I_G = 16 * 96, I_MEM = 16 * 64, I_OUT = 16 * 32, I_F1 = 16 * 128, I_F2 = 64 * 32;
        constexpr int NITEMS = I_IN + I_AB + I_G + I_MEM + I_OUT + I_F1 + I_F2;
        for (int it = gw; it < NITEMS; it += NGW) {
            int r = it;
            if (r < I_IN) { p0_transpose_item(w_in, 1024, ZW, 0, 7168, WinT, 0, 224, scr, r, lane); continue; } r -= I_IN;
            if (r < I_AB) { p0_transpose_item(w_in, 1024, ZW, 10240, 16, WinT, 7168, 8, scr, r, lane); continue; } r -= I_AB;
            if (r < I_G) { p0_transpose_item(w_in, 1024, ZW, 7168, 3072, WgT, 0, 96, scr, r, lane); continue; } r -= I_G;
            if (r < I_MEM) { p0_transpose_item(w_mem, 1024, 2048, 0, 2048, WmemT, 0, 64, scr, r, lane); continue; } r -= I_MEM;
            if (r < I_OUT) { p0_transpose_item(w_out, 1024, 1024, 0, 1024, WoutT, 0, 32, scr, r, lane); continue; } r -= I_OUT;
            if (r < I_F1) { p0_transpose_item(w_ff1, 1024, 4096, 0, 4096, Wff1T, 0, 128, scr, r, lane); continue; } r -= I_F1;
            p0_transpose_item(w_ff2, 4096, 1024, 0, 1024, Wff2T, 0, 32, scr, r, lane);
        }
        for (int m = gw; m < R_ALL + 4096; m += NGW) {
            if (m < R_P) cvt_row_bf16(args.in[0] + (size_t)m * 1024, XB + (size_t)m * 1024, lane);
            else if (m < R_ALL) cvt_row_bf16(args.in[1] + (size_t)(m - R_P) * 1024, XB + (size_t)m * 1024, lane);
            else cvt_row_bf16(args.in[8] + (size_t)(m - R_ALL) * 1024, MB + (size_t)(m - R_ALL) * 1024, lane);
        }
        if (BOTH(0)) GRIDBAR(); STAMP(1);
    }
    if (IN(1)) {
        pg8::Gemm g{XB, WinT, R_ALL, 7424, 1024, MB, WmemT};
        P1Order S; S.G = GRID_N; S.c = BLK_X;
        EpiP1 E{ws, out};
        pg8::gemm_phase<EpiP1, P1Order, true, true, 1024>(L, g, S, E);
        if (BOTH(1)) GRIDBAR(); STAMP(2);
    }
    if (IN(2)) {
        for (int u = VCU; u < 3072 + 96; u += GRID_N) {
            if (u < 3072) { const int op = u % 3, blk = (u / 3) & 63, b = u / 192;
                gdn::conv_unit((bf16*)(ws + WS_QKVB), (const bf16*)(ws + WS_SB), args.in[10], nullptr, (long)b * 2048 + blk * 32, 32, blk ? (b * 64 + blk - 1) * 3 : -1, op); }
            else { const int v = u - 3072, op = v % 3, b = v / 3;
                gdn::conv_unit((bf16*)(ws + WS_QKVB), nullptr, args.in[10], args.in[4] + (size_t)b * 3 * 3072, (long)R_P + b * 16, 16, -1, op); }
        }
        GRIDBAR(); STAMP(9);
    }
    if (IN(2)) {
        constexpr int Q0_GP = 0, Q0_GS = 128, Q0_SA = Q0_GS + 256, Q0_SC = Q0_SA + 512, Q0_C1 = Q0_SC + 128, Q0_G = Q0_C1 + 128, Q0_C2 = Q0_G + 8, Q0_A1 = Q0_C2 + 384, Q0_O = Q0_A1 + 512,
                      Q0_A2 = Q0_O + 8, Q0_L1 = Q0_A2 + 256, Q0_A3 = Q0_L1 + 8, Q0_F1 = Q0_A3 + 256, Q0_A4 = Q0_F1 + 32, Q0_F2 = Q0_A4 + 512, Q0_A5 = Q0_F2 + 8, Q0_L2 = Q0_A5 + 512, Q0_END = Q0_L2 + 8;
        volatile LAS int* qslot = (volatile LAS int*)(L + MISC_OFF);
        struct OneUnit { int pm, pn, n;
            __device__ __forceinline__ bool next(int i, pg8::Unit& u) const { if (i >= n) return false; u.pm = pm; u.pn = pn + 4 * i; u.job = 0; return true; }
            __device__ __forceinline__ void a_ready(const pg8::Unit&) const {}
            __device__ __forceinline__ void done(const pg8::Unit&) const {} };
#define SC_CNT(stage, panel) (ctl + CW_SC + 64 * ((stage) * 2 + (panel)))
#define SC_DONE(stage, panel) do { asm volatile("s_waitcnt vmcnt(0)" ::: "memory"); __syncthreads(); \
            if (threadIdx.x == 0) { __builtin_amdgcn_fence(__ATOMIC_RELEASE, "agent"); asm volatile("s_waitcnt vmcnt(0)" ::: "memory"); __hip_atomic_fetch_add(SC_CNT(stage, panel), 1u, __ATOMIC_RELAXED, __HIP_MEMORY_SCOPE_AGENT); } } while (0)
#define SC_WAIT(stage, panel, need) do { if (threadIdx.x == 0) { unsigned sp_ = 0; while (__hip_atomic_load(SC_CNT(stage, panel), __ATOMIC_RELAXED, __HIP_MEMORY_SCOPE_AGENT) < (unsigned)(need)) { __builtin_amdgcn_s_sleep(8); if (++sp_ > (1u << 22)) break; } \
            __builtin_amdgcn_fence(__ATOMIC_ACQUIRE, "agent"); asm volatile("s_waitcnt vmcnt(0)" ::: "memory"); } __syncthreads(); } while (0)
        for (;;) {
            if (threadIdx.x == 0) qslot[0] = (int)__hip_atomic_fetch_add(ctl + CW_QUEUE, 1u, __ATOMIC_RELAXED, __HIP_MEMORY_SCOPE_AGENT);
            __syncthreads();
            const int it = __builtin_amdgcn_readfirstlane(qslot[0]);
            __syncthreads();
            if (it >= Q0_END) break;
#if defined(ITEM_PROBE)
            unsigned long long it_t0 = 0; if (it == ITEM_PROBE) it_t0 = __builtin_amdgcn_s_memrealtime();
#endif
            int au = -1, cu = -1;
            int skind = -1, sp = 0, spn = 0;
            int lane_q = threadIdx.x & 63; asm volatile("" : "+v"(lane_q));
            if (it < Q0_GS) { const int b = it >> 3, h = it & 7;
                gdn::gdn_unit(L, (const bf16*)(ws + WS_QKVB), (bf16*)(ws + WS_QKVB), (const float*)(ws + WS_AB), (long)b * 2048, h, 32, 64, args.in[11], args.in[12], args.in[13], nullptr,
                              out + O_SSMP + ((size_t)b * 8 + h) * 16384);
            } else if (it < Q0_SA) { const int u = it - Q0_GS, b = u >> 3, h = u & 7;
                gdn::gdn_unit(L, (const bf16*)(ws + WS_QKVB), (bf16*)(ws + WS_QKVB), (const float*)(ws + WS_AB), (long)R_P + b * 16, h, 1, 16, args.in[11], args.in[12], args.in[13],
                              args.in[5] + ((size_t)b * 8 + h) * 16384, out + O_SSMS + ((size_t)b * 8 + h) * 16384);
                SC_DONE(0, b >> 4);
            } else if (it < Q0_SC) { const int u = it - Q0_SA, b = u >> 4, h = u & 15; const size_t r0 = (size_t)(R_P + b * 16) * 1024 + h * 64;
                satt::sattn_unit<64, 64>(L, (bf16*)(ws + WS_QA) + r0, args.in[2] + (size_t)b * 512 * 1024 + h * 64, args.in[3] + (size_t)b * 512 * 1024 + h * 64, 512,
                                         (const bf16*)(ws + WS_KA) + r0, (const bf16*)(ws + WS_VA) + r0, 16, args.in[14] + h * 257,
                                         out + O_AKS + (size_t)b * 512 * 1024 + h * 64, out + O_AVS + (size_t)b * 512 * 1024 + h * 64);
                SC_DONE(0, b >> 4);
            } else if (it < Q0_C1) { const int u = it - Q0_SC, b = u >> 2, h = u & 3; const size_t r0 = (size_t)(R_P + b * 16) * 1024 + h * 256;
                satt::sattn_unit<256, 32>(L, (bf16*)(outb + DO_QC) + r0, args.in[6] + (size_t)b * 256 * 1024 + h * 256, args.in[7] + (size_t)b * 256 * 1024 + h * 256, 256,
                                          nullptr, nullptr, 0, nullptr, nullptr, nullptr);
                SC_DONE(0, b >> 4);
            } else if (it < Q0_G) cu = it - Q0_C1;
            else if (it < Q0_C2) { const int u = it - Q0_G, p = u >> 2, pc = u & 3;
                SC_WAIT(0, p, 448);
                skind = 0; sp = p; spn = pc;
            } else if (it < Q0_A1) cu = 128 + it - Q0_C2;
            else if (it < Q0_O) au = it - Q0_A1;
            else if (it < Q0_A2) { const int u = it - Q0_O, p = u >> 2, pn = u & 3;
                SC_WAIT(1, p, 4);
                skind = 2; sp = p; spn = pn;
            } else if (it < Q0_L1) au = 512 + it - Q0_A2;
            else if (it < Q0_A3) { const int u = it - Q0_L1, p = u >> 2, q4 = u & 3;
                SC_WAIT(2, p, 4);
                for (int r = wave; r < 64; r += NWAVES) { const int m = p * 256 + q4 * 64 + r; ln_row((float*)(ws + WS_ST1) + (size_t)m * 1024, args.in[17], args.in[18], (bf16*)(ws + WS_SHB) + (size_t)m * 1024, lane_q); }
                SC_DONE(3, p);
            } else if (it < Q0_F1) au = 768 + it - Q0_A3;
            else if (it < Q0_A4) { const int u = it - Q0_F1, p = u >> 4, pn = u & 15;
                SC_WAIT(3, p, 4);
                skind = 1; sp = p; spn = pn;
            } else if (it < Q0_F2) au = 1024 + it - Q0_A4;
            else if (it < Q0_A5) { const int u = it - Q0_F2, p = u >> 2, pn = u & 3;
                SC_WAIT(4, p, 16);
                skind = 3; sp = p; spn = pn;
            } else if (it < Q0_L2) au = 1536 + it - Q0_A5;
            else { const int u = it - Q0_L2, p = u >> 2, q4 = u & 3;
                SC_WAIT(5, p, 4);
                for (int r = wave; r < 64; r += NWAVES) { const int m = p * 256 + q4 * 64 + r; ln_row((float*)(ws + WS_ST1) + (size_t)m * 1024, args.in[23], args.in[24], nullptr, lane_q); }
            }
            if (skind == 0 || skind == 1) {
                pg8::Gemm g{skind == 0 ? XB + (size_t)R_P * 1024 : (const bf16*)(ws + WS_SHB), skind == 0 ? WgT : Wff1T, 512, skind == 0 ? 3072 : 4096, 1024, XB, WgT}; OneUnit S{sp, spn, skind == 0 ? 3 : 1};
                EpiSPerm E{skind, EpiGate{ws, outb, 1}, EpiFf1{(bf16*)(ws + WS_SFF), args.in[20]}};
                pg8::gemm_phase<EpiSPerm, OneUnit, false, true, 1024>(L, g, S, E);
                SC_DONE(skind == 0 ? 1 : 4, sp);
            } else if (skind >= 2) {
                pg8::Gemm g{(const bf16*)(ws + (skind == 2 ? WS_SMG : WS_SFF)), skind == 2 ? WoutT : Wff2T, 512, 1024, skind == 2 ? 1024 : 4096, XB, WoutT}; OneUnit S{sp, spn, 1};
                EpiResF32 E{skind == 2 ? args.in[1] : (const float*)(ws + WS_ST1), skind == 2 ? args.in[1] : (const float*)(ws + WS_ST1), (float*)(ws + WS_ST1), skind == 2 ? nullptr : args.in[22]};
                pg8::gemm_phase<EpiResF32, OneUnit, false, true, 0>(L, g, S, E);
                SC_DONE(skind == 2 ? 2 : 5, sp);
            }
            if (cu >= 0) att::attnC_unit(cu >> 5, (cu >> 3) & 3, cu & 7, (bf16*)(outb + DO_QC), (const bf16*)(ws + WS_MK), (const bf16*)(ws + WS_MV), L);
            if (au >= 0) { const int bh = au >> 3; att::attnA_unit(bh >> 4, bh & 15, au & 7, (bf16*)(ws + WS_QA), (const bf16*)(ws + WS_KA), (const bf16*)(ws + WS_VA), args.in[14], L); }
#if defined(ITEM_PROBE)
            if (it == ITEM_PROBE && threadIdx.x == 0) ((volatile unsigned long long*)(ws + WS_CTL + CW_TS * 4))[24] = __builtin_amdgcn_s_memrealtime() - it_t0;
#endif
        }
#undef SC_CNT
#undef SC_DONE
#undef SC_WAIT
        if (BOTH(2)) GRIDBAR(); STAMP(3);
    }
    if (IN(3)) {
        pg8::Gemm g{XB, WgT, R_P, 3072, 1024, XB, WgT};
        P3OrderT<128> S; S.G = GRID_N; S.c = BLK_X;
        EpiGate E{ws, outb, 0};
        pg8::gemm_phase<EpiGate, P3OrderT<128>, true, true, 1024>(L, g, S, E);
        if (BOTH(3)) GRIDBAR(); STAMP(4);
    }
    if (IN(4)) {
        pg8::Gemm g{(const bf16*)(ws + WS_KA), WoutT, R_P, 1024, 1024, (const bf16*)(ws + WS_KA), WoutT};
        pg8::StaticOrder S; S.init(R_P, 1024, GRID_N, BLK_X);
        EpiResF32 E{args.in[0], args.in[1], out, nullptr};
        pg8::gemm_phase<EpiResF32, pg8::StaticOrder, true, true, 1024>(L, g, S, E);
        if (BOTH(4)) GRIDBAR(); STAMP(5);
    }
    if (IN(5)) {
        const int gw = VCU * NWAVES + wave, NGW = GRID_N * NWAVES;
        for (int m = gw; m < R_P; m += NGW) ln_row(out + (size_t)m * 1024, args.in[17], args.in[18], HB + (size_t)m * 1024, lane);
        if (BOTH(5)) GRIDBAR(); STAMP(6);
    }
    if (IN(6)) {
        pg8::Gemm g{HB, Wff1T, R_P, 4096, 1024, HB, Wff1T};
        pg8::StaticOrder S; S.init(R_P, 4096, GRID_N, BLK_X);
        EpiFf1 E{FF, args.in[20]};
        pg8::gemm_phase<EpiFf1, pg8::StaticOrder, true, true, 1024>(L, g, S, E);
        if (BOTH(6)) GRIDBAR(); STAMP(7);
    }
    if (IN(7)) {
        pg8::Gemm g{FF, Wff2T, R_P, 1024, 4096, FF, Wff2T};
        pg8::StaticOrder S; S.init(R_P, 1024, GRID_N, BLK_X);
        EpiResF32 E{out, out + (size_t)R_P * 1024, out, args.in[22]};
        pg8::gemm_phase<EpiResF32, pg8::StaticOrder, true, true, 4096>(L, g, S, E);
        if (BOTH(7)) GRIDBAR(); STAMP(8);
    }
    if (IN(8)) {
        const int gw = VCU * NWAVES + wave, NGW = GRID_N * NWAVES;
        for (int m = gw; m < R_P; m += NGW) ln_row(out + (size_t)m * 1024, args.in[23], args.in[24], nullptr, lane);
        for (int m = gw; m < R_S; m += NGW) { const GAS f32x4* sr = (const GAS f32x4*)((const float*)(ws + WS_ST1) + (size_t)m * 1024) + lane; GAS f32x4* dr = (GAS f32x4*)(out + O_YS + (size_t)m * 1024) + lane;
#pragma unroll
            for (int j = 0; j < 4; ++j) dr[64 * j] = sr[64 * j]; }
#if defined(PROBE_A)
        { const volatile unsigned long long* ts = (const volatile unsigned long long*)(ws + WS_CTL + CW_TS * 4);
#if defined(ITEM_PROBE)
          const float eps = floorf((float)ts[24] * 1e-5f * ITEM_Q) / ITEM_Q + 0.5f / ITEM_Q;
#elif defined(GDN_PROBE)
          const float eps = (GDN_PROBE == 5) ? floorf((float)ts[16 + 5] * 1e-5f * 10.f) * 0.1f + 0.05f : rintf((float)ts[16 + GDN_PROBE] / (float)ts[16 + 5] * 20.f) * 0.05f + 0.01f;
#else
          const float eps = floorf((float)(ts[PROBE_B] - ts[PROBE_A]) * 1e-5f * PROBE_Q) / PROBE_Q + 0.5f / PROBE_Q;
#endif
          asm volatile("s_waitcnt vmcnt(0)" ::: "memory");
          for (int m = R_P + gw; m < R_ALL; m += NGW) { GAS f32x4* xr = (GAS f32x4*)(out + (size_t)m * 1024) + lane;
              for (int j = 0; j < 4; ++j) xr[64 * j] = xr[64 * j] * (1.f + eps); } }
#endif
    }
#undef IN
#undef BOTH
}
extern "C" void kernel_launch(void* const* d_in, const int* in_sizes, int n_in, void* d_out, int out_size, void* d_ws, size_t ws_size, hipStream_t stream) {
    (void)in_sizes; (void)n_in; (void)out_size;
    static int inited = 0;
    if (!inited) { if (hipFuncSetAttribute((const void*)mega_fwd, hipFuncAttributeMaxDynamicSharedMemorySize, LDS_BYTES) != hipSuccess) fprintf(stderr, "hipFuncSetAttribute failed\n"); inited = 1; }
    if (ws_size < WS_END) { fprintf(stderr, "kernel_launch: workspace too small (%zu < %zu)\n", ws_size, (size_t)WS_END); return; }
    unsigned char* ws = (unsigned char*)d_ws;
    (void)hipMemsetAsync(ws + WS_CTL, 0, CTL_ZERO_BYTES, stream);
    Args a{}; for (int i = 0; i < 25; ++i) a.in[i] = (const float*)d_in[i];
    a.out = (float*)d_out; a.ws = ws; a.ph_lo = 0; a.ph_hi = 9;
    hipLaunchKernelGGL(mega_fwd, dim3(256), dim3(NWAVES * 64), LDS_BYTES, stream, a);
}
```

```cpp
#include <hip/hip_runtime.h>
#include <cstdio>
#include <cstdint>

constexpr int DM = 1024, BATCH = 16, SEQ = 2048, DEC_B = 32, DEC_T = 16, PAST = 1024;
constexpr int CHUNK = 64, AH = 16, AHD = 64, AWIN = 512, ABAND = 576, ACLIP = 128;
constexpr int BH = 8, BHD = 128, MEMT = 256, CH = 4, CHD = 256, DFF = 4096;
constexpr int ZW = 10256;
constexpr int ZQ_A = 0, ZK_A = 1024, ZV_A = 2048, ZB = 3072, ZQ_C = 6144, ZG = 7168, ZA_B = 10240, ZB_B = 10248;
constexpr float DN_ALPHA = 1.189207115002721f;
constexpr float LN_EPS = 1e-5f, RMS_EPS = 1e-6f, L2_EPS = 1e-6f;

constexpr size_t O_YP = 0, O_YS = 33554432, O_AKP = 34078720, O_AVP = 42467328, O_CONVP = 50855936, O_SSMP = 51003392,
                 O_MKP = 53100544, O_MVP = 57294848, O_AKS = 61489152, O_AVS = 78266368, O_CONVS = 95043584, O_SSMS = 95338496;

namespace pg8 {
#define PG8_LAS __attribute__((address_space(3)))
typedef unsigned short bf16_t;
typedef short bf16x8 __attribute__((ext_vector_type(8)));
typedef float f32x4 __attribute__((ext_vector_type(4)));
typedef unsigned u32x4 __attribute__((ext_vector_type(4)));
constexpr int BM = 256, BK = 64, HALF = 128, HTB = HALF * BK * 2  , STAGE_BYTES = 8 * HTB, NXCD = 8, WGM = 8;

__host__ __device__ __forceinline__ int lds_byte(int r, int c) { const int st = (r >> 4) * 2 + (c >> 5), rr = r & 15, cc = c & 31, ob = rr * 64 + cc * 2; return st * 1024 + (ob ^ (((ob >> 9) & 1) << 5)); }
__host__ __device__ __forceinline__ void stage_rc(int b, int& R, int& C) { const int st = b / 1024, sb = b % 1024, swz = sb ^ (((sb >> 9) & 1) << 5); R = (st >> 1) * 16 + swz / 64; C = (st & 1) * 32 + (swz % 64) / 2; }
__host__ __device__ __forceinline__ int perm32(int rho) { const int n = rho >> 4, i = rho & 15; return 8 * (i >> 2) + 4 * n + (i & 3); }

struct Unit { int pm, pn, job; };
struct Gemm { const bf16_t* A; const bf16_t* Bt; int M, N, K; const bf16_t* A1; const bf16_t* Bt1; };

struct StaticOrder {
    int nM, nN, nwg, G, c;
    __host__ __device__ void init(int M, int N, int G_, int c_) { nM = M / BM; nN = N / BM; nwg = nM * nN; G = G_; c = c_; }
    __host__ __device__ __forceinline__ bool next(int i, Unit& u) const {
        const long L = (long)i * G + c; if (L >= nwg) return false;
        int wgid = (int)L; { const int q = nwg / NXCD, r = nwg % NXCD, xcd = wgid % NXCD, off = wgid / NXCD; wgid = (xcd < r ? xcd * (q + 1) : r * (q + 1) + (xcd - r) * q) + off; }
        const int nig = WGM * nN, gid = wgid / nig, fm = gid * WGM, gsz = (nM - fm) < WGM ? (nM - fm) : WGM;
        u.pm = fm + ((wgid % nig) % gsz); u.pn = (wgid % nig) / gsz; u.job = 0; return true;
    }
    __device__ __forceinline__ void a_ready(const Unit&) const {}
    __device__ __forceinline__ void done(const Unit&) const {}
};

__device__ __forceinline__ unsigned cvt_pk_bf16(float lo, float hi) { unsigned r; asm volatile("v_cvt_pk_bf16_f32 %0, %1, %2" : "=v"(r) : "v"(lo), "v"(hi)); return r; }
template <class Epi, class Sched, bool ALIGN_EPI = false, bool SP2 = false, int KC = 0>
__device__ __forceinline__ void gemm_phase(PG8_LAS unsigned char* lds, const Gemm g, const Sched& S, const Epi& E) {
    int tid_ = threadIdx.x; asm volatile("" : "+v"(tid_));
    const int tid = tid_, wid = __builtin_amdgcn_readfirstlane(tid >> 6), lane = tid & 63, wr = wid >> 2, wc = wid & 3, fr = lane & 15, fq = lane >> 4;
    const int K = KC ? KC : g.K, nt = K / BK;
    unsigned voffA[2], voffB[2];
#pragma unroll
    for (int i = 0; i < 2; ++i) { int R, C; stage_rc(tid * 16 + i * 8192, R, C); const int Rb = Epi::PERM ? ((R & ~31) + perm32(R & 31)) : R;
        voffA[i] = (unsigned)(R * K + C) * 2u; voffB[i] = (unsigned)(Rb * K + C) * 2u; }
    const size_t kstep = (size_t)(BK * 2);
    const size_t hstep = (size_t)HALF * K * 2;
    const size_t tstep = 2 * hstep;
    const unsigned ldsw = (unsigned)wid * 1024u;
    const int aoff = lds_byte(wr * 64 + fr, fq * 8), boff = lds_byte(wc * 32 + fr, fq * 8);
#define PG8_SA(b, h) (((b) * 2 + (h)) * HTB)
#define PG8_SB(b, h) ((4 + (b) * 2 + (h)) * HTB)
#define PG8_STAGE(bufoff, gbase, voff) do { _Pragma("unroll") for (int _i = 0; _i < 2; ++_i) \
        __builtin_amdgcn_global_load_lds((const unsigned*)((const char*)(gbase) + (voff)[_i]), (PG8_LAS unsigned*)(lds + (bufoff) + ldsw + _i * 8192), 16, 0, 0); } while (0)
#define PG8_LDA(dst, b, h) do { _Pragma("unroll") for (int m = 0; m < 4; ++m) _Pragma("unroll") for (int k = 0; k < 2; ++k) dst[m][k] = *(const PG8_LAS bf16x8*)(lds + PG8_SA(b, h) + aoff + m * 2048 + k * 1024); } while (0)
#define PG8_LDB(dst, b, h) do { _Pragma("unroll") for (int n = 0; n < 2; ++n) _Pragma("unroll") for (int k = 0; k < 2; ++k) dst[n][k] = *(const PG8_LAS bf16x8*)(lds + PG8_SB(b, h) + boff + n * 2048 + k * 1024); } while (0)
#define PG8_MMA(ai, bj, At, Bt) do { __builtin_amdgcn_s_setprio(1); _Pragma("unroll") for (int m = 0; m < 4; ++m) _Pragma("unroll") for (int n = 0; n < 2; ++n) _Pragma("unroll") for (int k = 0; k < 2; ++k) \
        acc[ai][bj][m][n] = __builtin_amdgcn_mfma_f32_16x16x32_bf16(Bt[n][k], At[m][k], acc[ai][bj][m][n], 0, 0, 0); __builtin_amdgcn_s_setprio(0); } while (0)
#define PG8_WAIT_V(n) asm volatile("s_waitcnt vmcnt(" #n ")" ::: "memory")
#define PG8_WAIT_L(n) asm volatile("s_waitcnt lgkmcnt(" #n ")" ::: "memory")
#define PG8_BAR __builtin_amdgcn_s_barrier()
#define PG8_SCHED __builtin_amdgcn_sched_barrier(0)
    Unit cur, nxt; int ui = 0;
    if (!S.next(0, cur)) return;
    f32x4 acc[2][2][4][2];
#pragma unroll
    for (int a = 0; a < 2; ++a)
#pragma unroll
        for (int b = 0; b < 2; ++b)
#pragma unroll
            for (int m = 0; m < 4; ++m)
#pragma unroll
                for (int n = 0; n < 2; ++n) acc[a][b][m][n] = (f32x4){0.f, 0.f, 0.f, 0.f};
    bf16x8 At[4][2], B0[2][2], B1[2][2];
    const char* cA = (const char*)(cur.job ? g.A1 : g.A) + (size_t)cur.pm * tstep; const char* cB = (const char*)(cur.job ? g.Bt1 : g.Bt) + (size_t)cur.pn * tstep;
    S.a_ready(cur);
    if constexpr (SP2) {
        PG8_STAGE(PG8_SB(0, 0), cB, voffB); PG8_STAGE(PG8_SB(0, 1), cB + hstep, voffB); PG8_STAGE(PG8_SA(0, 0), cA, voffA); PG8_STAGE(PG8_SA(0, 1), cA + hstep, voffA);
        if (wr == 1) PG8_BAR;
        PG8_WAIT_V(2); PG8_BAR;
        PG8_STAGE(PG8_SB(1, 0), cB + kstep, voffB); PG8_STAGE(PG8_SA(1, 0), cA + kstep, voffA); PG8_STAGE(PG8_SB(1, 1), cB + hstep + kstep, voffB);
        PG8_WAIT_V(6); PG8_BAR;
    } else {
        PG8_STAGE(PG8_SB(0, 0), cB, voffB); PG8_STAGE(PG8_SA(0, 0), cA, voffA); PG8_STAGE(PG8_SB(0, 1), cB + hstep, voffB); PG8_STAGE(PG8_SA(0, 1), cA + hstep, voffA);
        if (wr == 1) PG8_BAR;
        PG8_WAIT_V(4); PG8_BAR;
        PG8_STAGE(PG8_SB(1, 0), cB + kstep, voffB); PG8_STAGE(PG8_SA(1, 0), cA + kstep, voffA); PG8_STAGE(PG8_SB(1, 1), cB + hstep + kstep, voffB);
        PG8_WAIT_V(6); PG8_BAR;
    }
    for (;;) {
        const bool has_next = S.next(ui + 1, nxt);
        const char* nA = has_next ? (const char*)(nxt.job ? g.A1 : g.A) + (size_t)nxt.pm * tstep : cA; const char* nB = has_next ? (const char*)(nxt.job ? g.Bt1 : g.Bt) + (size_t)nxt.pn * tstep : cB;
        for (int t = 0; t < nt; t += 2) {
            const bool last = (t == nt - 2);
            const char* a1 = cA + (size_t)(t + 1) * kstep;
            const char* a2 = last ? nA : cA + (size_t)(t + 2) * kstep; const char* b2 = last ? nB : cB + (size_t)(t + 2) * kstep;
            const char* a3 = a2 + kstep; const char* b3 = b2 + kstep;
            if (last && has_next) S.a_ready(nxt);
            if constexpr (SP2) {
            PG8_LDB(B0, 0, 0); PG8_LDB(B1, 0, 1); PG8_SCHED; PG8_LDA(At, 0, 0); PG8_STAGE(PG8_SA(1, 1), a1 + hstep, voffA);
            PG8_WAIT_V(8); PG8_WAIT_L(0); PG8_BAR; PG8_MMA(0, 0, At, B0); PG8_MMA(0, 1, At, B1); PG8_BAR; PG8_SCHED;
            PG8_LDA(At, 0, 1); PG8_STAGE(PG8_SB(0, 0), b2, voffB); PG8_STAGE(PG8_SB(0, 1), b2 + hstep, voffB); PG8_STAGE(PG8_SA(0, 0), a2, voffA);
            PG8_WAIT_V(8); PG8_WAIT_L(0); PG8_BAR; PG8_MMA(1, 0, At, B0); PG8_MMA(1, 1, At, B1); PG8_BAR; PG8_SCHED;
            PG8_LDB(B0, 1, 0); PG8_LDB(B1, 1, 1); PG8_SCHED; PG8_LDA(At, 1, 0); PG8_STAGE(PG8_SA(0, 1), a2 + hstep, voffA);
            PG8_WAIT_V(8); PG8_WAIT_L(0); PG8_BAR; PG8_MMA(0, 0, At, B0); PG8_MMA(0, 1, At, B1); PG8_BAR; PG8_SCHED;
            PG8_LDA(At, 1, 1); PG8_STAGE(PG8_SB(1, 0), b3, voffB); PG8_STAGE(PG8_SB(1, 1), b3 + hstep, voffB); PG8_STAGE(PG8_SA(1, 0), a3, voffA);
            PG8_WAIT_V(8); PG8_WAIT_L(0); PG8_BAR; PG8_MMA(1, 0, At, B0); PG8_MMA(1, 1, At, B1); PG8_BAR; PG8_SCHED;
            } else {
            PG8_LDB(B0, 0, 0); PG8_SCHED; PG8_LDA(At, 0, 0); PG8_STAGE(PG8_SA(1, 1), a1 + hstep, voffA);
            PG8_WAIT_L(8); PG8_BAR; PG8_WAIT_L(0); PG8_MMA(0, 0, At, B0); PG8_BAR; PG8_SCHED;
            PG8_LDB(B1, 0, 1); PG8_STAGE(PG8_SB(0, 0), b2, voffB);
            PG8_BAR; PG8_WAIT_L(0); PG8_MMA(0, 1, At, B1); PG8_BAR;
            PG8_LDA(At, 0, 1); PG8_STAGE(PG8_SA(0, 0), a2, voffA);
            PG8_BAR; PG8_WAIT_L(0); PG8_MMA(1, 0, At, B0); PG8_BAR; PG8_SCHED;
            PG8_STAGE(PG8_SB(0, 1), b2 + hstep, voffB);
            PG8_WAIT_V(6); PG8_BAR; PG8_MMA(1, 1, At, B1); PG8_BAR;
            PG8_LDB(B0, 1, 0); PG8_SCHED; PG8_LDA(At, 1, 0); PG8_STAGE(PG8_SA(0, 1), a2 + hstep, voffA);
            PG8_WAIT_L(8); PG8_BAR; PG8_WAIT_L(0); PG8_MMA(0, 0, At, B0); PG8_BAR; PG8_SCHED;
            PG8_LDB(B1, 1, 1); PG8_STAGE(PG8_SB(1, 0), b3, voffB);
            PG8_BAR; PG8_WAIT_L(0); PG8_MMA(0, 1, At, B1); PG8_BAR;
            PG8_LDA(At, 1, 1); PG8_STAGE(PG8_SA(1, 0), a3, voffA);
            PG8_BAR; PG8_WAIT_L(0); PG8_MMA(1, 0, At, B0); PG8_BAR; PG8_SCHED;
            PG8_STAGE(PG8_SB(1, 1), b3 + hstep, voffB);
            PG8_WAIT_V(6); PG8_BAR; PG8_MMA(1, 1, At, B1); PG8_BAR;
            }
        }
        if constexpr (ALIGN_EPI) { if (wr == 0) PG8_BAR; }
        if constexpr (!Epi::AFTER_DRAIN) { E(acc, cur, wr, wc, fr, fq); S.done(cur); }
        if (!has_next) break;
#pragma unroll
        for (int a = 0; a < 2; ++a)
#pragma unroll
            for (int b = 0; b < 2; ++b)
#pragma unroll
                for (int m = 0; m < 4; ++m)
#pragma unroll
                    for (int n = 0; n < 2; ++n) acc[a][b][m][n] = (f32x4){0.f, 0.f, 0.f, 0.f};
        cur = nxt; cA = nA; cB = nB; ++ui;
        if constexpr (ALIGN_EPI) { if (wr == 1) PG8_BAR; }
    }
    PG8_WAIT_V(0);
    if constexpr (!ALIGN_EPI) { if (wr == 0) PG8_BAR; }
    PG8_BAR;
    if constexpr (Epi::AFTER_DRAIN) { E.fused(acc, cur, wr, wc, fr, fq, lds, wid, lane); S.done(cur); }
#undef PG8_SA
#undef PG8_SB
#undef PG8_STAGE
#undef PG8_LDA
#undef PG8_LDB
#undef PG8_MMA
#undef PG8_WAIT_V
#undef PG8_WAIT_L
#undef PG8_BAR
#undef PG8_SCHED
}
}
#define GAS __attribute__((address_space(1)))
#define LAS __attribute__((address_space(3)))
typedef unsigned short bf16;
typedef unsigned v4u __attribute__((ext_vector_type(4)));
typedef float f32x4 __attribute__((ext_vector_type(4)));
typedef short bf16x8 __attribute__((ext_vector_type(8)));
typedef GAS unsigned gu32;
typedef GAS unsigned long long gu64;
#define RLX_AGENT __ATOMIC_RELAXED, __HIP_MEMORY_SCOPE_AGENT
#define LDS_WAIT() asm volatile("s_waitcnt lgkmcnt(0)" ::: "memory")
#define VM_WAIT() asm volatile("s_waitcnt vmcnt(0)" ::: "memory")
__device__ __forceinline__ unsigned long long rt() { return __builtin_amdgcn_s_memrealtime(); }
__device__ __forceinline__ unsigned f2bf(float f) { unsigned u = __builtin_bit_cast(unsigned, f); return (u + 0x7fffu + ((u >> 16) & 1u)) >> 16; }
__device__ __forceinline__ unsigned pk2(float lo, float hi) { return f2bf(lo) | (f2bf(hi) << 16); }

#define XB_TMO      128
#define XB_XCNT(j)  (256  + 64 * (j))
#define XB_XSUB(j)  (1280 + 64 * (j))
#define XB_XGEN(j)  (2304 + 64 * (j))
#define XB_TOP      3328
#define XB_TOPGEN   3392
#define XCD_BAR_WORDS 3456
#define XB_SPIN_CAP (1u << 18)

__device__ __forceinline__ unsigned xb_ld(unsigned* p)              { return __hip_atomic_load(p, __ATOMIC_RELAXED, __HIP_MEMORY_SCOPE_AGENT); }
__device__ __forceinline__ unsigned xb_add(unsigned* p, unsigned v) { return __hip_atomic_fetch_add(p, v, __ATOMIC_RELAXED, __HIP_MEMORY_SCOPE_AGENT); }
__device__ __forceinline__ unsigned xb_xcc_id() { return (unsigned)__builtin_amdgcn_s_getreg((3 << 11) | 20) & 0xFu; }
#define XB_SPIN(cond, bar) do { unsigned _sp = 0; while (cond) { __builtin_amdgcn_s_sleep(1); \
    if ((++_sp & 255u) == 0u) { if (xb_ld(&(bar)[XB_TMO])) break; if (_sp > XB_SPIN_CAP) { atomicAdd(&(bar)[XB_TMO], 1u); break; } } } } while (0)

struct XcdBarrier {
    unsigned* bar; unsigned x;
    volatile LAS unsigned* st;
};

__device__ __forceinline__ XcdBarrier xcd_barrier_post(unsigned* bar, volatile LAS unsigned* st) {
    XcdBarrier b; b.bar = bar; b.x = xb_xcc_id(); b.st = st;
    if (threadIdx.x == 0) (void)xb_add(&bar[XB_XCNT(b.x)], 1u);
    return b;
}
__device__ __forceinline__ void xcd_barrier_complete(unsigned* bar, unsigned x, unsigned& nloc, unsigned& nx) {
    const unsigned G = gridDim.x * gridDim.y * gridDim.z;
    unsigned sum, cnt, mine, sp = 0u;
    for (;;) {
        sum = 0u; cnt = 0u; mine = 0u;
#pragma unroll
        for (unsigned j = 0; j < 16; ++j) { const unsigned c = xb_ld(&bar[XB_XCNT(j)]); sum += c; cnt += (c > 0u) ? 1u : 0u; mine = (j == x) ? c : mine; }
        if (sum == G) break;
        __builtin_amdgcn_s_sleep(1);
        if ((++sp & 255u) == 0u) { if (xb_ld(&bar[XB_TMO])) break; if (sp > XB_SPIN_CAP) { atomicAdd(&bar[XB_TMO], 1u); break; } }
    }
    nloc = mine > 0u ? mine : 1u; nx = cnt > 0u ? cnt : 1u;
}

__device__ __forceinline__ void xcd_barrier(const XcdBarrier& b) {
    asm volatile("s_waitcnt vmcnt(0)" ::: "memory");
    __syncthreads();
    if (threadIdx.x == 0) {
        unsigned* bar = b.bar;
        __builtin_amdgcn_s_waitcnt(0);
        unsigned nloc = b.st[0], nx = b.st[1];
        if (nloc == 0u) { xcd_barrier_complete(bar, b.x, nloc, nx); b.st[0] = nloc; b.st[1] = nx; }
        const unsigned old = xb_add(&bar[XB_XSUB(b.x)], 1u);
        const unsigned gen = old / nloc;
        if (old + 1u == (gen + 1u) * nloc) {
            __builtin_amdgcn_fence(__ATOMIC_RELEASE, "agent");
            asm volatile("s_waitcnt vmcnt(0)" ::: "memory");
            const unsigned og = xb_add(&bar[XB_TOP], 1u);
            const unsigned tg = og / nx;
            if (og + 1u == (tg + 1u) * nx) xb_add(&bar[XB_TOPGEN], 1u);
            else XB_SPIN(xb_ld(&bar[XB_TOPGEN]) == tg, bar);
            __builtin_amdgcn_fence(__ATOMIC_ACQUIRE, "agent");
            xb_add(&bar[XB_XGEN(b.x)], 1u);
            asm volatile("s_waitcnt vmcnt(0)" ::: "memory");
        } else {
            XB_SPIN(xb_ld(&bar[XB_XGEN(b.x)]) == gen, bar);
            __builtin_amdgcn_fence(__ATOMIC_ACQUIRE, "agent");
            asm volatile("s_waitcnt vmcnt(0)" ::: "memory");
        }
    }
    __syncthreads();
}
constexpr float C2A = 0.125f * 1.4426950408889634f, C2C = 0.0625f * 1.4426950408889634f, LOG2E = 1.4426950408889634f;
namespace att {
typedef short bf16x8 __attribute__((ext_vector_type(8)));
typedef short s16x4 __attribute__((ext_vector_type(4)));
typedef float f32x16 __attribute__((ext_vector_type(16)));
typedef unsigned u32x4 __attribute__((ext_vector_type(4)));
typedef LAS const char* lds_cptr;
#define ATT_SBAR() __builtin_amdgcn_sched_barrier(0)
#define ATT_WAIT_BAR(N) asm volatile("s_waitcnt vmcnt(" #N ") lgkmcnt(0)\n\ts_barrier" ::: "memory")
__device__ __forceinline__ int crow(int r, int hi) { return (r & 3) + 8 * (r >> 2) + 4 * hi; }
__device__ __forceinline__ void glds16(const void* gsrc, unsigned lds_dst) { unsigned keep;
    asm volatile("s_mov_b32 %0, m0\n\ts_mov_b32 m0, %2\n\ts_nop 0\n\tglobal_load_lds_dwordx4 %1, off\n\ts_mov_b32 m0, %0" : "=&s"(keep) : "v"(gsrc), "s"(lds_dst) : "memory"); }
__device__ __forceinline__ float max3f(float a, float b, float c) { float r; asm("v_max3_f32 %0, %1, %2, %3" : "=v"(r) : "v"(a), "v"(b), "v"(c)); return r; }
typedef float f32x2_t __attribute__((ext_vector_type(2))); typedef __bf16 bf16x2_t __attribute__((ext_vector_type(2)));
__device__ __forceinline__ unsigned cvtpk_s(float lo, float hi) { f32x2_t v = {lo, hi}; bf16x2_t b = __builtin_convertvector(v, bf16x2_t); return __builtin_bit_cast(unsigned, b); }
template <int NKS, int CHUNK_STRIDE>
__device__ __forceinline__ void qkt(f32x16& p0, f32x16& p1, lds_cptr Kslot, const bf16x8* qr, const f32x16& c0, int r32, int hi) {
    lds_cptr kb = Kslot + hi * CHUNK_STRIDE + r32 * 16;
    p0 = c0; p1 = c0;
#pragma unroll
    for (int d0 = 0; d0 < NKS; ++d0) {
        const bf16x8 b0 = *(const LAS bf16x8*)(kb + d0 * 2 * CHUNK_STRIDE);
        const bf16x8 b1 = *(const LAS bf16x8*)(kb + d0 * 2 * CHUNK_STRIDE + 512);
        p0 = __builtin_amdgcn_mfma_f32_32x32x16_bf16(b0, qr[d0], p0, 0, 0, 0);
        p1 = __builtin_amdgcn_mfma_f32_32x32x16_bf16(b1, qr[d0], p1, 0, 0, 0);
    }
}
__device__ __forceinline__ float rowmax(const f32x16& p0, const f32x16& p1) {
    float a = max3f(p0[0], p0[1], p1[0]), b = max3f(p0[2], p0[3], p1[1]); a = max3f(a, p1[2], p1[3]);
#pragma unroll
    for (int r = 4; r < 16; r += 4) { a = max3f(a, p0[r], p0[r + 1]); b = max3f(b, p0[r + 2], p0[r + 3]); a = max3f(a, p1[r], p1[r + 1]); b = max3f(b, p1[r + 2], p1[r + 3]); }
    const float m = fmaxf(a, b);
    auto rr = __builtin_amdgcn_permlane32_swap(__float_as_uint(m), __float_as_uint(m), false, false);
    return fmaxf(__uint_as_float(rr[0]), __uint_as_float(rr[1]));
}
template <int ND>
__device__ __forceinline__ void pv(f32x16* o, int vb, bf16x8 pa0, bf16x8 pa1, bf16x8 pa2, bf16x8 pa3) {
#pragma unroll
    for (int d0 = 0; d0 < ND; ++d0) { s16x4 lo[4], hi[4];
#pragma unroll
        for (int ks = 0; ks < 4; ++ks) {
            asm volatile("ds_read_b64_tr_b16 %0,%1 offset:%c2" : "=&v"(lo[ks]) : "v"(vb), "i"(d0 * 4096 + ks * 1024) : "memory");
            asm volatile("ds_read_b64_tr_b16 %0,%1 offset:%c2" : "=&v"(hi[ks]) : "v"(vb), "i"(d0 * 4096 + ks * 1024 + 512) : "memory"); }
        asm volatile("s_waitcnt lgkmcnt(0)" ::: "memory"); ATT_SBAR();
#define ATT_PK(k) (bf16x8){lo[k][0], lo[k][1], lo[k][2], lo[k][3], hi[k][0], hi[k][1], hi[k][2], hi[k][3]}
        o[d0] = __builtin_amdgcn_mfma_f32_32x32x16_bf16(pa0, ATT_PK(0), o[d0], 0, 0, 0);
        o[d0] = __builtin_amdgcn_mfma_f32_32x32x16_bf16(pa1, ATT_PK(1), o[d0], 0, 0, 0);
        o[d0] = __builtin_amdgcn_mfma_f32_32x32x16_bf16(pa2, ATT_PK(2), o[d0], 0, 0, 0);
        o[d0] = __builtin_amdgcn_mfma_f32_32x32x16_bf16(pa3, ATT_PK(3), o[d0], 0, 0, 0);
#undef ATT_PK
    }
}
constexpr int A_K = 0, A_V = 16384, A_WS = 32768, A_BT = 34816, A_OST = 36864, A_BYTES = A_OST + 8 * 4096;
__device__ __forceinline__ void attnA_unit(int b, int h, int qb, bf16* QO, const bf16* KA, const bf16* VA, const float* relb, LAS unsigned char* L) {
    int tid = threadIdx.x; asm volatile("" : "+v"(tid));
    const int lane = tid & 63, r32 = lane & 31, hi = lane >> 5; const int wid = __builtin_amdgcn_readfirstlane(tid >> 6);
    const long rowbase = (long)b * 2048; const int q0 = qb * 256;
    bf16* Qw = QO + (rowbase + q0 + wid * 32) * 1024 + h * 64;
    const bf16 *Kh = KA + rowbase * 1024 + h * 64, *Vh = VA + rowbase * 1024 + h * 64;
    const unsigned lds0 = (unsigned)(uintptr_t)L;
    LAS float* wsf = (LAS float*)(L + A_WS) + wid * 64;
    LAS float* btab = (LAS float*)(L + A_BT);
    const bf16* ksrc = Kh + (long)lane * 1024 + wid * 8;
    const bf16* vsrc = Vh + (long)(16 * (wid & 3) + (lane >> 2)) * 1024 + (wid >> 2) * 32 + (lane & 3) * 8;
    const unsigned kdst = lds0 + A_K + wid * 1024, vdst = lds0 + A_V + wid * 1024;
#define DMA_K(t, slot) glds16(ksrc + (long)(t) * 64 * 1024, (unsigned)__builtin_amdgcn_readfirstlane(kdst + (slot)))
#define DMA_V(t, slot) glds16(vsrc + (long)(t) * 64 * 1024, (unsigned)__builtin_amdgcn_readfirstlane(vdst + (slot)))
    const int vb0 = (int)(lds0 + A_V) + ((lane >> 4) & 1) * 32 + (lane & 3) * 8 + (4 * hi + ((lane & 15) >> 2)) * 64;
    lds_cptr Kbase = (lds_cptr)(L + A_K);
    const int cq = 4 * qb + (wid >> 1), qi = 32 * (wid & 1) + r32;
    const int kc0 = (4 * qb - 8) > 0 ? (4 * qb - 8) : 0, kc1 = 4 * qb + 3;
    for (int i = tid; i < 257; i += 512) btab[i] = relb[h * 257 + i] * LOG2E;
    DMA_K(kc0, 0); DMA_V(kc0, 0);
    bf16x8 qr[4];
#pragma unroll
    for (int d0 = 0; d0 < 4; ++d0) qr[d0] = *reinterpret_cast<const bf16x8*>(&Qw[(long)r32 * 1024 + d0 * 16 + hi * 8]);
    float mhat = 0.f, l_run = 0.f; f32x16 o[2]; o[0] = f32x16{}; o[1] = f32x16{};
    bool first = true;
    ATT_WAIT_BAR(0);
    for (int kc = kc0; kc <= kc1; ++kc) {
        const int sl = ((kc - kc0) & 1) * 8192;
        if (kc < kc1) { DMA_K(kc + 1, sl ^ 8192); DMA_V(kc + 1, sl ^ 8192); }
        const int dC = cq - kc;
        if (dC >= 0 && dC <= 8) {
            const float c0v = ((dC >= 3) ? btab[256] : 0.f) - (first ? 0.f : mhat);
            f32x16 c0;
#pragma unroll
            for (int r = 0; r < 16; ++r) c0[r] = c0v;
            f32x16 p0, p1;
            qkt<4, 1024>(p0, p1, Kbase + sl, qr, c0, r32, hi);
            if (dC < 3) { const int base = 64 * dC + qi + 128;
#pragma unroll
                for (int r = 0; r < 16; ++r) { const int kj = crow(r, hi); int i0 = base - kj, i1 = base - kj - 32; i0 = i0 > 256 ? 256 : i0; i1 = i1 > 256 ? 256 : i1; p0[r] += btab[i0]; p1[r] += btab[i1]; }
            }
            const float rm = rowmax(p0, p1);
            if (first) {
                mhat = rm; first = false;
#pragma unroll
                for (int r = 0; r < 16; ++r) { p0[r] -= rm; p1[r] -= rm; }
            } else if (__any(rm > 8.f)) {
                const float dl = fmaxf(rm, 0.f); mhat += dl;
#pragma unroll
                for (int r = 0; r < 16; ++r) { p0[r] -= dl; p1[r] -= dl; }
                const float f = __builtin_amdgcn_exp2f(-dl); l_run *= f;
                if (hi == 0) wsf[r32] = f;
                asm volatile("s_waitcnt lgkmcnt(0)" ::: "memory");
#pragma unroll
                for (int r = 0; r < 16; ++r) { const float fr_ = wsf[crow(r, hi)]; o[0][r] *= fr_; o[1][r] *= fr_; }
            }
            float s = 0.f;
#pragma unroll
            for (int r = 0; r < 16; ++r) { p0[r] = __builtin_amdgcn_exp2f(p0[r]); p1[r] = __builtin_amdgcn_exp2f(p1[r]); s += p0[r] + p1[r]; }
            l_run += s;
            u32x4 pw0, pw1, pw2, pw3;
            pw0 = (u32x4){cvtpk_s(p0[0], p0[1]), cvtpk_s(p0[2], p0[3]), cvtpk_s(p0[4], p0[5]), cvtpk_s(p0[6], p0[7])};
            pw1 = (u32x4){cvtpk_s(p0[8], p0[9]), cvtpk_s(p0[10], p0[11]), cvtpk_s(p0[12], p0[13]), cvtpk_s(p0[14], p0[15])};
            pw2 = (u32x4){cvtpk_s(p1[0], p1[1]), cvtpk_s(p1[2], p1[3]), cvtpk_s(p1[4], p1[5]), cvtpk_s(p1[6], p1[7])};
            pw3 = (u32x4){cvtpk_s(p1[8], p1[9]), cvtpk_s(p1[10], p1[11]), cvtpk_s(p1[12], p1[13]), cvtpk_s(p1[14], p1[15])};
            ATT_SBAR();
            pv<2>(o, vb0 + sl, __builtin_bit_cast(bf16x8, pw0), __builtin_bit_cast(bf16x8, pw1), __builtin_bit_cast(bf16x8, pw2), __builtin_bit_cast(bf16x8, pw3));
        }
        ATT_WAIT_BAR(0);
    }
    { auto rr = __builtin_amdgcn_permlane32_swap(__float_as_uint(l_run), __float_as_uint(l_run), false, false); l_run = __uint_as_float(rr[0]) + __uint_as_float(rr[1]); }
    if (hi == 0) wsf[32 + r32] = l_run;
    asm volatile("s_waitcnt lgkmcnt(0)" ::: "memory");
    float rli[16];
#pragma unroll
    for (int r = 0; r < 16; ++r) rli[r] = __builtin_amdgcn_rcpf(wsf[32 + crow(r, hi)]);
    { LAS unsigned short* stg = (LAS unsigned short*)(L + A_OST) + wid * 2048;
#pragma unroll
        for (int r = 0; r < 16; ++r) { const int orow = crow(r, hi);
#pragma unroll
            for (int d0 = 0; d0 < 2; ++d0) stg[orow * 64 + d0 * 32 + r32] = (unsigned short)f2bf(o[d0][r] * rli[r]); }
        asm volatile("s_waitcnt lgkmcnt(0)" ::: "memory");
#pragma unroll
        for (int i = 0; i < 4; ++i) { const int row = i * 8 + (lane >> 3), ch = lane & 7; const u32x4 v = *(const LAS u32x4*)(stg + row * 64 + ch * 8); *(u32x4*)(Qw + (long)row * 1024 + ch * 8) = v; } }
    asm volatile("s_waitcnt lgkmcnt(0)\n\ts_barrier" ::: "memory");
#undef DMA_K
#undef DMA_V
}

constexpr int C_WS = 131072 + 1024;
__device__ __forceinline__ void attnC_unit(int b, int h, int qb, bf16* QO, const bf16* MK, const bf16* MV, LAS unsigned char* L) {
    int tid = threadIdx.x; asm volatile("" : "+v"(tid));
    const int lane = tid & 63, r32 = lane & 31, hi = lane >> 5; const int wid = __builtin_amdgcn_readfirstlane(tid >> 6);
    bf16* Qw = QO + ((long)b * 2048 + qb * 256 + wid * 32) * 1024 + h * 256;
    const bf16 *Kh = MK + (long)b * 256 * 1024 + h * 256, *Vh = MV + (long)b * 256 * 1024 + h * 256;
    const unsigned lds0 = (unsigned)(uintptr_t)L;
    LAS float* wsf = (LAS float*)(L + C_WS) + wid * 64;
#pragma unroll
    for (int j = 0; j < 16; ++j) { const int p = wid * 16 + j;
        glds16(Kh + (long)(64 * (p & 3) + lane) * 1024 + (p >> 2) * 8, (unsigned)__builtin_amdgcn_readfirstlane(lds0 + p * 1024)); }
    const bf16* qp = &Qw[(long)r32 * 1024 + hi * 8];
    bf16x8 qa[4], qb4[4];
#pragma unroll
    for (int i = 0; i < 4; ++i) qa[i] = *reinterpret_cast<const bf16x8*>(qp + i * 16);
    f32x16 S[8];
#pragma unroll
    for (int kt = 0; kt < 8; ++kt) S[kt] = f32x16{};
    ATT_WAIT_BAR(0);
    { lds_cptr kb = (lds_cptr)L + hi * 4096 + r32 * 16;
#define C_GROUP(QF, g) do { _Pragma("unroll") for (int i = 0; i < 4; ++i) { _Pragma("unroll") for (int kt = 0; kt < 8; ++kt) { \
            const bf16x8 kf = *(const LAS bf16x8*)(kb + ((g) * 4 + i) * 8192 + kt * 512); S[kt] = __builtin_amdgcn_mfma_f32_32x32x16_bf16(kf, QF[i], S[kt], 0, 0, 0); } } } while (0)
#pragma unroll
        for (int i = 0; i < 4; ++i) qb4[i] = *reinterpret_cast<const bf16x8*>(qp + (4 + i) * 16);
        C_GROUP(qa, 0);
#pragma unroll
        for (int i = 0; i < 4; ++i) qa[i] = *reinterpret_cast<const bf16x8*>(qp + (8 + i) * 16);
        C_GROUP(qb4, 1);
#pragma unroll
        for (int i = 0; i < 4; ++i) qb4[i] = *reinterpret_cast<const bf16x8*>(qp + (12 + i) * 16);
        C_GROUP(qa, 2);
        C_GROUP(qb4, 3);
#undef C_GROUP
    }
    float mx = -1e30f;
#pragma unroll
    for (int kt = 0; kt < 8; ++kt)
#pragma unroll
        for (int r = 0; r < 16; ++r) mx = fmaxf(mx, S[kt][r]);
    { auto rr = __builtin_amdgcn_permlane32_swap(__float_as_uint(mx), __float_as_uint(mx), false, false); mx = fmaxf(__uint_as_float(rr[0]), __uint_as_float(rr[1])); }
    float l_run = 0.f; bf16x8 pa[16];
#pragma unroll
    for (int kt = 0; kt < 8; ++kt) {
#pragma unroll
        for (int r = 0; r < 16; ++r) { S[kt][r] = __builtin_amdgcn_exp2f(S[kt][r] - mx); l_run += S[kt][r]; }
        const u32x4 w0 = (u32x4){cvtpk_s(S[kt][0], S[kt][1]), cvtpk_s(S[kt][2], S[kt][3]), cvtpk_s(S[kt][4], S[kt][5]), cvtpk_s(S[kt][6], S[kt][7])};
        const u32x4 w1 = (u32x4){cvtpk_s(S[kt][8], S[kt][9]), cvtpk_s(S[kt][10], S[kt][11]), cvtpk_s(S[kt][12], S[kt][13]), cvtpk_s(S[kt][14], S[kt][15])};
        pa[2 * kt] = __builtin_bit_cast(bf16x8, w0); pa[2 * kt + 1] = __builtin_bit_cast(bf16x8, w1);
    }
    ATT_WAIT_BAR(0);
#pragma unroll
    for (int j = 0; j < 16; ++j) { const int p = wid * 16 + j;
        glds16(Vh + (long)(16 * (p & 15) + (lane >> 2)) * 1024 + (p >> 4) * 32 + (lane & 3) * 8, (unsigned)__builtin_amdgcn_readfirstlane(lds0 + p * 1024)); }
    f32x16 o[8];
#pragma unroll
    for (int d0 = 0; d0 < 8; ++d0) o[d0] = f32x16{};
    ATT_WAIT_BAR(0);
    { const int vbA = (int)lds0 + ((lane >> 4) & 1) * 32 + (lane & 3) * 8 + (4 * hi + ((lane & 15) >> 2)) * 64, vbB = vbA + 65536;
#pragma unroll
        for (int s = 0; s < 16; ++s) {
#pragma unroll
            for (int d0 = 0; d0 < 8; ++d0) { s16x4 lo, hh;
                if (d0 < 4) { asm volatile("ds_read_b64_tr_b16 %0,%1 offset:%c2" : "=&v"(lo) : "v"(vbA), "i"((d0 & 3) * 16384 + s * 1024) : "memory");
                              asm volatile("ds_read_b64_tr_b16 %0,%1 offset:%c2" : "=&v"(hh) : "v"(vbA), "i"((d0 & 3) * 16384 + s * 1024 + 512) : "memory"); }
                else        { asm volatile("ds_read_b64_tr_b16 %0,%1 offset:%c2" : "=&v"(lo) : "v"(vbB), "i"((d0 & 3) * 16384 + s * 1024) : "memory");
                              asm volatile("ds_read_b64_tr_b16 %0,%1 offset:%c2" : "=&v"(hh) : "v"(vbB), "i"((d0 & 3) * 16384 + s * 1024 + 512) : "memory"); }
                asm volatile("s_waitcnt lgkmcnt(0)" : "+v"(lo), "+v"(hh) :: "memory"); ATT_SBAR();
                const bf16x8 vf = (bf16x8){lo[0], lo[1], lo[2], lo[3], hh[0], hh[1], hh[2], hh[3]};
                o[d0] = __builtin_amdgcn_mfma_f32_32x32x16_bf16(pa[s], vf, o[d0], 0, 0, 0); } } }
    { auto rr = __builtin_amdgcn_permlane32_swap(__float_as_uint(l_run), __float_as_uint(l_run), false, false); l_run = __uint_as_float(rr[0]) + __uint_as_float(rr[1]); }
    if (hi == 0) wsf[r32] = l_run;
    asm volatile("s_waitcnt lgkmcnt(0)" ::: "memory");
    float rli[16];
#pragma unroll
    for (int r = 0; r < 16; ++r) rli[r] = __builtin_amdgcn_rcpf(wsf[crow(r, hi)]);
    ATT_WAIT_BAR(0);
    { LAS unsigned short* stg = (LAS unsigned short*)L + wid * 8192;
#pragma unroll
        for (int r = 0; r < 16; ++r) { const int orow = crow(r, hi);
#pragma unroll
            for (int d0 = 0; d0 < 8; ++d0) stg[orow * 256 + d0 * 32 + r32] = (unsigned short)f2bf(o[d0][r] * rli[r]); }
        asm volatile("s_waitcnt lgkmcnt(0)" ::: "memory");
#pragma unroll
        for (int i = 0; i < 16; ++i) { const int row = i * 2 + (lane >> 5), ch = lane & 31; const u32x4 v = *(const LAS u32x4*)(stg + row * 256 + ch * 8); *(u32x4*)(Qw + (long)row * 1024 + ch * 8) = v; } }
    asm volatile("s_waitcnt lgkmcnt(0)\n\ts_barrier" ::: "memory");
}
}
namespace satt {
template <int D, int KT>
__device__ __forceinline__ void sattn_unit(LAS unsigned char* L, bf16* QO  , const float* Kc, const float* Vc  , int ncache,
                                           const bf16* Kn, const bf16* Vn  , int nnew, const float* btab  , float* copyK, float* copyV) {
    int tid = threadIdx.x; asm volatile("" : "+v"(tid));
    const int t = tid >> 5, jj = tid & 31;
    LAS float* Ks = (LAS float*)L; LAS float* Vs = Ks + KT * (D + 1); LAS float* Qs = Vs + KT * D; LAS float* Ps = Qs + 16 * D;
    const int nkeys = ncache + nnew, ntiles = (nkeys + KT - 1) / KT;
    __syncthreads();
    for (int i = tid; i < 16 * D; i += 512) Qs[i] = __uint_as_float(((unsigned)QO[(i / D) * 1024 + (i % D)]) << 16);
    float m_run = -1e30f, l_run = 0.f; float o[D / 32];
#pragma unroll
    for (int i = 0; i < D / 32; ++i) o[i] = 0.f;
    for (int tile = 0; tile < ntiles; ++tile) {
        __syncthreads();
        for (int idx = tid; idx < KT * D / 4; idx += 512) {
            const int j = idx / (D / 4), c4 = (idx % (D / 4)) * 4, key = tile * KT + j;
            float4 kv = make_float4(0.f, 0.f, 0.f, 0.f), vv = kv;
            if (key < ncache) { kv = *(const float4*)(Kc + (size_t)key * 1024 + c4); vv = *(const float4*)(Vc + (size_t)key * 1024 + c4);
                if (copyK && key >= 16) { *(float4*)(copyK + (size_t)(key - 16) * 1024 + c4) = kv; *(float4*)(copyV + (size_t)(key - 16) * 1024 + c4) = vv; } }
            else if (key < nkeys) { const uint2 a = *(const uint2*)(Kn + (size_t)(key - ncache) * 1024 + c4), b = *(const uint2*)(Vn + (size_t)(key - ncache) * 1024 + c4);
                kv = make_float4(__uint_as_float(a.x << 16), __uint_as_float(a.x & 0xffff0000u), __uint_as_float(a.y << 16), __uint_as_float(a.y & 0xffff0000u));
                vv = make_float4(__uint_as_float(b.x << 16), __uint_as_float(b.x & 0xffff0000u), __uint_as_float(b.y << 16), __uint_as_float(b.y & 0xffff0000u)); }
            LAS float* kd = Ks + j * (D + 1) + c4; kd[0] = kv.x; kd[1] = kv.y; kd[2] = kv.z; kd[3] = kv.w;
            *(LAS f32x4*)(Vs + j * D + c4) = (f32x4){vv.x, vv.y, vv.z, vv.w};
        }
        __syncthreads();
        float sc[KT / 32]; float tmax = -1e30f;
#pragma unroll
        for (int kk = 0; kk < KT / 32; ++kk) {
            const int j = jj + 32 * kk, key = tile * KT + j; float s = 0.f;
            const LAS float* qp = Qs + t * D; const LAS float* kp = Ks + j * (D + 1);
#pragma unroll 8
            for (int d = 0; d < D; ++d) s += qp[d] * kp[d];
            if (key >= nkeys) s = -1e30f;
            else if (btab) { int dd = 512 + t - key; dd = dd > 128 ? 128 : dd; s += btab[dd + 128] * LOG2E; }
            sc[kk] = s; tmax = fmaxf(tmax, s);
        }
#pragma unroll
        for (int o_ = 1; o_ < 32; o_ <<= 1) tmax = fmaxf(tmax, __shfl_xor(tmax, o_));
        const float mn = fmaxf(m_run, tmax), alpha = __builtin_amdgcn_exp2f(m_run - mn);
        float ps = 0.f;
#pragma unroll
        for (int kk = 0; kk < KT / 32; ++kk) { const float p = (sc[kk] <= -1e29f) ? 0.f : __builtin_amdgcn_exp2f(sc[kk] - mn); Ps[t * KT + jj + 32 * kk] = p; ps += p; }
#pragma unroll
        for (int o_ = 1; o_ < 32; o_ <<= 1) ps += __shfl_xor(ps, o_);
        l_run = l_run * alpha + ps; m_run = mn;
#pragma unroll
        for (int i = 0; i < D / 32; ++i) o[i] *= alpha;
        __syncthreads();
        for (int j = 0; j < KT; ++j) { const float pj = Ps[t * KT + j];
#pragma unroll
            for (int i = 0; i < D / 32; ++i) o[i] += pj * Vs[j * D + jj + 32 * i]; }
    }
    const float rl = 1.f / l_run;
#pragma unroll
    for (int i = 0; i < D / 32; ++i) QO[t * 1024 + jj + 32 * i] = (bf16)f2bf(o[i] * rl);
    __syncthreads();
}
}
namespace gdn {
typedef short bf16x8 __attribute__((ext_vector_type(8)));
typedef short s16x4 __attribute__((ext_vector_type(4)));
typedef float f32x4 __attribute__((ext_vector_type(4)));
typedef unsigned u32x2 __attribute__((ext_vector_type(2)));
typedef unsigned u32x4 __attribute__((ext_vector_type(4)));
constexpr int QN = 0, KN = 17408  , KNT = 34816, VT = 53248  , ABF = 71680, AQK = 80896, DBF = 90112, AD = 92160, ST = 96512,
              GV = 131328, BETA = GV + 256, EGT = GV + 512, EGR = GV + 768, BEG = GV + 1024, CARRY = GV + 1280, RMS = CARRY + 4608, NB = RMS + 1024, G_END = NB + 6144;
constexpr int S272 = 272, S144 = 144;
__device__ __forceinline__ float bf2f(short s) { return __uint_as_float(((unsigned)(unsigned short)s) << 16); }
__device__ __forceinline__ unsigned pk(float lo, float hi) { return att::cvtpk_s(lo, hi); }
__device__ __forceinline__ s16x4 pk4(const f32x4& v) { u32x2 w; w.x = pk(v[0], v[1]); w.y = pk(v[2], v[3]); return __builtin_bit_cast(s16x4, w); }
__device__ __forceinline__ s16x4 pk4n(const f32x4& v) { u32x2 w; w.x = pk(-v[0], -v[1]); w.y = pk(-v[2], -v[3]); return __builtin_bit_cast(s16x4, w); }
#define G_MMA32(a, b, c) __builtin_amdgcn_mfma_f32_16x16x32_bf16(a, b, c, 0, 0, 0)
#define G_MMA16(a, b, c) __builtin_amdgcn_mfma_f32_16x16x16bf16_1k(a, b, c, 0, 0, 0)
#define G_FRAG8(base, stride, row, kb) (*(const LAS bf16x8*)((base) + (row) * (stride) + (kb)))

#define DBG_FLAG(k, cond) do {} while (0)
#define DBG_X(k) do {} while (0)
__device__ __forceinline__ void gdn_unit(LAS unsigned char* L, const bf16* QKVB, bf16* OB, const float* AB, long row0, int h, int nchunks, int nvalid,
                                         const float* alog, const float* dtb, const float* normg, const float* S0, float* Sout, unsigned long long* tsum = nullptr) {
    unsigned long long tacc0 = 0, tacc1 = 0, tacc2 = 0, tacc3 = 0, tacc4 = 0, tlast = 0;
#define GT_MARK(v) do { if (tsum) { const unsigned long long n_ = __builtin_amdgcn_s_memrealtime(); v += n_ - tlast; tlast = n_; } } while (0)
    int tid0 = threadIdx.x; asm volatile("" : "+v"(tid0));
    const int wave = __builtin_amdgcn_readfirstlane(tid0 >> 6), wq = wave & 3; const bool grpA = wave < 4;
    const float alog_h = alog[h], dtb_h = dtb[h];
    LAS float* fGV = (LAS float*)(L + GV); LAS float* fBETA = (LAS float*)(L + BETA); LAS float* fEGT = (LAS float*)(L + EGT); LAS float* fEGR = (LAS float*)(L + EGR); LAS float* fBEG = (LAS float*)(L + BEG);
    LAS float* fRMS = (LAS float*)(L + RMS);
    f32x4 Sreg[8][2];
    u32x4 pfq[2], pfk[2], pfv[2]; float pfa = 0.f, pfb = 0.f;
#define G_ISSUE(cn) do { const long r0_ = row0 + (long)(cn) * 64; _Pragma("unroll") for (int i_ = 0; i_ < 2; ++i_) { const int idx_ = (int)(threadIdx.x) + 512 * i_, row_ = idx_ >> 4, ch_ = idx_ & 15; \
        unsigned z_ = 0u; asm volatile("" : "+v"(z_)); pfq[i_] = (u32x4){z_, z_, z_, z_}; pfk[i_] = pfq[i_]; pfv[i_] = pfq[i_]; \
        if (row_ < nvalid) { const bf16* b_ = QKVB + (r0_ + row_) * 3072 + h * 128 + ch_ * 8; pfq[i_] = *(const u32x4*)b_; pfk[i_] = *(const u32x4*)(b_ + 1024); pfv[i_] = *(const u32x4*)(b_ + 2048); } } \
        if (wave == 0) { const int ln_ = (int)(threadIdx.x) & 63; pfa = 0.f; pfb = 0.f; if (ln_ < nvalid) { const float* ab_ = AB + (r0_ + ln_) * 16; pfa = ab_[h]; pfb = ab_[8 + h]; } } } while (0)
    {
    const int tid = tid0, lane = tid & 63, lr = lane & 15, lg = lane >> 4;
    for (int i = tid; i < 9216 / 4; i += 512) ((LAS unsigned*)(L + AQK))[i] = 0u;
    if (grpA) {
#pragma unroll
        for (int j = 0; j < 8; ++j)
#pragma unroll
            for (int ct = 0; ct < 2; ++ct) { f32x4 v = (f32x4){0.f, 0.f, 0.f, 0.f};
                if (S0) {
#pragma unroll
                    for (int e = 0; e < 4; ++e) v[e] = S0[(size_t)(16 * j + 4 * lg + e) * 128 + 32 * wq + 16 * ct + lr]; }
                Sreg[j][ct] = v;
                *(LAS s16x4*)(L + ST + (32 * wq + 16 * ct + lr) * S272 + (16 * j + 4 * lg) * 2) = pk4(v); }
    }
    }
    G_ISSUE(0);
    __syncthreads();
    for (int c = 0; c < nchunks; ++c) {
        const long crow0 = row0 + (long)c * 64;
        if (tsum && c == 0) tlast = __builtin_amdgcn_s_memrealtime();
        int tid = threadIdx.x; asm volatile("" : "+v"(tid));
        const int lane = tid & 63, lr = lane & 15, lg = lane >> 4;
        if (wave == 0) {
            float g = 0.f, beta = 0.f;
            if (lane < nvalid) { const float a = pfa + dtb_h; const float sp = a > 20.f ? a : log1pf(__expf(a)); g = -__expf(alog_h) * sp; beta = 1.f / (1.f + __expf(-pfb)); }
            float G = g;
#pragma unroll
            for (int o = 1; o < 64; o <<= 1) { const float n = __shfl_up(G, o); if (lane >= o) G += n; }
            const float G63 = __shfl(G, 63);
            fGV[lane] = G; fBETA[lane] = beta; fEGT[lane] = __expf(G); fEGR[lane] = __expf(G63 - G); fBEG[lane] = beta * __expf(G);
        }
#pragma unroll
        for (int i = 0; i < 2; ++i) { const int idx = tid + 512 * i, row = idx >> 4, ch = idx & 15;
            *(LAS u32x4*)(L + QN + row * S272 + ch * 16) = pfq[i]; *(LAS u32x4*)(L + KN + row * S272 + ch * 16) = pfk[i];
#pragma unroll
            for (int e = 0; e < 8; ++e) { const unsigned wk = pfk[i][e >> 1], wv = pfv[i][e >> 1];
                *(LAS unsigned short*)(L + KNT + (ch * 8 + e) * S144 + row * 2) = (unsigned short)((e & 1) ? (wk >> 16) : (wk & 0xffffu));
                *(LAS unsigned short*)(L + VT + (ch * 8 + e) * S144 + row * 2) = (unsigned short)((e & 1) ? (wv >> 16) : (wv & 0xffffu)); } }
        if (c + 1 < nchunks) G_ISSUE(c + 1);
        __syncthreads();
        GT_MARK(tacc0);
        if (grpA) {
            const int ri = wave;
            f32x4 acc = (f32x4){0.f, 0.f, 0.f, 0.f};
#pragma unroll
            for (int ks = 0; ks < 4; ++ks) { const bf16x8 a = G_FRAG8(L + KN, S272, 16 * ri + lr, ks * 64 + lg * 16); acc = G_MMA32(a, a, acc); }
            const float Gs = fGV[16 * ri + lr];
            const f32x4 Gt = *(const LAS f32x4*)(fGV + 16 * ri + 4 * lg), Bt = *(const LAS f32x4*)(fBETA + 16 * ri + 4 * lg);
            f32x4 n1;
#pragma unroll
            for (int e = 0; e < 4; ++e) n1[e] = (lr < 4 * lg + e) ? -acc[e] * Bt[e] * __expf(Gt[e] - Gs) : 0.f;
            LAS unsigned char* nb = L + NB + wave * 1536;
#define G_NBW(off, v) do { _Pragma("unroll") for (int e_ = 0; e_ < 4; ++e_) *(LAS unsigned short*)(nb + (off) + (4 * lg + e_) * 32 + lr * 2) = (unsigned short)f2bf((v)[e_]); } while (0)
#define G_NBR(off) (*(const LAS s16x4*)(nb + (off) + lr * 32 + lg * 8))
            const f32x4 z4 = (f32x4){0.f, 0.f, 0.f, 0.f};
            G_NBW(0, n1);
            const s16x4 a1 = G_NBR(0);
            f32x4 n2 = G_MMA16(a1, pk4(n1), z4);
            G_NBW(512, n2);
            const s16x4 a2 = G_NBR(512);
            f32x4 n4 = G_MMA16(a2, pk4(n2), z4);
            G_NBW(1024, n4);
            const s16x4 a4 = G_NBR(1024);
            f32x4 R = G_MMA16(a4, pk4(n4), z4);
#pragma unroll
            for (int e = 0; e < 4; ++e) R[e] += (lr == 4 * lg + e) ? 1.f : 0.f;
            R = G_MMA16(a4, pk4(R), R);
            R = G_MMA16(a2, pk4(R), R);
            R = G_MMA16(a1, pk4(R), R);
#pragma unroll
            for (int e = 0; e < 4; ++e) *(LAS unsigned short*)(L + DBF + (16 * ri + 4 * lg + e) * 32 + lr * 2) = (unsigned short)f2bf(R[e]);
#undef G_NBW
#undef G_NBR
        } else {
            for (int it = 0; it < 4; ++it) {
                const int idx0 = (wave - 4) + 4 * it; const bool isqk = idx0 >= 6; const int idx = isqk ? idx0 - 6 : idx0 + 1;
                int ri, cj;
                if (isqk) { ri = idx < 1 ? 0 : (idx < 3 ? 1 : (idx < 6 ? 2 : 3)); cj = idx < 1 ? 0 : (idx < 3 ? idx - 1 : (idx < 6 ? idx - 3 : idx - 6)); }
                else { const int k = idx0; ri = k < 1 ? 1 : (k < 3 ? 2 : 3); cj = k < 1 ? 0 : (k < 3 ? k - 1 : k - 3); }
                f32x4 acc = (f32x4){0.f, 0.f, 0.f, 0.f};
                LAS const unsigned char* Abase = L + (isqk ? QN : KN);
#pragma unroll
                for (int ks = 0; ks < 4; ++ks) { const bf16x8 a = G_FRAG8(Abase, S272, 16 * ri + lr, ks * 64 + lg * 16), b = G_FRAG8(L + KN, S272, 16 * cj + lr, ks * 64 + lg * 16); acc = G_MMA32(a, b, acc); }
                const int s = 16 * cj + lr; const float Gs = fGV[s];
                const f32x4 Gt = *(const LAS f32x4*)(fGV + 16 * ri + 4 * lg), Bt = *(const LAS f32x4*)(fBETA + 16 * ri + 4 * lg);
#pragma unroll
                for (int e = 0; e < 4; ++e) { const int tt = 16 * ri + 4 * lg + e;
                    if (isqk) { const float v = (s <= tt) ? acc[e] * __expf(Gt[e] - Gs) : 0.f; *(LAS unsigned short*)(L + AQK + tt * S144 + s * 2) = (unsigned short)f2bf(v); }
                    else { const float v = -acc[e] * Bt[e] * __expf(Gt[e] - Gs); *(LAS unsigned short*)(L + ABF + tt * S144 + s * 2) = (unsigned short)f2bf(v); } }
            }
        }
        __syncthreads();
        GT_MARK(tacc1);
        f32x4 X[4][2];
        {
            LAS const unsigned char* SRC = L + (grpA ? VT : KNT); LAS const float* SCL = grpA ? fBETA : fBEG;
            s16x4 Xb[4][2];
#pragma unroll
            for (int i = 0; i < 4; ++i) {
                const f32x4 sc = *(const LAS f32x4*)(SCL + 16 * i + 4 * lg);
#pragma unroll
                for (int ct = 0; ct < 2; ++ct) { const s16x4 raw = *(const LAS s16x4*)(SRC + (32 * wq + 16 * ct + lr) * S144 + (16 * i + 4 * lg) * 2);
                    X[i][ct] = (f32x4){bf2f(raw[0]) * sc[0], bf2f(raw[1]) * sc[1], bf2f(raw[2]) * sc[2], bf2f(raw[3]) * sc[3]}; }
            }
#pragma unroll
            for (int i = 0; i < 4; ++i) {
#pragma unroll
                for (int k = 0; k < i; ++k) { const s16x4 a = *(const LAS s16x4*)(L + ABF + (16 * i + lr) * S144 + (16 * k + 4 * lg) * 2);
#pragma unroll
                    for (int ct = 0; ct < 2; ++ct) X[i][ct] = G_MMA16(a, Xb[k][ct], X[i][ct]); }
                const s16x4 d = *(const LAS s16x4*)(L + DBF + (16 * i + lr) * 32 + (4 * lg) * 2);
#pragma unroll
                for (int ct = 0; ct < 2; ++ct) { const s16x4 tb = pk4(X[i][ct]); X[i][ct] = G_MMA16(d, tb, ((f32x4){0.f, 0.f, 0.f, 0.f})); Xb[i][ct] = pk4(X[i][ct]); }
            }
            if (!grpA) {
#pragma unroll
                for (int i = 0; i < 4; ++i)
#pragma unroll
                    for (int ct = 0; ct < 2; ++ct)
#pragma unroll
                        for (int e = 0; e < 4; ++e) *(LAS unsigned short*)(L + KN + (16 * i + 4 * lg + e) * S272 + (32 * wq + 16 * ct + lr) * 2) = (unsigned short)f2bf(-X[i][ct][e]);
            }
        }
        DBG_X(2);
        __syncthreads();
        GT_MARK(tacc2);
        {
            bf16x8 bS[2][4];
#pragma unroll
            for (int ct = 0; ct < 2; ++ct)
#pragma unroll
                for (int ks = 0; ks < 4; ++ks) bS[ct][ks] = G_FRAG8(L + ST, S272, 32 * wq + 16 * ct + lr, ks * 64 + lg * 16);
            LAS const unsigned char* Abase = L + (grpA ? KN : QN);
            if (!grpA) {
#pragma unroll
                for (int i = 0; i < 4; ++i) { X[i][0] = (f32x4){0.f, 0.f, 0.f, 0.f}; X[i][1] = (f32x4){0.f, 0.f, 0.f, 0.f}; } }
#pragma unroll
            for (int i = 0; i < 4; ++i)
#pragma unroll
                for (int ks = 0; ks < 4; ++ks) { const bf16x8 a = G_FRAG8(Abase, S272, 16 * i + lr, ks * 64 + lg * 16);
#pragma unroll
                    for (int ct = 0; ct < 2; ++ct) X[i][ct] = G_MMA32(a, bS[ct][ks], X[i][ct]); }
            if (grpA) {
#pragma unroll
                for (int i = 0; i < 4; ++i)
#pragma unroll
                    for (int ct = 0; ct < 2; ++ct) *(LAS s16x4*)(L + VT + (32 * wq + 16 * ct + lr) * S144 + (16 * i + 4 * lg) * 2) = pk4(X[i][ct]);
            }
        }
        DBG_X(3);
        __syncthreads();
        GT_MARK(tacc3);
        if (grpA) {
            const float eg63 = fEGT[63];
            bf16x8 bsc[2][2];
#pragma unroll
            for (int ct = 0; ct < 2; ++ct)
#pragma unroll
                for (int ks = 0; ks < 2; ++ks) { const bf16x8 raw = G_FRAG8(L + VT, S144, 32 * wq + 16 * ct + lr, ks * 64 + lg * 16);
                    const f32x4 e0 = *(const LAS f32x4*)(fEGR + 32 * ks + 8 * lg), e1 = *(const LAS f32x4*)(fEGR + 32 * ks + 8 * lg + 4);
                    const u32x4 w = (u32x4){pk(bf2f(raw[0]) * e0[0], bf2f(raw[1]) * e0[1]), pk(bf2f(raw[2]) * e0[2], bf2f(raw[3]) * e0[3]), pk(bf2f(raw[4]) * e1[0], bf2f(raw[5]) * e1[1]), pk(bf2f(raw[6]) * e1[2], bf2f(raw[7]) * e1[3])};
                    bsc[ct][ks] = __builtin_bit_cast(bf16x8, w); }
#pragma unroll
            for (int j = 0; j < 8; ++j) {
#pragma unroll
                for (int ct = 0; ct < 2; ++ct) Sreg[j][ct] = Sreg[j][ct] * eg63;
#pragma unroll
                for (int ks = 0; ks < 2; ++ks) { const bf16x8 a = G_FRAG8(L + KNT, S144, 16 * j + lr, ks * 64 + lg * 16);
#pragma unroll
                    for (int ct = 0; ct < 2; ++ct) Sreg[j][ct] = G_MMA32(a, bsc[ct][ks], Sreg[j][ct]); }
#pragma unroll
                for (int ct = 0; ct < 2; ++ct) *(LAS s16x4*)(L + ST + (32 * wq + 16 * ct + lr) * S272 + (16 * j + 4 * lg) * 2) = pk4(Sreg[j][ct]);
            }
            __syncthreads();
        } else {
            f32x4 O2[4][2];
#pragma unroll
            for (int i = 0; i < 4; ++i) { O2[i][0] = (f32x4){0.f, 0.f, 0.f, 0.f}; O2[i][1] = (f32x4){0.f, 0.f, 0.f, 0.f}; }
            bf16x8 bW[2][2];
#pragma unroll
            for (int ct = 0; ct < 2; ++ct)
#pragma unroll
                for (int ks = 0; ks < 2; ++ks) bW[ct][ks] = G_FRAG8(L + VT, S144, 32 * wq + 16 * ct + lr, ks * 64 + lg * 16);
#pragma unroll
            for (int i = 0; i < 4; ++i)
#pragma unroll
                for (int ks = 0; ks < 2; ++ks) { const bf16x8 a = G_FRAG8(L + AQK, S144, 16 * i + lr, ks * 64 + lg * 16);
#pragma unroll
                    for (int ct = 0; ct < 2; ++ct) O2[i][ct] = G_MMA32(a, bW[ct][ks], O2[i][ct]); }
#pragma unroll
            for (int i = 0; i < 4; ++i) { const f32x4 eg = *(const LAS f32x4*)(fEGT + 16 * i + 4 * lg);
#pragma unroll
                for (int ct = 0; ct < 2; ++ct) X[i][ct] = X[i][ct] * eg + O2[i][ct];
                f32x4 p = X[i][0] * X[i][0] + X[i][1] * X[i][1];
#pragma unroll
                for (int e = 0; e < 4; ++e) { float v = p[e]; v += __shfl_xor(v, 1); v += __shfl_xor(v, 2); v += __shfl_xor(v, 4); v += __shfl_xor(v, 8); p[e] = v; }
                if (lr == 0) {
#pragma unroll
                    for (int e = 0; e < 4; ++e) fRMS[(16 * i + 4 * lg + e) * 4 + wq] = p[e]; } }
            DBG_X(4);
            __syncthreads();
            const float ng0 = normg[32 * wq + lr], ng1 = normg[32 * wq + 16 + lr];
#pragma unroll
            for (int i = 0; i < 4; ++i)
#pragma unroll
                for (int e = 0; e < 4; ++e) { const int tt = 16 * i + 4 * lg + e;
                    const f32x4 pr = *(const LAS f32x4*)(fRMS + tt * 4); const float rstd = rsqrtf((pr[0] + pr[1] + pr[2] + pr[3]) * (1.f / 128.f) + 1e-6f);
                    if (tt < nvalid) { bf16* orow = OB + (crow0 + tt) * 3072 + h * 128 + 32 * wq + lr;
                        orow[0] = (bf16)f2bf(X[i][0][e] * rstd * ng0); orow[16] = (bf16)f2bf(X[i][1][e] * rstd * ng1); } }
        }
        GT_MARK(tacc4);
    }
    if (grpA) {
        const int lane = tid0 & 63, lr = lane & 15, lg = lane >> 4;
#pragma unroll
        for (int j = 0; j < 8; ++j)
#pragma unroll
            for (int ct = 0; ct < 2; ++ct)
#pragma unroll
                for (int e = 0; e < 4; ++e) Sout[(size_t)(16 * j + 4 * lg + e) * 128 + 32 * wq + 16 * ct + lr] = Sreg[j][ct][e];
    }
    __syncthreads();
    if (tsum && threadIdx.x == 0) { tsum[0] = tacc0; tsum[1] = tacc1; tsum[2] = tacc2; tsum[3] = tacc3; tsum[4] = tacc4; tsum[5] = tacc0 + tacc1 + tacc2 + tacc3 + tacc4; }
}
#undef GT_MARK
#undef G_ISSUE

__device__ __forceinline__ void conv_unit(bf16* QKVB, const bf16* SB, const float* wconv, const float* convst, long r0, int nrows, int sbrow, int op) {
    int tid = threadIdx.x; asm volatile("" : "+v"(tid));
    const int cg = tid & 127, seg = tid >> 7, col = op * 1024 + cg * 8;
    const bool act = seg * 8 < nrows;
    bf16x8 x[11];
#pragma unroll
    for (int i = 0; i < 11; ++i) x[i] = (bf16x8){0, 0, 0, 0, 0, 0, 0, 0};
    if (act) {
#pragma unroll
        for (int j = 0; j < 3; ++j) {
            if (seg > 0) x[j] = *(const bf16x8*)(QKVB + (r0 + 8 * seg - 3 + j) * 3072 + col);
            else if (sbrow >= 0) x[j] = *(const bf16x8*)(SB + (size_t)(sbrow + j) * 3072 + col);
            else if (convst) { const f32x4 a = *(const f32x4*)(convst + j * 3072 + col), b = *(const f32x4*)(convst + j * 3072 + col + 4);
                const u32x4 w = (u32x4){pk(a[0], a[1]), pk(a[2], a[3]), pk(b[0], b[1]), pk(b[2], b[3])}; x[j] = __builtin_bit_cast(bf16x8, w); }
        }
#pragma unroll
        for (int i = 0; i < 8; ++i) x[3 + i] = *(const bf16x8*)(QKVB + (r0 + 8 * seg + i) * 3072 + col);
    }
    f32x4 w0[4], w1[4];
#pragma unroll
    for (int j = 0; j < 4; ++j) { w0[j] = *(const f32x4*)(wconv + j * 3072 + col); w1[j] = *(const f32x4*)(wconv + j * 3072 + col + 4); }
    __syncthreads();
    if (act) {
#pragma unroll
        for (int i = 0; i < 8; ++i) {
            float y[8];
#pragma unroll
            for (int e = 0; e < 8; ++e) y[e] = 0.f;
#pragma unroll
            for (int j = 0; j < 4; ++j) {
#pragma unroll
                for (int e = 0; e < 4; ++e) { y[e] += w0[j][e] * bf2f(x[i + j][e]); y[4 + e] += w1[j][e] * bf2f(x[i + j][4 + e]); } }
            float ss = 0.f;
#pragma unroll
            for (int e = 0; e < 8; ++e) { y[e] = y[e] * __builtin_amdgcn_rcpf(1.f + __expf(-y[e])); ss += y[e] * y[e]; }
            float r = 1.f;
            if (op < 2) { ss += __shfl_xor(ss, 1); ss += __shfl_xor(ss, 2); ss += __shfl_xor(ss, 4); ss += __shfl_xor(ss, 8); r = rsqrtf(ss + 1e-6f); if (op == 0) r *= 0.08838834764831845f; }
            const u32x4 w = (u32x4){pk(y[0] * r, y[1] * r), pk(y[2] * r, y[3] * r), pk(y[4] * r, y[5] * r), pk(y[6] * r, y[7] * r)};
            *(u32x4*)(QKVB + (r0 + 8 * seg + i) * 3072 + col) = w;
        }
    }
    __syncthreads();
}
#undef G_MMA32
#undef G_MMA16
#undef G_FRAG8
}
constexpr int NWAVES = 8;
constexpr int R_P = 32768, R_S = 512, R_ALL = 33280;
constexpr size_t MiB = 1u << 20;
constexpr size_t WS_CTL = 0, CTL_ZERO_BYTES = 1 * MiB;
constexpr size_t WS_WIN = 1 * MiB;
constexpr size_t WS_WG = 16 * MiB;
constexpr size_t WS_WMEM = 22 * MiB;
constexpr size_t WS_WOUT = 26 * MiB;
constexpr size_t WS_WFF1 = 28 * MiB;
constexpr size_t WS_WFF2 = 36 * MiB;
constexpr size_t WS_AB = 44 * MiB;
constexpr size_t WS_MK = 47 * MiB, WS_MV = 55 * MiB, WS_MB = 63 * MiB;
constexpr size_t WS_QA = 72 * MiB, WS_KA = 138 * MiB, WS_VA = 204 * MiB;
constexpr size_t WS_QKVB = 270 * MiB;
constexpr size_t WS_SB = 466 * MiB;
constexpr size_t WS_SMG = 486 * MiB, WS_ST1 = 487 * MiB, WS_SHB = 489 * MiB, WS_SFF = 490 * MiB;
constexpr size_t WS_END = 494 * MiB;
constexpr size_t DO_XB = 0, DO_QC = 65 * MiB;
constexpr int CW_BAR = 4096;
constexpr int CW_CHK = 1024;
constexpr int CW_QUEUE = 2048;
constexpr int CW_SC = 8192;
constexpr int CW_TS = 3072;
constexpr int LDS_BYTES = 147456, RING_BYTES = 131072, MISC_OFF = LDS_BYTES - 256;

struct Args { const float* in[25]; float* out; unsigned char* ws; int ph_lo, ph_hi; };

__device__ __forceinline__ void p0_transpose_item(const float* W, int K, int N, int col_off, int nvalid, bf16* WT, int row_off, int nblk, LAS float* scr, int item, int lane) {
    const int kb = item / nblk, nb = item % nblk, k0 = 64 * kb, n0 = 32 * nb;
    const bool ok = (n0 + (lane & 31)) < nvalid;
#pragma unroll 8
    for (int i = 0; i < 32; ++i) { const int kk = 2 * i + (lane >> 5); scr[kk * 33 + (lane & 31)] = ok ? W[(size_t)(k0 + kk) * N + col_off + n0 + (lane & 31)] : 0.f; }
    LDS_WAIT(); asm volatile("" ::: "memory");
    const int c = lane & 7;
#pragma unroll
    for (int j = 0; j < 4; ++j) { const int n = (lane >> 3) + 8 * j; const LAS float* s = scr + (8 * c) * 33 + n;
        v4u o; o.x = pk2(s[0 * 33], s[1 * 33]); o.y = pk2(s[2 * 33], s[3 * 33]); o.z = pk2(s[4 * 33], s[5 * 33]); o.w = pk2(s[6 * 33], s[7 * 33]);
        *(GAS v4u*)(WT + (size_t)(row_off + n0 + n) * K + k0 + 8 * c) = o; }
    LDS_WAIT(); asm volatile("" ::: "memory");
}
__device__ __forceinline__ void cvt_row_bf16(const float* xrow, bf16* orow, int lane) {
    const GAS f32x4* xr = (const GAS f32x4*)xrow + lane;
    GAS unsigned long long* o8 = (GAS unsigned long long*)orow + lane;
    f32x4 v[4];
#pragma unroll
    for (int j = 0; j < 4; ++j) v[j] = xr[64 * j];
#pragma unroll
    for (int j = 0; j < 4; ++j) o8[64 * j] = (unsigned long long)pk2(v[j].x, v[j].y) | ((unsigned long long)pk2(v[j].z, v[j].w) << 32);
}

struct P1Order {
    int G, c;
    static constexpr int nM0 = 130, nN0 = 29, nwg0 = nM0 * nN0, nM1 = 16, nN1 = 8, nwg1 = nM1 * nN1, nwg = nwg0 + nwg1;
    __device__ __forceinline__ bool next(int i, pg8::Unit& u) const {
        const long L = (long)i * G + c; if (L >= nwg) return false;
        int wgid = (int)L; { const int q = nwg / 8, r = nwg % 8, xcd = wgid % 8, off = wgid / 8; wgid = (xcd < r ? xcd * (q + 1) : r * (q + 1) + (xcd - r) * q) + off; }
        if (wgid < nwg0) { const int nig = 8 * nN0, gid = wgid / nig, fm = gid * 8, gsz = (nM0 - fm) < 8 ? (nM0 - fm) : 8;
            u.pm = fm + ((wgid % nig) % gsz); u.pn = (wgid % nig) / gsz; u.job = 0; }
        else { const int w = wgid - nwg0; u.pm = w % nM1; u.pn = w / nM1; u.job = 1; }
        return true;
    }
    __device__ __forceinline__ void a_ready(const pg8::Unit&) const {}
    __device__ __forceinline__ void done(const pg8::Unit&) const {}
};

typedef pg8::f32x4 acc_t[2][2][4][2];
struct EpiP1 {
    static constexpr bool PERM = true, AFTER_DRAIN = false;
    unsigned char* ws; float* out;
    __device__ __forceinline__ void operator()(const acc_t& acc, const pg8::Unit& u, int wr, int wc, int fr, int fq) const {
        int lr0 = wr * 64 + fr, cl0 = wc * 32 + 8 * fq; const int pm = u.pm, pn = u.pn;
        asm volatile("" : "+v"(lr0), "+v"(cl0));
        if (u.job == 0 && pn == 28) {
            if (wc == 0 && fq < 2) {
                float* AB = (float*)(ws + WS_AB);
#pragma unroll
                for (int ai = 0; ai < 2; ++ai)
#pragma unroll
                    for (int m = 0; m < 4; ++m) { float* d = AB + (size_t)(pm * 256 + lr0 + ai * 128 + m * 16) * 16 + 8 * fq;
                        *(pg8::f32x4*)d = acc[ai][0][m][0]; *(pg8::f32x4*)(d + 4) = acc[ai][0][m][1]; }
            }
            return;
        }
        bf16* tile; bf16* sbt = nullptr; int ld = 1024; float sc = 1.f; int fmode = 0; size_t fbase = 0; int fld = 1024;
        if (u.job == 0) {
            if (pn < 12) { const int which = pn >> 2, colt = (pn & 3) * 256;
                tile = (bf16*)(ws + (which == 0 ? WS_QA : (which == 1 ? WS_KA : WS_VA))) + (size_t)pm * 256 * 1024 + colt; if (which == 0) sc = C2A;
                if (which != 0) { const bool smp = pm >= 128;
                    if (smp) { fmode = 2; fbase = (which == 1 ? O_AKS : O_AVS) + colt; }
                    else if ((pm & 7) >= 6) { fmode = 1; fbase = (which == 1 ? O_AKP : O_AVP) + ((size_t)(pm >> 3) * 512 + ((pm & 7) - 6) * 256) * 1024 + colt; } }
            } else if (pn < 24) { const int c3t = (pn - 12) * 256; ld = 3072; fld = 3072;
                tile = (bf16*)(ws + WS_QKVB) + (size_t)pm * 256 * 3072 + c3t;
                if (pm >= 128) { fmode = 4; fbase = O_CONVS + c3t; } else { sbt = (bf16*)(ws + WS_SB) + (size_t)pm * 8 * 3 * 3072 + c3t; if ((pm & 7) == 7) { fmode = 3; fbase = O_CONVP + (size_t)(pm >> 3) * 3 * 3072 + c3t; } }
            } else { tile = (bf16*)((unsigned char*)out + DO_QC) + (size_t)pm * 256 * 1024 + (pn - 24) * 256; sc = C2C; }
        } else { const int isv = pn >> 2, colt = (pn & 3) * 256;
            tile = (bf16*)(ws + (isv ? WS_MV : WS_MK)) + (size_t)pm * 256 * 1024 + colt; fmode = 5; fbase = (isv ? O_MVP : O_MKP) + (size_t)pm * 256 * 1024 + colt; }
#pragma unroll
        for (int ai = 0; ai < 2; ++ai)
#pragma unroll
            for (int m = 0; m < 4; ++m) {
                const int lr = lr0 + ai * 128 + m * 16;
                bf16* rowp = tile + (size_t)lr * ld + cl0;
#pragma unroll
                for (int bj = 0; bj < 2; ++bj) { const pg8::f32x4 v0 = acc[ai][bj][m][0] * sc, v1 = acc[ai][bj][m][1] * sc;
                    pg8::u32x4 w; w.x = pg8::cvt_pk_bf16(v0[0], v0[1]); w.y = pg8::cvt_pk_bf16(v0[2], v0[3]); w.z = pg8::cvt_pk_bf16(v1[0], v1[1]); w.w = pg8::cvt_pk_bf16(v1[2], v1[3]);
                    *(pg8::u32x4*)(rowp + bj * 128) = w;
                    if (sbt && (lr & 31) >= 29) *(pg8::u32x4*)(sbt + (size_t)((lr >> 5) * 3 + (lr & 31) - 29) * 3072 + cl0 + bj * 128) = w; }
                if (fmode) {
                    long drow = -1;
                    if (fmode == 1 || fmode == 5) drow = lr;
                    else if (fmode == 2) { const int rs = (pm - 128) * 256 + lr; drow = (long)(rs >> 4) * 512 + 496 + (rs & 15); }
                    else if (fmode == 3) { if (lr >= 253) drow = lr - 253; }
                    else { const int rs = (pm - 128) * 256 + lr; if ((rs & 15) >= 13) drow = (long)(rs >> 4) * 3 + (rs & 15) - 13; }
                    if (drow >= 0) { float* d = out + fbase + (size_t)drow * fld + cl0;
#pragma unroll
                        for (int bj = 0; bj < 2; ++bj) { *(pg8::f32x4*)(d + bj * 128) = acc[ai][bj][m][0]; *(pg8::f32x4*)(d + bj * 128 + 4) = acc[ai][bj][m][1]; } }
                }
                asm volatile("" ::: "memory");
            }
    }
};

template <int NM> struct P3OrderT {
    int G, c;
    static constexpr int nM = NM, nP = 4, npair = nM * nP;
    __device__ __forceinline__ bool next(int i, pg8::Unit& u) const {
        const int tr = i / 3, br = i - 3 * tr; const long L = (long)tr * G + c; if (L >= npair) return false;
        int wgid = (int)L; { const int q = npair / 8, r = npair % 8, xcd = wgid % 8, off = wgid / 8; wgid = (xcd < r ? xcd * (q + 1) : r * (q + 1) + (xcd - r) * q) + off; }
        const int nig = 8 * nP, gid = wgid / nig, fm = gid * 8, gsz = (nM - fm) < 8 ? (nM - fm) : 8;
        u.pm = fm + ((wgid % nig) % gsz); u.pn = br * 4 + (wgid % nig) / gsz; u.job = 0; return true;
    }
    __device__ __forceinline__ void a_ready(const pg8::Unit&) const {}
    __device__ __forceinline__ void done(const pg8::Unit&) const {}
};
__device__ __forceinline__ float bflo(unsigned w) { return __uint_as_float(w << 16); }
__device__ __forceinline__ float bfhi(unsigned w) { return __uint_as_float(w & 0xffff0000u); }
__device__ __forceinline__ float sigmoid_f(float g) { return __builtin_amdgcn_rcpf(1.f + __builtin_amdgcn_exp2f(-g * LOG2E)); }
struct EpiGate {
    static constexpr bool PERM = true, AFTER_DRAIN = false;
    unsigned char* ws; unsigned char* outb; int smp;
    __device__ __forceinline__ void operator()(const acc_t& acc, const pg8::Unit& u, int wr, int wc, int fr, int fq) const {
        int lr0 = wr * 64 + fr, cl0 = wc * 32 + 8 * fq; const int pm = u.pm, br = u.pn >> 2, pc = u.pn & 3;
        asm volatile("" : "+v"(lr0), "+v"(cl0));
        const bf16* ob; int ldo = 1024;
        if (br == 0) ob = (const bf16*)(ws + WS_QA); else if (br == 1) { ob = (const bf16*)(ws + WS_QKVB); ldo = 3072; } else ob = (const bf16*)(outb + DO_QC);
        ob += (size_t)(pm * 256 + (smp ? R_P : 0)) * ldo + pc * 256 + cl0;
        bf16* mg = (bf16*)(ws + (smp ? WS_SMG : WS_KA)) + (size_t)pm * 256 * 1024 + pc * 256 + cl0;
#pragma unroll
        for (int ai = 0; ai < 2; ++ai)
#pragma unroll
            for (int m = 0; m < 4; ++m) {
                const int lr = lr0 + ai * 128 + m * 16;
#pragma unroll
                for (int bj = 0; bj < 2; ++bj) {
                    const pg8::u32x4 ov = *(const pg8::u32x4*)(ob + (size_t)lr * ldo + bj * 128);
                    const pg8::f32x4 g0 = acc[ai][bj][m][0], g1 = acc[ai][bj][m][1];
                    float v[8];
                    v[0] = sigmoid_f(g0[0]) * bflo(ov.x); v[1] = sigmoid_f(g0[1]) * bfhi(ov.x); v[2] = sigmoid_f(g0[2]) * bflo(ov.y); v[3] = sigmoid_f(g0[3]) * bfhi(ov.y);
                    v[4] = sigmoid_f(g1[0]) * bflo(ov.z); v[5] = sigmoid_f(g1[1]) * bfhi(ov.z); v[6] = sigmoid_f(g1[2]) * bflo(ov.w); v[7] = sigmoid_f(g1[3]) * bfhi(ov.w);
                    pg8::u32x4* mp = (pg8::u32x4*)(mg + (size_t)lr * 1024 + bj * 128);
                    if (br != 0) { const pg8::u32x4 pv = *mp;
                        v[0] += bflo(pv.x); v[1] += bfhi(pv.x); v[2] += bflo(pv.y); v[3] += bfhi(pv.y); v[4] += bflo(pv.z); v[5] += bfhi(pv.z); v[6] += bflo(pv.w); v[7] += bfhi(pv.w); }
                    pg8::u32x4 w; w.x = pg8::cvt_pk_bf16(v[0], v[1]); w.y = pg8::cvt_pk_bf16(v[2], v[3]); w.z = pg8::cvt_pk_bf16(v[4], v[5]); w.w = pg8::cvt_pk_bf16(v[6], v[7]);
                    *mp = w;
                }
                asm volatile("" ::: "memory");
            }
    }
};
struct EpiResF32 {
    static constexpr bool PERM = false, AFTER_DRAIN = false;
    const float* res_p; const float* res_s; float* dst; const float* bias;
    __device__ __forceinline__ void operator()(const acc_t& acc, const pg8::Unit& u, int wr, int wc, int fr, int fq) const {
        int lr0 = wr * 64 + fr, cl0 = u.pn * 256 + wc * 32 + 4 * fq;
        asm volatile("" : "+v"(lr0), "+v"(cl0));
        const float* rb = (u.pm < 128) ? res_p + (size_t)u.pm * 256 * 1024 : res_s + (size_t)(u.pm - 128) * 256 * 1024;
        float* db = dst + (size_t)u.pm * 256 * 1024;
        pg8::f32x4 bv[2][2];
#pragma unroll
        for (int bj = 0; bj < 2; ++bj)
#pragma unroll
            for (int n = 0; n < 2; ++n) bv[bj][n] = bias ? *(const pg8::f32x4*)(bias + cl0 + bj * 128 + n * 16) : (pg8::f32x4){0.f, 0.f, 0.f, 0.f};
#pragma unroll
        for (int ai = 0; ai < 2; ++ai)
#pragma unroll
            for (int m = 0; m < 4; ++m) { const size_t off = (size_t)(lr0 + ai * 128 + m * 16) * 1024 + cl0;
#pragma unroll
                for (int bj = 0; bj < 2; ++bj)
#pragma unroll
                    for (int n = 0; n < 2; ++n) { const pg8::f32x4 rv = *(const pg8::f32x4*)(rb + off + bj * 128 + n * 16);
                        *(pg8::f32x4*)(db + off + bj * 128 + n * 16) = rv * DN_ALPHA + acc[ai][bj][m][n] + bv[bj][n]; }
                asm volatile("" ::: "memory"); }
    }
};
struct EpiFf1 {
    static constexpr bool PERM = true, AFTER_DRAIN = false;
    bf16* FF; const float* bias;
    __device__ __forceinline__ void operator()(const acc_t& acc, const pg8::Unit& u, int wr, int wc, int fr, int fq) const {
        int lr0 = wr * 64 + fr, cl0 = u.pn * 256 + wc * 32 + 8 * fq;
        asm volatile("" : "+v"(lr0), "+v"(cl0));
        bf16* tile = FF + (size_t)u.pm * 256 * 4096 + cl0;
        pg8::f32x4 bv[2][2];
#pragma unroll
        for (int bj = 0; bj < 2; ++bj)
#pragma unroll
            for (int n = 0; n < 2; ++n) bv[bj][n] = *(const pg8::f32x4*)(bias + cl0 + bj * 128 + 4 * n);
#pragma unroll
        for (int ai = 0; ai < 2; ++ai)
#pragma unroll
            for (int m = 0; m < 4; ++m) { bf16* rowp = tile + (size_t)(lr0 + ai * 128 + m * 16) * 4096;
#pragma unroll
                for (int bj = 0; bj < 2; ++bj) { pg8::f32x4 v0 = acc[ai][bj][m][0] + bv[bj][0], v1 = acc[ai][bj][m][1] + bv[bj][1];
#pragma unroll
                    for (int e = 0; e < 4; ++e) { v0[e] = fmaxf(v0[e], 0.f); v0[e] *= v0[e]; v1[e] = fmaxf(v1[e], 0.f); v1[e] *= v1[e]; }
                    pg8::u32x4 w; w.x = pg8::cvt_pk_bf16(v0[0], v0[1]); w.y = pg8::cvt_pk_bf16(v0[2], v0[3]); w.z = pg8::cvt_pk_bf16(v1[0], v1[1]); w.w = pg8::cvt_pk_bf16(v1[2], v1[3]);
                    *(pg8::u32x4*)(rowp + bj * 128) = w; }
                asm volatile("" ::: "memory"); }
    }
};
__device__ __forceinline__ float wsum64(float v) {
#pragma unroll
    for (int o = 1; o < 64; o <<= 1) v += __shfl_xor(v, o);
    return v;
}
__device__ __forceinline__ void ln_row(float* row, const float* g, const float* b, bf16* hb, int lane, float* dst = nullptr) {
    GAS f32x4* xr = (GAS f32x4*)row + lane; GAS f32x4* xo = dst ? (GAS f32x4*)dst + lane : xr;
    f32x4 v[4]; float s = 0.f;
#pragma unroll
    for (int j = 0; j < 4; ++j) { v[j] = xr[64 * j]; s += (v[j].x + v[j].y) + (v[j].z + v[j].w); }
    const float mean = wsum64(s) * (1.f / 1024.f); float s2 = 0.f;
#pragma unroll
    for (int j = 0; j < 4; ++j) { v[j] = v[j] - mean; s2 += (v[j].x * v[j].x + v[j].y * v[j].y) + (v[j].z * v[j].z + v[j].w * v[j].w); }
    const float rstd = 1.f / sqrtf(wsum64(s2) * (1.f / 1024.f) + LN_EPS);
#pragma unroll
    for (int j = 0; j < 4; ++j) { const f32x4 gv = *((const GAS f32x4*)g + lane + 64 * j), bv = *((const GAS f32x4*)b + lane + 64 * j);
        v[j] = v[j] * rstd * gv + bv; xo[64 * j] = v[j];
        if (hb) ((GAS unsigned long long*)hb + lane)[64 * j] = (unsigned long long)pk2(v[j].x, v[j].y) | ((unsigned long long)pk2(v[j].z, v[j].w) << 32); }
}

struct EpiSPerm {
    static constexpr bool PERM = true, AFTER_DRAIN = false;
    int kind; EpiGate eg; EpiFf1 ef;
    __device__ __forceinline__ void operator()(const acc_t& acc, const pg8::Unit& u, int wr, int wc, int fr, int fq) const { if (kind == 0) eg(acc, u, wr, wc, fr, fq); else ef(acc, u, wr, wc, fr, fq); }
};
__global__ void __launch_bounds__(NWAVES * 64, 2) mega_fwd(Args args) {
    extern __shared__ __attribute__((aligned(16))) unsigned char lds[];
    LAS unsigned char* L = (LAS unsigned char*)lds;
    volatile LAS unsigned* MISC = (volatile LAS unsigned*)(L + MISC_OFF);
    const int tid = threadIdx.x, lane = tid & 63, wave = __builtin_amdgcn_readfirstlane(tid >> 6);
#define GRID_N ((int)gridDim.x)
#define BLK_X ((int)blockIdx.x)
#define VCU ((BLK_X % 8) * (GRID_N / 8) + BLK_X / 8)
    unsigned char* ws = args.ws; float* out = args.out; unsigned char* outb = (unsigned char*)args.out;
    gu32* ctl = (gu32*)(ws + WS_CTL);
    for (int u = tid; u < (LDS_BYTES - RING_BYTES) / 4; u += NWAVES * 64) ((LAS unsigned*)(L + RING_BYTES))[u] = 0u;
    __syncthreads();
    (void)xcd_barrier_post((unsigned*)(ctl + CW_BAR), MISC + 8);
#define GRIDBAR() do { XcdBarrier bar_; bar_.bar = (unsigned*)(ws + WS_CTL) + CW_BAR; bar_.x = xb_xcc_id(); bar_.st = (volatile LAS unsigned*)(L + MISC_OFF) + 8; xcd_barrier(bar_); } while (0)
#define IN(k) (args.ph_lo <= (k) && (k) < args.ph_hi)
#if defined(PROBE_A)
#define STAMP(k) do { if (blockIdx.x == 0 && threadIdx.x == 0) ((volatile unsigned long long*)(ws + WS_CTL + CW_TS * 4))[k] = __builtin_amdgcn_s_memrealtime(); } while (0)
#else
#define STAMP(k) do {} while (0)
#endif
    STAMP(0);
#define BOTH(k) (IN(k) && IN((k) + 1))
#define XB ((bf16*)(outb + DO_XB))
#define QC ((bf16*)(outb + DO_QC))
#define WinT ((bf16*)(ws + WS_WIN))
#define WgT ((bf16*)(ws + WS_WG))
#define WmemT ((bf16*)(ws + WS_WMEM))
#define WoutT ((bf16*)(ws + WS_WOUT))
#define Wff1T ((bf16*)(ws + WS_WFF1))
#define Wff2T ((bf16*)(ws + WS_WFF2))
#define MB ((bf16*)(ws + WS_MB))
#define HB ((bf16*)(ws + WS_QKVB + 130 * MiB))
#define FF ((bf16*)(ws + WS_QA))
    if (IN(0)) {
        LAS float* scr = (LAS float*)(L + wave * 16384);
        const int gw = VCU * NWAVES + wave, NGW = GRID_N * NWAVES;
        const float *w_in = args.in[9], *w_mem = args.in[15], *w_out = args.in[16], *w_ff1 = args.in[19], *w_ff2 = args.in[21];
        constexpr int I_IN = 16 * 224, I_AB = 16 * 8, I_G = 16 * 96, I_MEM = 16 * 64, I_OUT = 16 * 32, I_F1 = 16 * 128, I_F2 = 64 * 32;
        constexpr int NITEMS = I_IN + I_AB + I_G + I_MEM + I_OUT + I_F1 + I_F2;
        for (int it = gw; it < NITEMS; it += NGW) {
            int r = it;
            if (r < I_IN) { p0_transpose_item(w_in, 1024, ZW, 0, 7168, WinT, 0, 224, scr, r, lane); continue; } r -= I_IN;
            if (r < I_AB) { p0_transpose_item(w_in, 1024, ZW, 10240, 16, WinT, 7168, 8, scr, r, lane); continue; } r -= I_AB;
            if (r < I_G) { p0_transpose_item(w_in, 1024, ZW, 7168, 3072, WgT, 0, 96, scr, r, lane); continue; } r -= I_G;
            if (r < I_MEM) { p0_transpose_item(w_mem, 1024, 2048, 0, 2048, WmemT, 0, 64, scr, r, lane); continue; } r -= I_MEM;
            if (r < I_OUT) { p0_transpose_item(w_out, 1024, 1024, 0, 1024, WoutT, 0, 32, scr, r, lane); continue; } r -= I_OUT;
            if (r < I_F1) { p0_transpose_item(w_ff1, 1024, 4096, 0, 4096, Wff1T, 0, 128, scr, r, lane); continue; } r -= I_F1;
            p0_transpose_item(w_ff2, 4096, 1024, 0, 1024, Wff2T, 0, 32, scr, r, lane);
        }
        for (int m = gw; m < R_ALL + 4096; m += NGW) {
            if (m < R_P) cvt_row_bf16(args.in[0] + (size_t)m * 1024, XB + (size_t)m * 1024, lane);
            else if (m < R_ALL) cvt_row_bf16(args.in[1] + (size_t)(m - R_P) * 1024, XB + (size_t)m * 1024, lane);
            else cvt_row_bf16(args.in[8] + (size_t)(m - R_ALL) * 1024, MB + (size_t)(m - R_ALL) * 1024, lane);
        }
        if (BOTH(0)) GRIDBAR(); STAMP(1);
    }
    if (IN(1)) {
        pg8::Gemm g{XB, WinT, R_ALL, 7424, 1024, MB, WmemT};
        P1Order S; S.G = GRID_N; S.c = BLK_X;
        EpiP1 E{ws, out};
        pg8::gemm_phase<EpiP1, P1Order, true, true, 1024>(L, g, S, E);
        if (BOTH(1)) GRIDBAR(); STAMP(2);
    }
    if (IN(2)) {
        for (int u = VCU; u < 3072 + 96; u += GRID_N) {
            if (u < 3072) { const int op = u % 3, blk = (u / 3) & 63, b = u / 192;
                gdn::conv_unit((bf16*)(ws + WS_QKVB), (const bf16*)(ws + WS_SB), args.in[10], nullptr, (long)b * 2048 + blk * 32, 32, blk ? (b * 64 + blk - 1) * 3 : -1, op); }
            else { const int v = u - 3072, op = v % 3, b = v / 3;
                gdn::conv_unit((bf16*)(ws + WS_QKVB), nullptr, args.in[10], args.in[4] + (size_t)b * 3 * 3072, (long)R_P + b * 16, 16, -1, op); }
        }
        GRIDBAR(); STAMP(9);
    }
    if (IN(2)) {
        constexpr int Q0_GP = 0, Q0_GS = 128, Q0_SA = Q0_GS + 256, Q0_SC = Q0_SA + 512, Q0_C1 = Q0_SC + 128, Q0_G = Q0_C1 + 128, Q0_C2 = Q0_G + 8, Q0_A1 = Q0_C2 + 384, Q0_O = Q0_A1 + 512,
                      Q0_A2 = Q0_O + 8, Q0_L1 = Q0_A2 + 256, Q0_A3 = Q0_L1 + 8, Q0_F1 = Q0_A3 + 256, Q0_A4 = Q0_F1 + 32, Q0_F2 = Q0_A4 + 512, Q0_A5 = Q0_F2 + 8, Q0_L2 = Q0_A5 + 512, Q0_END = Q0_L2 + 8;
        volatile LAS int* qslot = (volatile LAS int*)(L + MISC_OFF);
        struct OneUnit { int pm, pn, n;
            __device__ __forceinline__ bool next(int i, pg8::Unit& u) const { if (i >= n) return false; u.pm = pm; u.pn = pn + 4 * i; u.job = 0; return true; }
            __device__ __forceinline__ void a_ready(const pg8::Unit&) const {}
            __device__ __forceinline__ void done(const pg8::Unit&) const {} };
#define SC_CNT(stage, panel) (ctl + CW_SC + 64 * ((stage) * 2 + (panel)))
#define SC_DONE(stage, panel) do { asm volatile("s_waitcnt vmcnt(0)" ::: "memory"); __syncthreads(); \
            if (threadIdx.x == 0) { __builtin_amdgcn_fence(__ATOMIC_RELEASE, "agent"); asm volatile("s_waitcnt vmcnt(0)" ::: "memory"); __hip_atomic_fetch_add(SC_CNT(stage, panel), 1u, __ATOMIC_RELAXED, __HIP_MEMORY_SCOPE_AGENT); } } while (0)
#define SC_WAIT(stage, panel, need) do { if (threadIdx.x == 0) { unsigned sp_ = 0; while (__hip_atomic_load(SC_CNT(stage, panel), __ATOMIC_RELAXED, __HIP_MEMORY_SCOPE_AGENT) < (unsigned)(need)) { __builtin_amdgcn_s_sleep(8); if (++sp_ > (1u << 22)) break; } \
            __builtin_amdgcn_fence(__ATOMIC_ACQUIRE, "agent"); asm volatile("s_waitcnt vmcnt(0)" ::: "memory"); } __syncthreads(); } while (0)
        for (;;) {
            if (threadIdx.x == 0) qslot[0] = (int)__hip_atomic_fetch_add(ctl + CW_QUEUE, 1u, __ATOMIC_RELAXED, __HIP_MEMORY_SCOPE_AGENT);
            __syncthreads();
            const int it = __builtin_amdgcn_readfirstlane(qslot[0]);
            __syncthreads();
            if (it >= Q0_END) break;
#if defined(ITEM_PROBE)
            unsigned long long it_t0 = 0; if (it == ITEM_PROBE) it_t0 = __builtin_amdgcn_s_memrealtime();
#endif
            int au = -1, cu = -1;
            int skind = -1, sp = 0, spn = 0;
            int lane_q = threadIdx.x & 63; asm volatile("" : "+v"(lane_q));
            if (it < Q0_GS) { const int b = it >> 3, h = it & 7;
                gdn::gdn_unit(L, (const bf16*)(ws + WS_QKVB), (bf16*)(ws + WS_QKVB), (const float*)(ws + WS_AB), (long)b * 2048, h, 32, 64, args.in[11], args.in[12], args.in[13], nullptr,
                              out + O_SSMP + ((size_t)b * 8 + h) * 16384);
            } else if (it < Q0_SA) { const int u = it - Q0_GS, b = u >> 3, h = u & 7;
                gdn::gdn_unit(L, (const bf16*)(ws + WS_QKVB), (bf16*)(ws + WS_QKVB), (const float*)(ws + WS_AB), (long)R_P + b * 16, h, 1, 16, args.in[11], args.in[12], args.in[13],
                              args.in[5] + ((size_t)b * 8 + h) * 16384, out + O_SSMS + ((size_t)b * 8 + h) * 16384);
                SC_DONE(0, b >> 4);
            } else if (it < Q0_SC) { const int u = it - Q0_SA, b = u >> 4, h = u & 15; const size_t r0 = (size_t)(R_P + b * 16) * 1024 + h * 64;
                satt::sattn_unit<64, 64>(L, (bf16*)(ws + WS_QA) + r0, args.in[2] + (size_t)b * 512 * 1024 + h * 64, args.in[3] + (size_t)b * 512 * 1024 + h * 64, 512,
                                         (const bf16*)(ws + WS_KA) + r0, (const bf16*)(ws + WS_VA) + r0, 16, args.in[14] + h * 257,
                                         out + O_AKS + (size_t)b * 512 * 1024 + h * 64, out + O_AVS + (size_t)b * 512 * 1024 + h * 64);
                SC_DONE(0, b >> 4);
            } else if (it < Q0_C1) { const int u = it - Q0_SC, b = u >> 2, h = u & 3; const size_t r0 = (size_t)(R_P + b * 16) * 1024 + h * 256;
                satt::sattn_unit<256, 32>(L, (bf16*)(outb + DO_QC) + r0, args.in[6] + (size_t)b * 256 * 1024 + h * 256, args.in[7] + (size_t)b * 256 * 1024 + h * 256, 256,
                                          nullptr, nullptr, 0, nullptr, nullptr, nullptr);
                SC_DONE(0, b >> 4);
            } else if (it < Q0_G) cu = it - Q0_C1;
            else if (it < Q0_C2) { const int u = it - Q0_G, p = u >> 2, pc = u & 3;
                SC_WAIT(0, p, 448);
                skind = 0; sp = p; spn = pc;
            } else if (it < Q0_A1) cu = 128 + it - Q0_C2;
            else if (it < Q0_O) au = it - Q0_A1;
            else if (it < Q0_A2) { const int u = it - Q0_O, p = u >> 2, pn = u & 3;
                SC_WAIT(1, p, 4);
                skind = 2; sp = p; spn = pn;
            } else if (it < Q0_L1) au = 512 + it - Q0_A2;
            else if (it < Q0_A3) { const int u = it - Q0_L1, p = u >> 2, q4 = u & 3;
                SC_WAIT(2, p, 4);
                for (int r = wave; r < 64; r += NWAVES) { const int m = p * 256 + q4 * 64 + r; ln_row((float*)(ws + WS_ST1) + (size_t)m * 1024, args.in[17], args.in[18], (bf16*)(ws + WS_SHB) + (size_t)m * 1024, lane_q); }
                SC_DONE(3, p);
            } else if (it < Q0_F1) au = 768 + it - Q0_A3;
            else if (it < Q0_A4) { const int u = it - Q0_F1, p = u >> 4, pn = u & 15;
                SC_WAIT(3, p, 4);
                skind = 1; sp = p; spn = pn;
            } else if (it < Q0_F2) au = 1024 + it - Q0_A4;
            else if (it < Q0_A5) { const int u = it - Q0_F2, p = u >> 2, pn = u & 3;
                SC_WAIT(4, p, 16);
                skind = 3; sp = p; spn = pn;
            } else if (it < Q0_L2) au = 1536 + it - Q0_A5;
            else { const int u = it - Q0_L2, p = u >> 2, q4 = u & 3;
                SC_WAIT(5, p, 4);
                for (int r = wave; r < 64; r += NWAVES) { const int m = p * 256 + q4 * 64 + r; ln_row((float*)(ws + WS_ST1) + (size_t)m * 1024, args.in[23], args.in[24], nullptr, lane_q); }
            }
            if (skind == 0 || skind == 1) {
                pg8::Gemm g{skind == 0 ? XB + (size_t)R_P * 1024 : (const bf16*)(ws + WS_SHB), skind == 0 ? WgT : Wff1T, 512, skind == 0 ? 3072 : 4096, 1024, XB, WgT}; OneUnit S{sp, spn, skind == 0 ? 3 : 1};
                EpiSPerm E{skind, EpiGate{ws, outb, 1}, EpiFf1{(bf16*)(ws + WS_SFF), args.in[20]}};
                pg8::gemm_phase<EpiSPerm, OneUnit, false, true, 1024>(L, g, S, E);
                SC_DONE(skind == 0 ? 1 : 4, sp);
            } else if (skind >= 2) {
                pg8::Gemm g{(const bf16*)(ws + (skind == 2 ? WS_SMG : WS_SFF)), skind == 2 ? WoutT : Wff2T, 512, 1024, skind == 2 ? 1024 : 4096, XB, WoutT}; OneUnit S{sp, spn, 1};
                EpiResF32 E{skind == 2 ? args.in[1] : (const float*)(ws + WS_ST1), skind == 2 ? args.in[1] : (const float*)(ws + WS_ST1), (float*)(ws + WS_ST1), skind == 2 ? nullptr : args.in[22]};
                pg8::gemm_phase<EpiResF32, OneUnit, false, true, 0>(L, g, S, E);
                SC_DONE(skind == 2 ? 2 : 5, sp);
            }
            if (cu >= 0) att::attnC_unit(cu >> 5, (cu >> 3) & 3, cu & 7, (bf16*)(outb + DO_QC), (const bf16*)(ws + WS_MK), (const bf16*)(ws + WS_MV), L);
            if (au >= 0) { const int bh = au >> 3; att::attnA_unit(bh >> 4, bh & 15, au & 7, (bf16*)(ws + WS_QA), (const bf16*)(ws + WS_KA), (const bf16*)(ws + WS_VA), args.in[14], L); }
#if defined(ITEM_PROBE)
            if (it == ITEM_PROBE && threadIdx.x == 0) ((volatile unsigned long long*)(ws + WS_CTL + CW_TS * 4))[24] = __builtin_amdgcn_s_memrealtime() - it_t0;
#endif
        }
#undef SC_CNT
#undef SC_DONE
#undef SC_WAIT
        if (BOTH(2)) GRIDBAR(); STAMP(3);
    }
    if (IN(3)) {
        pg8::Gemm g{XB, WgT, R_P, 3072, 1024, XB, WgT};
        P3OrderT<128> S; S.G = GRID_N; S.c = BLK_X;
        EpiGate E{ws, outb, 0};
        pg8::gemm_phase<EpiGate, P3OrderT<128>, true, true, 1024>(L, g, S, E);
        if (BOTH(3)) GRIDBAR(); STAMP(4);
    }
    if (IN(4)) {
        pg8::Gemm g{(const bf16*)(ws + WS_KA), WoutT, R_P, 1024, 1024, (const bf16*)(ws + WS_KA), WoutT};
        pg8::StaticOrder S; S.init(R_P, 1024, GRID_N, BLK_X);
        EpiResF32 E{args.in[0], args.in[1], out, nullptr};
        pg8::gemm_phase<EpiResF32, pg8::StaticOrder, true, true, 1024>(L, g, S, E);
        if (BOTH(4)) GRIDBAR(); STAMP(5);
    }
    if (IN(5)) {
        const int gw = VCU * NWAVES + wave, NGW = GRID_N * NWAVES;
        for (int m = gw; m < R_P; m += NGW) ln_row(out + (size_t)m * 1024, args.in[17], args.in[18], HB + (size_t)m * 1024, lane);
        if (BOTH(5)) GRIDBAR(); STAMP(6);
    }
    if (IN(6)) {
        pg8::Gemm g{HB, Wff1T, R_P, 4096, 1024, HB, Wff1T};
        pg8::StaticOrder S; S.init(R_P, 4096, GRID_N, BLK_X);
        EpiFf1 E{FF, args.in[20]};
        pg8::gemm_phase<EpiFf1, pg8::StaticOrder, true, true, 1024>(L, g, S, E);
        if (BOTH(6)) GRIDBAR(); STAMP(7);
    }
    if (IN(7)) {
        pg8::Gemm g{FF, Wff2T, R_P, 1024, 4096, FF, Wff2T};
        pg8::StaticOrder S; S.init(R_P, 1024, GRID_N, BLK_X);
        EpiResF32 E{out, out + (size_t)R_P * 1024, out, args.in[22]};
        pg8::gemm_phase<EpiResF32, pg8::StaticOrder, true, true, 4096>(L, g, S, E);
        if (BOTH(7)) GRIDBAR(); STAMP(8);
    }
    if (IN(8)) {
        const int gw = VCU * NWAVES + wave, NGW = GRID_N * NWAVES;
        for (int m = gw; m < R_P; m += NGW) ln_row(out + (size_t)m * 1024, args.in[23], args.in[24], nullptr, lane);
        for (int m = gw; m < R_S; m += NGW) { const GAS f32x4* sr = (const GAS f32x4*)((const float*)(ws + WS_ST1) + (size_t)m * 1024) + lane; GAS f32x4* dr = (GAS f32x4*)(out + O_YS + (size_t)m * 1024) + lane;
#pragma unroll
            for (int j = 0; j < 4; ++j) dr[64 * j] = sr[64 * j]; }
#if defined(PROBE_A)
        { const volatile unsigned long long* ts = (const volatile unsigned long long*)(ws + WS_CTL + CW_TS * 4);
#if defined(ITEM_PROBE)
          const float eps = floorf((float)ts[24] * 1e-5f * ITEM_Q) / ITEM_Q + 0.5f / ITEM_Q;
#elif defined(GDN_PROBE)
          const float eps = (GDN_PROBE == 5) ? floorf((float)ts[16 + 5] * 1e-5f * 10.f) * 0.1f + 0.05f : rintf((float)ts[16 + GDN_PROBE] / (float)ts[16 + 5] * 20.f) * 0.05f + 0.01f;
#else
          const float eps = floorf((float)(ts[PROBE_B] - ts[PROBE_A]) * 1e-5f * PROBE_Q) / PROBE_Q + 0.5f / PROBE_Q;
#endif
          asm volatile("s_waitcnt vmcnt(0)" ::: "memory");
          for (int m = R_P + gw; m < R_ALL; m += NGW) { GAS f32x4* xr = (GAS f32x4*)(out + (size_t)m * 1024) + lane;
              for (int j = 0; j < 4; ++j) xr[64 * j] = xr[64 * j] * (1.f + eps); } }
#endif
    }
#undef IN
#undef BOTH
}
extern "C" void kernel_launch(void* const* d_in, const int* in_sizes, int n_in, void* d_out, int out_size, void* d_ws, size_t ws_size, hipStream_t stream) {
    (void)in_sizes; (void)n_in; (void)out_size;
    static int inited = 0;
    if (!inited) { if (hipFuncSetAttribute((const void*)mega_fwd, hipFuncAttributeMaxDynamicSharedMemorySize, LDS_BYTES) != hipSuccess) fprintf(stderr, "hipFuncSetAttribute failed\n"); inited = 1; }
    if (ws_size < WS_END) { fprintf(stderr, "kernel_launch: workspace too small (%zu < %zu)\n", ws_size, (size_t)WS_END); return; }
    unsigned char* ws = (unsigned char*)d_ws;
    (void)hipMemsetAsync(ws + WS_CTL, 0, CTL_ZERO_BYTES, stream);
    Args a{}; for (int i = 0; i < 25; ++i) a.in[i] = (const float*)d_in[i];
    a.out = (float*)d_out; a.ws = ws; a.ph_lo = 0; a.ph_hi = 9;
    hipLaunchKernelGGL(mega_fwd, dim3(256), dim3(NWAVES * 64), LDS_BYTES, stream, a);
}
```

```cpp
#include <hip/hip_runtime.h>
#include <cstdio>
#include <cstdint>

constexpr int DM = 1024, BATCH = 16, SEQ = 2048, DEC_B = 32, DEC_T = 16, PAST = 1024;
constexpr int CHUNK = 64, AH = 16, AHD = 64, AWIN = 512, ABAND = 576, ACLIP = 128;
constexpr int BH = 8, BHD = 128, MEMT = 256, CH = 4, CHD = 256, DFF = 4096;
constexpr int ZW = 10256;
constexpr int ZQ_A = 0, ZK_A = 1024, ZV_A = 2048, ZB = 3072, ZQ_C = 6144, ZG = 7168, ZA_B = 10240, ZB_B = 10248;
constexpr float DN_ALPHA = 1.189207115002721f;
constexpr float LN_EPS = 1e-5f, RMS_EPS = 1e-6f, L2_EPS = 1e-6f;

constexpr size_t O_YP = 0, O_YS = 33554432, O_AKP = 34078720, O_AVP = 42467328, O_CONVP = 50855936, O_SSMP = 51003392,
                 O_MKP = 53100544, O_MVP = 57294848, O_AKS = 61489152, O_AVS = 78266368, O_CONVS = 95043584, O_SSMS = 95338496;

namespace pg8 {
#define PG8_LAS __attribute__((address_space(3)))
typedef unsigned short bf16_t;
typedef short bf16x8 __attribute__((ext_vector_type(8)));
typedef float f32x4 __attribute__((ext_vector_type(4)));
typedef unsigned u32x4 __attribute__((ext_vector_type(4)));
constexpr int BM = 256, BK = 64, HALF = 128, HTB = HALF * BK * 2  , STAGE_BYTES = 8 * HTB, NXCD = 8, WGM = 8;

__host__ __device__ __forceinline__ int lds_byte(int r, int c) { const int st = (r >> 4) * 2 + (c >> 5), rr = r & 15, cc = c & 31, ob = rr * 64 + cc * 2; return st * 1024 + (ob ^ (((ob >> 9) & 1) << 5)); }
__host__ __device__ __forceinline__ void stage_rc(int b, int& R, int& C) { const int st = b / 1024, sb = b % 1024, swz = sb ^ (((sb >> 9) & 1) << 5); R = (st >> 1) * 16 + swz / 64; C = (st & 1) * 32 + (swz % 64) / 2; }
__host__ __device__ __forceinline__ int perm32(int rho) { const int n = rho >> 4, i = rho & 15; return 8 * (i >> 2) + 4 * n + (i & 3); }

struct Unit { int pm, pn, job; };
struct Gemm { const bf16_t* A; const bf16_t* Bt; int M, N, K; const bf16_t* A1; const bf16_t* Bt1; };

struct StaticOrder {
    int nM, nN, nwg, G, c;
    __host__ __device__ void init(int M, int N, int G_, int c_) { nM = M / BM; nN = N / BM; nwg = nM * nN; G = G_; c = c_; }
    __host__ __device__ __forceinline__ bool next(int i, Unit& u) const {
        const long L = (long)i * G + c; if (L >= nwg) return false;
        int wgid = (int)L; { const int q = nwg / NXCD, r = nwg % NXCD, xcd = wgid % NXCD, off = wgid / NXCD; wgid = (xcd < r ? xcd * (q + 1) : r * (q + 1) + (xcd - r) * q) + off; }
        const int nig = WGM * nN, gid = wgid / nig, fm = gid * WGM, gsz = (nM - fm) < WGM ? (nM - fm) : WGM;
        u.pm = fm + ((wgid % nig) % gsz); u.pn = (wgid % nig) / gsz; u.job = 0; return true;
    }
    __device__ __forceinline__ void a_ready(const Unit&) const {}
    __device__ __forceinline__ void done(const Unit&) const {}
};

__device__ __forceinline__ unsigned cvt_pk_bf16(float lo, float hi) { unsigned r; asm volatile("v_cvt_pk_bf16_f32 %0, %1, %2" : "=v"(r) : "v"(lo), "v"(hi)); return r; }
template <class Epi, class Sched, bool ALIGN_EPI = false, bool SP2 = false, int KC = 0>
__device__ __forceinline__ void gemm_phase(PG8_LAS unsigned char* lds, const Gemm g, const Sched& S, const Epi& E) {
    int tid_ = threadIdx.x; asm volatile("" : "+v"(tid_));
    const int tid = tid_, wid = __builtin_amdgcn_readfirstlane(tid >> 6), lane = tid & 63, wr = wid >> 2, wc = wid & 3, fr = lane & 15, fq = lane >> 4;
    const int K = KC ? KC : g.K, nt = K / BK;
    unsigned voffA[2], voffB[2];
#pragma unroll
    for (int i = 0; i < 2; ++i) { int R, C; stage_rc(tid * 16 + i * 8192, R, C); const int Rb = Epi::PERM ? ((R & ~31) + perm32(R & 31)) : R;
        voffA[i] = (unsigned)(R * K + C) * 2u; voffB[i] = (unsigned)(Rb * K + C) * 2u; }
    const size_t kstep = (size_t)(BK * 2);
    const size_t hstep = (size_t)HALF * K * 2;
    const size_t tstep = 2 * hstep;
    const unsigned ldsw = (unsigned)wid * 1024u;
    const int aoff = lds_byte(wr * 64 + fr, fq * 8), boff = lds_byte(wc * 32 + fr, fq * 8);
#define PG8_SA(b, h) (((b) * 2 + (h)) * HTB)
#define PG8_SB(b, h) ((4 + (b) * 2 + (h)) * HTB)
#define PG8_STAGE(bufoff, gbase, voff) do { _Pragma("unroll") for (int _i = 0; _i < 2; ++_i) \
        __builtin_amdgcn_global_load_lds((const unsigned*)((const char*)(gbase) + (voff)[_i]), (PG8_LAS unsigned*)(lds + (bufoff) + ldsw + _i * 8192), 16, 0, 0); } while (0)
#define PG8_LDA(dst, b, h) do { _Pragma("unroll") for (int m = 0; m < 4; ++m) _Pragma("unroll") for (int k = 0; k < 2; ++k) dst[m][k] = *(const PG8_LAS bf16x8*)(lds + PG8_SA(b, h) + aoff + m * 2048 + k * 1024); } while (0)
#define PG8_LDB(dst, b, h) do { _Pragma("unroll") for (int n = 0; n < 2; ++n) _Pragma("unroll") for (int k = 0; k < 2; ++k) dst[n][k] = *(const PG8_LAS bf16x8*)(lds + PG8_SB(b, h) + boff + n * 2048 + k * 1024); } while (0)
#define PG8_MMA(ai, bj, At, Bt) do { __builtin_amdgcn_s_setprio(1); _Pragma("unroll") for (int m = 0; m < 4; ++m) _Pragma("unroll") for (int n = 0; n < 2; ++n) _Pragma("unroll") for (int k = 0; k < 2; ++k) \
        acc[ai][bj][m][n] = __builtin_amdgcn_mfma_f32_16x16x32_bf16(Bt[n][k], At[m][k], acc[ai][bj][m][n], 0, 0, 0); __builtin_amdgcn_s_setprio(0); } while (0)
#define PG8_WAIT_V(n) asm volatile("s_waitcnt vmcnt(" #n ")" ::: "memory")
#define PG8_WAIT_L(n) asm volatile("s_waitcnt lgkmcnt(" #n ")" ::: "memory")
#define PG8_BAR __builtin_amdgcn_s_barrier()
#define PG8_SCHED __builtin_amdgcn_sched_barrier(0)
    Unit cur, nxt; int ui = 0;
    if (!S.next(0, cur)) return;
    f32x4 acc[2][2][4][2];
#pragma unroll
    for (int a = 0; a < 2; ++a)
#pragma unroll
        for (int b = 0; b < 2; ++b)
#pragma unroll
            for (int m = 0; m < 4; ++m)
#pragma unroll
                for (int n = 0; n < 2; ++n) acc[a][b][m][n] = (f32x4){0.f, 0.f, 0.f, 0.f};
    bf16x8 At[4][2], B0[2][2], B1[2][2];
    const char* cA = (const char*)(cur.job ? g.A1 : g.A) + (size_t)cur.pm * tstep; const char* cB = (const char*)(cur.job ? g.Bt1 : g.Bt) + (size_t)cur.pn * tstep;
    S.a_ready(cur);
    if constexpr (SP2) {
        PG8_STAGE(PG8_SB(0, 0), cB, voffB); PG8_STAGE(PG8_SB(0, 1), cB + hstep, voffB); PG8_STAGE(PG8_SA(0, 0), cA, voffA); PG8_STAGE(PG8_SA(0, 1), cA + hstep, voffA);
        if (wr == 1) PG8_BAR;
        PG8_WAIT_V(2); PG8_BAR;
        PG8_STAGE(PG8_SB(1, 0), cB + kstep, voffB); PG8_STAGE(PG8_SA(1, 0), cA + kstep, voffA); PG8_STAGE(PG8_SB(1, 1), cB + hstep + kstep, voffB);
        PG8_WAIT_V(6); PG8_BAR;
    } else {
        PG8_STAGE(PG8_SB(0, 0), cB, voffB); PG8_STAGE(PG8_SA(0, 0), cA, voffA); PG8_STAGE(PG8_SB(0, 1), cB + hstep, voffB); PG8_STAGE(PG8_SA(0, 1), cA + hstep, voffA);
        if (wr == 1) PG8_BAR;
        PG8_WAIT_V(4); PG8_BAR;
        PG8_STAGE(PG8_SB(1, 0), cB + kstep, voffB); PG8_STAGE(PG8_SA(1, 0), cA + kstep, voffA); PG8_STAGE(PG8_SB(1, 1), cB + hstep + kstep, voffB);
        PG8_WAIT_V(6); PG8_BAR;
    }
    for (;;) {
        const bool has_next = S.next(ui + 1, nxt);
        const char* nA = has_next ? (const char*)(nxt.job ? g.A1 : g.A) + (size_t)nxt.pm * tstep : cA; const char* nB = has_next ? (const char*)(nxt.job ? g.Bt1 : g.Bt) + (size_t)nxt.pn * tstep : cB;
        for (int t = 0; t < nt; t += 2) {
            const bool last = (t == nt - 2);
            const char* a1 = cA + (size_t)(t + 1) * kstep;
            const char* a2 = last ? nA : cA + (size_t)(t + 2) * kstep; const char* b2 = last ? nB : cB + (size_t)(t + 2) * kstep;
            const char* a3 = a2 + kstep; const char* b3 = b2 + kstep;
            if (last && has_next) S.a_ready(nxt);
            if constexpr (SP2) {
            PG8_LDB(B0, 0, 0); PG8_LDB(B1, 0, 1); PG8_SCHED; PG8_LDA(At, 0, 0); PG8_STAGE(PG8_SA(1, 1), a1 + hstep, voffA);
            PG8_WAIT_V(8); PG8_WAIT_L(0); PG8_BAR; PG8_MMA(0, 0, At, B0); PG8_MMA(0, 1, At, B1); PG8_BAR; PG8_SCHED;
            PG8_LDA(At, 0, 1); PG8_STAGE(PG8_SB(0, 0), b2, voffB); PG8_STAGE(PG8_SB(0, 1), b2 + hstep, voffB); PG8_STAGE(PG8_SA(0, 0), a2, voffA);
            PG8_WAIT_V(8); PG8_WAIT_L(0); PG8_BAR; PG8_MMA(1, 0, At, B0); PG8_MMA(1, 1, At, B1); PG8_BAR; PG8_SCHED;
            PG8_LDB(B0, 1, 0); PG8_LDB(B1, 1, 1); PG8_SCHED; PG8_LDA(At, 1, 0); PG8_STAGE(PG8_SA(0, 1), a2 + hstep, voffA);
            PG8_WAIT_V(8); PG8_WAIT_L(0); PG8_BAR; PG8_MMA(0, 0, At, B0); PG8_MMA(0, 1, At, B1); PG8_BAR; PG8_SCHED;
            PG8_LDA(At, 1, 1); PG8_STAGE(PG8_SB(1, 0), b3, voffB); PG8_STAGE(PG8_SB(1, 1), b3 + hstep, voffB); PG8_STAGE(PG8_SA(1, 0), a3, voffA);
            PG8_WAIT_V(8); PG8_WAIT_L(0); PG8_BAR; PG8_MMA(1, 0, At, B0); PG8_MMA(1, 1, At, B1); PG8_BAR; PG8_SCHED;
            } else {
            PG8_LDB(B0, 0, 0); PG8_SCHED; PG8_LDA(At, 0, 0); PG8_STAGE(PG8_SA(1, 1), a1 + hstep, voffA);
            PG8_WAIT_L(8); PG8_BAR; PG8_WAIT_L(0); PG8_MMA(0, 0, At, B0); PG8_BAR; PG8_SCHED;
            PG8_LDB(B1, 0, 1); PG8_STAGE(PG8_SB(0, 0), b2, voffB);
            PG8_BAR; PG8_WAIT_L(0); PG8_MMA(0, 1, At, B1); PG8_BAR;
            PG8_LDA(At, 0, 1); PG8_STAGE(PG8_SA(0, 0), a2, voffA);
            PG8_BAR; PG8_WAIT_L(0); PG8_MMA(1, 0, At, B0); PG8_BAR; PG8_SCHED;
            PG8_STAGE(PG8_SB(0, 1), b2 + hstep, voffB);
            PG8_WAIT_V(6); PG8_BAR; PG8_MMA(1, 1, At, B1); PG8_BAR;
            PG8_LDB(B0, 1, 0); PG8_SCHED; PG8_LDA(At, 1, 0); PG8_STAGE(PG8_SA(0, 1), a2 + hstep, voffA);
            PG8_WAIT_L(8); PG8_BAR; PG8_WAIT_L(0); PG8_MMA(0, 0, At, B0); PG8_BAR; PG8_SCHED;
            PG8_LDB(B1, 1, 1); PG8_STAGE(PG8_SB(1, 0), b3, voffB);
            PG8_BAR; PG8_WAIT_L(0); PG8_MMA(0, 1, At, B1); PG8_BAR;
            PG8_LDA(At, 1, 1); PG8_STAGE(PG8_SA(1, 0), a3, voffA);
            PG8_BAR; PG8_WAIT_L(0); PG8_MMA(1, 0, At, B0); PG8_BAR; PG8_SCHED;
            PG8_STAGE(PG8_SB(1, 1), b3 + hstep, voffB);
            PG8_WAIT_V(6); PG8_BAR; PG8_MMA(1, 1, At, B1); PG8_BAR;
            }
        }
        if constexpr (ALIGN_EPI) { if (wr == 0) PG8_BAR; }
        if constexpr (!Epi::AFTER_DRAIN) { E(acc, cur, wr, wc, fr, fq); S.done(cur); }
        if (!has_next) break;
#pragma unroll
        for (int a = 0; a < 2; ++a)
#pragma unroll
            for (int b = 0; b < 2; ++b)
#pragma unroll
                for (int m = 0; m < 4; ++m)
#pragma unroll
                    for (int n = 0; n < 2; ++n) acc[a][b][m][n] = (f32x4){0.f, 0.f, 0.f, 0.f};
        cur = nxt; cA = nA; cB = nB; ++ui;
        if constexpr (ALIGN_EPI) { if (wr == 1) PG8_BAR; }
    }
    PG8_WAIT_V(0);
    if constexpr (!ALIGN_EPI) { if (wr == 0) PG8_BAR; }
    PG8_BAR;
    if constexpr (Epi::AFTER_DRAIN) { E.fused(acc, cur, wr, wc, fr, fq, lds, wid, lane); S.done(cur); }
#undef PG8_SA
#undef PG8_SB
#undef PG8_STAGE
#undef PG8_LDA
#undef PG8_LDB
#undef PG8_MMA
#undef PG8_WAIT_V
#undef PG8_WAIT_L
#undef PG8_BAR
#undef PG8_SCHED
}
}
#define GAS __attribute__((address_space(1)))
#define LAS __attribute__((address_space(3)))
typedef unsigned short bf16;
typedef unsigned v4u __attribute__((ext_vector_type(4)));
typedef float f32x4 __attribute__((ext_vector_type(4)));
typedef short bf16x8 __attribute__((ext_vector_type(8)));
typedef GAS unsigned gu32;
typedef GAS unsigned long long gu64;
#define RLX_AGENT __ATOMIC_RELAXED, __HIP_MEMORY_SCOPE_AGENT
#define LDS_WAIT() asm volatile("s_waitcnt lgkmcnt(0)" ::: "memory")
#define VM_WAIT() asm volatile("s_waitcnt vmcnt(0)" ::: "memory")
__device__ __forceinline__ unsigned long long rt() { return __builtin_amdgcn_s_memrealtime(); }
__device__ __forceinline__ unsigned f2bf(float f) { unsigned u = __builtin_bit_cast(unsigned, f); return (u + 0x7fffu + ((u >> 16) & 1u)) >> 16; }
__device__ __forceinline__ unsigned pk2(float lo, float hi) { return f2bf(lo) | (f2bf(hi) << 16); }

#define XB_TMO      128
#define XB_XCNT(j)  (256  + 64 * (j))
#define XB_XSUB(j)  (1280 + 64 * (j))
#define XB_XGEN(j)  (2304 + 64 * (j))
#define XB_TOP      3328
#define XB_TOPGEN   3392
#define XCD_BAR_WORDS 3456
#define XB_SPIN_CAP (1u << 18)

__device__ __forceinline__ unsigned xb_ld(unsigned* p)              { return __hip_atomic_load(p, __ATOMIC_RELAXED, __HIP_MEMORY_SCOPE_AGENT); }
__device__ __forceinline__ unsigned xb_add(unsigned* p, unsigned v) { return __hip_atomic_fetch_add(p, v, __ATOMIC_RELAXED, __HIP_MEMORY_SCOPE_AGENT); }
__device__ __forceinline__ unsigned xb_xcc_id() { return (unsigned)__builtin_amdgcn_s_getreg((3 << 11) | 20) & 0xFu; }
#define XB_SPIN(cond, bar) do { unsigned _sp = 0; while (cond) { __builtin_amdgcn_s_sleep(1); \
    if ((++_sp & 255u) == 0u) { if (xb_ld(&(bar)[XB_TMO])) break; if (_sp > XB_SPIN_CAP) { atomicAdd(&(bar)[XB_TMO], 1u); break; } } } } while (0)

struct XcdBarrier {
    unsigned* bar; unsigned x;
    volatile LAS unsigned* st;
};

__device__ __forceinline__ XcdBarrier xcd_barrier_post(unsigned* bar, volatile LAS unsigned* st) {
    XcdBarrier b; b.bar = bar; b.x = xb_xcc_id(); b.st = st;
    if (threadIdx.x == 0) (void)xb_add(&bar[XB_XCNT(b.x)], 1u);
    return b;
}
__device__ __forceinline__ void xcd_barrier_complete(unsigned* bar, unsigned x, unsigned& nloc, unsigned& nx) {
    const unsigned G = gridDim.x * gridDim.y * gridDim.z;
    unsigned sum, cnt, mine, sp = 0u;
    for (;;) {
        sum = 0u; cnt = 0u; mine = 0u;
#pragma unroll
        for (unsigned j = 0; j < 16; ++j) { const unsigned c = xb_ld(&bar[XB_XCNT(j)]); sum += c; cnt += (c > 0u) ? 1u : 0u; mine = (j == x) ? c : mine; }
        if (sum == G) break;
        __builtin_amdgcn_s_sleep(1);
        if ((++sp & 255u) == 0u) { if (xb_ld(&bar[XB_TMO])) break; if (sp > XB_SPIN_CAP) { atomicAdd(&bar[XB_TMO], 1u); break; } }
    }
    nloc = mine > 0u ? mine : 1u; nx = cnt > 0u ? cnt : 1u;
}

__device__ __forceinline__ void xcd_barrier(const XcdBarrier& b) {
    asm volatile("s_waitcnt vmcnt(0)" ::: "memory");
    __syncthreads();
    if (threadIdx.x == 0) {
        unsigned* bar = b.bar;
        __builtin_amdgcn_s_waitcnt(0);
        unsigned nloc = b.st[0], nx = b.st[1];
        if (nloc == 0u) { xcd_barrier_complete(bar, b.x, nloc, nx); b.st[0] = nloc; b.st[1] = nx; }
        const unsigned old = xb_add(&bar[XB_XSUB(b.x)], 1u);
        const unsigned gen = old / nloc;
        if (old + 1u == (gen + 1u) * nloc) {
            __builtin_amdgcn_fence(__ATOMIC_RELEASE, "agent");
            asm volatile("s_waitcnt vmcnt(0)" ::: "memory");
            const unsigned og = xb_add(&bar[XB_TOP], 1u);
            const unsigned tg = og / nx;
            if (og + 1u == (tg + 1u) * nx) xb_add(&bar[XB_TOPGEN], 1u);
            else XB_SPIN(xb_ld(&bar[XB_TOPGEN]) == tg, bar);
            __builtin_amdgcn_fence(__ATOMIC_ACQUIRE, "agent");
            xb_add(&bar[XB_XGEN(b.x)], 1u);
            asm volatile("s_waitcnt vmcnt(0)" ::: "memory");
        } else {
            XB_SPIN(xb_ld(&bar[XB_XGEN(b.x)]) == gen, bar);
            __builtin_amdgcn_fence(__ATOMIC_ACQUIRE, "agent");
            asm volatile("s_waitcnt vmcnt(0)" ::: "memory");
        }
    }
    __syncthreads();
}
constexpr float C2A = 0.125f * 1.4426950408889634f, C2C = 0.0625f * 1.4426950408889634f, LOG2E = 1.4426950408889634f;
namespace att {
typedef short bf16x8 __attribute__((ext_vector_type(8)));
typedef short s16x4 __attribute__((ext_vector_type(4)));
typedef float f32x16 __attribute__((ext_vector_type(16)));
typedef unsigned u32x4 __attribute__((ext_vector_type(4)));
typedef LAS const char* lds_cptr;
#define ATT_SBAR() __builtin_amdgcn_sched_barrier(0)
#define ATT_WAIT_BAR(N) asm volatile("s_waitcnt vmcnt(" #N ") lgkmcnt(0)\n\ts_barrier" ::: "memory")
__device__ __forceinline__ int crow(int r, int hi) { return (r & 3) + 8 * (r >> 2) + 4 * hi; }
__device__ __forceinline__ void glds16(const void* gsrc, unsigned lds_dst) { unsigned keep;
    asm volatile("s_mov_b32 %0, m0\n\ts_mov_b32 m0, %2\n\ts_nop 0\n\tglobal_load_lds_dwordx4 %1, off\n\ts_mov_b32 m0, %0" : "=&s"(keep) : "v"(gsrc), "s"(lds_dst) : "memory"); }
__device__ __forceinline__ float max3f(float a, float b, float c) { float r; asm("v_max3_f32 %0, %1, %2, %3" : "=v"(r) : "v"(a), "v"(b), "v"(c)); return r; }
typedef float f32x2_t __attribute__((ext_vector_type(2))); typedef __bf16 bf16x2_t __attribute__((ext_vector_type(2)));
__device__ __forceinline__ unsigned cvtpk_s(float lo, float hi) { f32x2_t v = {lo, hi}; bf16x2_t b = __builtin_convertvector(v, bf16x2_t); return __builtin_bit_cast(unsigned, b); }
template <int NKS, int CHUNK_STRIDE>
__device__ __forceinline__ void qkt(f32x16& p0, f32x16& p1, lds_cptr Kslot, const bf16x8* qr, const f32x16& c0, int r32, int hi) {
    lds_cptr kb = Kslot + hi * CHUNK_STRIDE + r32 * 16;
    p0 = c0; p1 = c0;
#pragma unroll
    for (int d0 = 0; d0 < NKS; ++d0) {
        const bf16x8 b0 = *(const LAS bf16x8*)(kb + d0 * 2 * CHUNK_STRIDE);
        const bf16x8 b1 = *(const LAS bf16x8*)(kb + d0 * 2 * CHUNK_STRIDE + 512);
        p0 = __builtin_amdgcn_mfma_f32_32x32x16_bf16(b0, qr[d0], p0, 0, 0, 0);
        p1 = __builtin_amdgcn_mfma_f32_32x32x16_bf16(b1, qr[d0], p1, 0, 0, 0);
    }
}
__device__ __forceinline__ float rowmax(const f32x16& p0, const f32x16& p1) {
    float a = max3f(p0[0], p0[1], p1[0]), b = max3f(p0[2], p0[3], p1[1]); a = max3f(a, p1[2], p1[3]);
#pragma unroll
    for (int r = 4; r < 16; r += 4) { a = max3f(a, p0[r], p0[r + 1]); b = max3f(b, p0[r + 2], p0[r + 3]); a = max3f(a, p1[r], p1[r + 1]); b = max3f(b, p1[r + 2], p1[r + 3]); }
    const float m = fmaxf(a, b);
    auto rr = __builtin_amdgcn_permlane32_swap(__float_as_uint(m), __float_as_uint(m), false, false);
    return fmaxf(__uint_as_float(rr[0]), __uint_as_float(rr[1]));
}
template <int ND>
__device__ __forceinline__ void pv(f32x16* o, int vb, bf16x8 pa0, bf16x8 pa1, bf16x8 pa2, bf16x8 pa3) {
#pragma unroll
    for (int d0 = 0; d0 < ND; ++d0) { s16x4 lo[4], hi[4];
#pragma unroll
        for (int ks = 0; ks < 4; ++ks) {
            asm volatile("ds_read_b64_tr_b16 %0,%1 offset:%c2" : "=&v"(lo[ks]) : "v"(vb), "i"(d0 * 4096 + ks * 1024) : "memory");
            asm volatile("ds_read_b64_tr_b16 %0,%1 offset:%c2" : "=&v"(hi[ks]) : "v"(vb), "i"(d0 * 4096 + ks * 1024 + 512) : "memory"); }
        asm volatile("s_waitcnt lgkmcnt(0)" ::: "memory"); ATT_SBAR();
#define ATT_PK(k) (bf16x8){lo[k][0], lo[k][1], lo[k][2], lo[k][3], hi[k][0], hi[k][1], hi[k][2], hi[k][3]}
        o[d0] = __builtin_amdgcn_mfma_f32_32x32x16_bf16(pa0, ATT_PK(0), o[d0], 0, 0, 0);
        o[d0] = __builtin_amdgcn_mfma_f32_32x32x16_bf16(pa1, ATT_PK(1), o[d0], 0, 0, 0);
        o[d0] = __builtin_amdgcn_mfma_f32_32x32x16_bf16(pa2, ATT_PK(2), o[d0], 0, 0, 0);
        o[d0] = __builtin_amdgcn_mfma_f32_32x32x16_bf16(pa3, ATT_PK(3), o[d0], 0, 0, 0);
#undef ATT_PK
    }
}
constexpr int A_K = 0, A_V = 16384, A_WS = 32768, A_BT = 34816, A_OST = 36864, A_BYTES = A_OST + 8 * 4096;
__device__ __forceinline__ void attnA_unit(int b, int h, int qb, bf16* QO, const bf16* KA, const bf16* VA, const float* relb, LAS unsigned char* L) {
    int tid = threadIdx.x; asm volatile("" : "+v"(tid));
    const int lane = tid & 63, r32 = lane & 31, hi = lane >> 5; const int wid = __builtin_amdgcn_readfirstlane(tid >> 6);
    const long rowbase = (long)b * 2048; const int q0 = qb * 256;
    bf16* Qw = QO + (rowbase + q0 + wid * 32) * 1024 + h * 64;
    const bf16 *Kh = KA + rowbase * 1024 + h * 64, *Vh = VA + rowbase * 1024 + h * 64;
    const unsigned lds0 = (unsigned)(uintptr_t)L;
    LAS float* wsf = (LAS float*)(L + A_WS) + wid * 64;
    LAS float* btab = (LAS float*)(L + A_BT);
    const bf16* ksrc = Kh + (long)lane * 1024 + wid * 8;
    const bf16* vsrc = Vh + (long)(16 * (wid & 3) + (lane >> 2)) * 1024 + (wid >> 2) * 32 + (lane & 3) * 8;
    const unsigned kdst = lds0 + A_K + wid * 1024, vdst = lds0 + A_V + wid * 1024;
#define DMA_K(t, slot) glds16(ksrc + (long)(t) * 64 * 1024, (unsigned)__builtin_amdgcn_readfirstlane(kdst + (slot)))
#define DMA_V(t, slot) glds16(vsrc + (long)(t) * 64 * 1024, (unsigned)__builtin_amdgcn_readfirstlane(vdst + (slot)))
    const int vb0 = (int)(lds0 + A_V) + ((lane >> 4) & 1) * 32 + (lane & 3) * 8 + (4 * hi + ((lane & 15) >> 2)) * 64;
    lds_cptr Kbase = (lds_cptr)(L + A_K);
    const int cq = 4 * qb + (wid >> 1), qi = 32 * (wid & 1) + r32;
    const int kc0 = (4 * qb - 8) > 0 ? (4 * qb - 8) : 0, kc1 = 4 * qb + 3;
    for (int i = tid; i < 257; i += 512) btab[i] = relb[h * 257 + i] * LOG2E;
    DMA_K(kc0, 0); DMA_V(kc0, 0);
    bf16x8 qr[4];
#pragma unroll
    for (int d0 = 0; d0 < 4; ++d0) qr[d0] = *reinterpret_cast<const bf16x8*>(&Qw[(long)r32 * 1024 + d0 * 16 + hi * 8]);
    float mhat = 0.f, l_run = 0.f; f32x16 o[2]; o[0] = f32x16{}; o[1] = f32x16{};
    bool first = true;
    ATT_WAIT_BAR(0);
    for (int kc = kc0; kc <= kc1; ++kc) {
        const int sl = ((kc - kc0) & 1) * 8192;
        if (kc < kc1) { DMA_K(kc + 1, sl ^ 8192); DMA_V(kc + 1, sl ^ 8192); }
        const int dC = cq - kc;
        if (dC >= 0 && dC <= 8) {
            const float c0v = ((dC >= 3) ? btab[256] : 0.f) - (first ? 0.f : mhat);
            f32x16 c0;
#pragma unroll
            for (int r = 0; r < 16; ++r) c0[r] = c0v;
            f32x16 p0, p1;
            qkt<4, 1024>(p0, p1, Kbase + sl, qr, c0, r32, hi);
            if (dC < 3) { const int base = 64 * dC + qi + 128;
#pragma unroll
                for (int r = 0; r < 16; ++r) { const int kj = crow(r, hi); int i0 = base - kj, i1 = base - kj - 32; i0 = i0 > 256 ? 256 : i0; i1 = i1 > 256 ? 256 : i1; p0[r] += btab[i0]; p1[r] += btab[i1]; }
            }
            const float rm = rowmax(p0, p1);
            if (first) {
                mhat = rm; first = false;
#pragma unroll
                for (int r = 0; r < 16; ++r) { p0[r] -= rm; p1[r] -= rm; }
            } else if (__any(rm > 8.f)) {
                const float dl = fmaxf(rm, 0.f); mhat += dl;
#pragma unroll
                for (int r = 0; r < 16; ++r) { p0[r] -= dl; p1[r] -= dl; }
                const float f = __builtin_amdgcn_exp2f(-dl); l_run *= f;
                if (hi == 0) wsf[r32] = f;
                asm volatile("s_waitcnt lgkmcnt(0)" ::: "memory");
#pragma unroll
                for (int r = 0; r < 16; ++r) { const float fr_ = wsf[crow(r, hi)]; o[0][r] *= fr_; o[1][r] *= fr_; }
            }
            float s = 0.f;
#pragma unroll
            for (int r = 0; r < 16; ++r) { p0[r] = __builtin_amdgcn_exp2f(p0[r]); p1[r] = __builtin_amdgcn_exp2f(p1[r]); s += p0[r] + p1[r]; }
            l_run += s;
            u32x4 pw0, pw1, pw2, pw3;
            pw0 = (u32x4){cvtpk_s(p0[0], p0[1]), cvtpk_s(p0[2], p0[3]), cvtpk_s(p0[4], p0[5]), cvtpk_s(p0[6], p0[7])};
            pw1 = (u32x4){cvtpk_s(p0[8], p0[9]), cvtpk_s(p0[10], p0[11]), cvtpk_s(p0[12], p0[13]), cvtpk_s(p0[14], p0[15])};
            pw2 = (u32x4){cvtpk_s(p1[0], p1[1]), cvtpk_s(p1[2], p1[3]), cvtpk_s(p1[4], p1[5]), cvtpk_s(p1[6], p1[7])};
            pw3 = (u32x4){cvtpk_s(p1[8], p1[9]), cvtpk_s(p1[10], p1[11]), cvtpk_s(p1[12], p1[13]), cvtpk_s(p1[14], p1[15])};
            ATT_SBAR();
            pv<2>(o, vb0 + sl, __builtin_bit_cast(bf16x8, pw0), __builtin_bit_cast(bf16x8, pw1), __builtin_bit_cast(bf16x8, pw2), __builtin_bit_cast(bf16x8, pw3));
        }
        ATT_WAIT_BAR(0);
    }
    { auto rr = __builtin_amdgcn_permlane32_swap(__float_as_uint(l_run), __float_as_uint(l_run), false, false); l_run = __uint_as_float(rr[0]) + __uint_as_float(rr[1]); }
    if (hi == 0) wsf[32 + r32] = l_run;
    asm volatile("s_waitcnt lgkmcnt(0)" ::: "memory");
    float rli[16];
#pragma unroll
    for (int r = 0; r < 16; ++r) rli[r] = __builtin_amdgcn_rcpf(wsf[32 + crow(r, hi)]);
    { LAS unsigned short* stg = (LAS unsigned short*)(L + A_OST) + wid * 2048;
#pragma unroll
        for (int r = 0; r < 16; ++r) { const int orow = crow(r, hi);
#pragma unroll
            for (int d0 = 0; d0 < 2; ++d0) stg[orow * 64 + d0 * 32 + r32] = (unsigned short)f2bf(o[d0][r] * rli[r]); }
        asm volatile("s_waitcnt lgkmcnt(0)" ::: "memory");
#pragma unroll
        for (int i = 0; i < 4; ++i) { const int row = i * 8 + (lane >> 3), ch = lane & 7; const u32x4 v = *(const LAS u32x4*)(stg + row * 64 + ch * 8); *(u32x4*)(Qw + (long)row * 1024 + ch * 8) = v; } }
    asm volatile("s_waitcnt lgkmcnt(0)\n\ts_barrier" ::: "memory");
#undef DMA_K
#undef DMA_V
}

constexpr int C_WS = 131072 + 1024;
__device__ __forceinline__ void attnC_unit(int b, int h, int qb, bf16* QO, const bf16* MK, const bf16* MV, LAS unsigned char* L) {
    int tid = threadIdx.x; asm volatile("" : "+v"(tid));
    const int lane = tid & 63, r32 = lane & 31, hi = lane >> 5; const int wid = __builtin_amdgcn_readfirstlane(tid >> 6);
    bf16* Qw = QO + ((long)b * 2048 + qb * 256 + wid * 32) * 1024 + h * 256;
    const bf16 *Kh = MK + (long)b * 256 * 1024 + h * 256, *Vh = MV + (long)b * 256 * 1024 + h * 256;
    const unsigned lds0 = (unsigned)(uintptr_t)L;
    LAS float* wsf = (LAS float*)(L + C_WS) + wid * 64;
#pragma unroll
    for (int j = 0; j < 16; ++j) { const int p = wid * 16 + j;
        glds16(Kh + (long)(64 * (p & 3) + lane) * 1024 + (p >> 2) * 8, (unsigned)__builtin_amdgcn_readfirstlane(lds0 + p * 1024)); }
    const bf16* qp = &Qw[(long)r32 * 1024 + hi * 8];
    bf16x8 qa[4], qb4[4];
#pragma unroll
    for (int i = 0; i < 4; ++i) qa[i] = *reinterpret_cast<const bf16x8*>(qp + i * 16);
    f32x16 S[8];
#pragma unroll
    for (int kt = 0; kt < 8; ++kt) S[kt] = f32x16{};
    ATT_WAIT_BAR(0);
    { lds_cptr kb = (lds_cptr)L + hi * 4096 + r32 * 16;
#define C_GROUP(QF, g) do { _Pragma("unroll") for (int i = 0; i < 4; ++i) { _Pragma("unroll") for (int kt = 0; kt < 8; ++kt) { \
            const bf16x8 kf = *(const LAS bf16x8*)(kb + ((g) * 4 + i) * 8192 + kt * 512); S[kt] = __builtin_amdgcn_mfma_f32_32x32x16_bf16(kf, QF[i], S[kt], 0, 0, 0); } } } while (0)
#pragma unroll
        for (int i = 0; i < 4; ++i) qb4[i] = *reinterpret_cast<const bf16x8*>(qp + (4 + i) * 16);
        C_GROUP(qa, 0);
#pragma unroll
        for (int i = 0; i < 4; ++i) qa[i] = *reinterpret_cast<const bf16x8*>(qp + (8 + i) * 16);
        C_GROUP(qb4, 1);
#pragma unroll
        for (int i = 0; i < 4; ++i) qb4[i] = *reinterpret_cast<const bf16x8*>(qp + (12 + i) * 16);
        C_GROUP(qa, 2);
        C_GROUP(qb4, 3);
#undef C_GROUP
    }
    float mx = -1e30f;
#pragma unroll
    for (int kt = 0; kt < 8; ++kt)
#pragma unroll
        for (int r = 0; r < 16; ++r) mx = fmaxf(mx, S[kt][r]);
    { auto rr = __builtin_amdgcn_permlane32_swap(__float_as_uint(mx), __float_as_uint(mx), false, false); mx = fmaxf(__uint_as_float(rr[0]), __uint_as_float(rr[1])); }
    float l_run = 0.f; bf16x8 pa[16];
#pragma unroll
    for (int kt = 0; kt < 8; ++kt) {
#pragma unroll
        for (int r = 0; r < 16; ++r) { S[kt][r] = __builtin_amdgcn_exp2f(S[kt][r] - mx); l_run += S[kt][r]; }
        const u32x4 w0 = (u32x4){cvtpk_s(S[kt][0], S[kt][1]), cvtpk_s(S[kt][2], S[kt][3]), cvtpk_s(S[kt][4], S[kt][5]), cvtpk_s(S[kt][6], S[kt][7])};
        const u32x4 w1 = (u32x4){cvtpk_s(S[kt][8], S[kt][9]), cvtpk_s(S[kt][10], S[kt][11]), cvtpk_s(S[kt][12], S[kt][13]), cvtpk_s(S[kt][14], S[kt][15])};
        pa[2 * kt] = __builtin_bit_cast(bf16x8, w0); pa[2 * kt + 1] = __builtin_bit_cast(bf16x8, w1);
    }
    ATT_WAIT_BAR(0);
#pragma unroll
    for (int j = 0; j < 16; ++j) { const int p = wid * 16 + j;
        glds16(Vh + (long)(16 * (p & 15) + (lane >> 2)) * 1024 + (p >> 4) * 32 + (lane & 3) * 8, (unsigned)__builtin_amdgcn_readfirstlane(lds0 + p * 1024)); }
    f32x16 o[8];
#pragma unroll
    for (int d0 = 0; d0 < 8; ++d0) o[d0] = f32x16{};
    ATT_WAIT_BAR(0);
    { const int vbA = (int)lds0 + ((lane >> 4) & 1) * 32 + (lane & 3) * 8 + (4 * hi + ((lane & 15) >> 2)) * 64, vbB = vbA + 65536;
#pragma unroll
        for (int s = 0; s < 16; ++s) {
#pragma unroll
            for (int d0 = 0; d0 < 8; ++d0) { s16x4 lo, hh;
                if (d0 < 4) { asm volatile("ds_read_b64_tr_b16 %0,%1 offset:%c2" : "=&v"(lo) : "v"(vbA), "i"((d0 & 3) * 16384 + s * 1024) : "memory");
                              asm volatile("ds_read_b64_tr_b16 %0,%1 offset:%c2" : "=&v"(hh) : "v"(vbA), "i"((d0 & 3) * 16384 + s * 1024 + 512) : "memory"); }
                else        { asm volatile("ds_read_b64_tr_b16 %0,%1 offset:%c2" : "=&v"(lo) : "v"(vbB), "i"((d0 & 3) * 16384 + s * 1024) : "memory");
                              asm volatile("ds_read_b64_tr_b16 %0,%1 offset:%c2" : "=&v"(hh) : "v"(vbB), "i"((d0 & 3) * 16384 + s * 1024 + 512) : "memory"); }
                asm volatile("s_waitcnt lgkmcnt(0)" : "+v"(lo), "+v"(hh) :: "memory"); ATT_SBAR();
                const bf16x8 vf = (bf16x8){lo[0], lo[1], lo[2], lo[3], hh[0], hh[1], hh[2], hh[3]};
                o[d0] = __builtin_amdgcn_mfma_f32_32x32x16_bf16(pa[s], vf, o[d0], 0, 0, 0); } } }
    { auto rr = __builtin_amdgcn_permlane32_swap(__float_as_uint(l_run), __float_as_uint(l_run), false, false); l_run = __uint_as_float(rr[0]) + __uint_as_float(rr[1]); }
    if (hi == 0) wsf[r32] = l_run;
    asm volatile("s_waitcnt lgkmcnt(0)" ::: "memory");
    float rli[16];
#pragma unroll
    for (int r = 0; r < 16; ++r) rli[r] = __builtin_amdgcn_rcpf(wsf[crow(r, hi)]);
    ATT_WAIT_BAR(0);
    { LAS unsigned short* stg = (LAS unsigned short*)L + wid * 8192;
#pragma unroll
        for (int r = 0; r < 16; ++r) { const int orow = crow(r, hi);
#pragma unroll
            for (int d0 = 0; d0 < 8; ++d0) stg[orow * 256 + d0 * 32 + r32] = (unsigned short)f2bf(o[d0][r] * rli[r]); }
        asm volatile("s_waitcnt lgkmcnt(0)" ::: "memory");
#pragma unroll
        for (int i = 0; i < 16; ++i) { const int row = i * 2 + (lane >> 5), ch = lane & 31; const u32x4 v = *(const LAS u32x4*)(stg + row * 256 + ch * 8); *(u32x4*)(Qw + (long)row * 1024 + ch * 8) = v; } }
    asm volatile("s_waitcnt lgkmcnt(0)\n\ts_barrier" ::: "memory");
}
}
namespace satt {
template <int D, int KT>
__device__ __forceinline__ void sattn_unit(LAS unsigned char* L, bf16* QO  , const float* Kc, const float* Vc  , int ncache,
                                           const bf16* Kn, const bf16* Vn  , int nnew, const float* btab  , float* copyK, float* copyV) {
    int tid = threadIdx.x; asm volatile("" : "+v"(tid));
    const int t = tid >> 5, jj = tid & 31;
    LAS float* Ks = (LAS float*)L; LAS float* Vs = Ks + KT * (D + 1); LAS float* Qs = Vs + KT * D; LAS float* Ps = Qs + 16 * D;
    const int nkeys = ncache + nnew, ntiles = (nkeys + KT - 1) / KT;
    __syncthreads();
    for (int i = tid; i < 16 * D; i += 512) Qs[i] = __uint_as_float(((unsigned)QO[(i / D) * 1024 + (i % D)]) << 16);
    float m_run = -1e30f, l_run = 0.f; float o[D / 32];
#pragma unroll
    for (int i = 0; i < D / 32; ++i) o[i] = 0.f;
    for (int tile = 0; tile < ntiles; ++tile) {
        __syncthreads();
        for (int idx = tid; idx < KT * D / 4; idx += 512) {
            const int j = idx / (D / 4), c4 = (idx % (D / 4)) * 4, key = tile * KT + j;
            float4 kv = make_float4(0.f, 0.f, 0.f, 0.f), vv = kv;
            if (key < ncache) { kv = *(const float4*)(Kc + (size_t)key * 1024 + c4); vv = *(const float4*)(Vc + (size_t)key * 1024 + c4);
                if (copyK && key >= 16) { *(float4*)(copyK + (size_t)(key - 16) * 1024 + c4) = kv; *(float4*)(copyV + (size_t)(key - 16) * 1024 + c4) = vv; } }
            else if (key < nkeys) { const uint2 a = *(const uint2*)(Kn + (size_t)(key - ncache) * 1024 + c4), b = *(const uint2*)(Vn + (size_t)(key - ncache) * 1024 + c4);
                kv = make_float4(__uint_as_float(a.x << 16), __uint_as_float(a.x & 0xffff0000u), __uint_as_float(a.y << 16), __uint_as_float(a.y & 0xffff0000u));
                vv = make_float4(__uint_as_float(b.x << 16), __uint_as_float(b.x & 0xffff0000u), __uint_as_float(b.y << 16), __uint_as_float(b.y & 0xffff0000u)); }
            LAS float* kd = Ks + j * (D + 1) + c4; kd[0] = kv.x; kd[1] = kv.y; kd[2] = kv.z; kd[3] = kv.w;
            *(LAS f32x4*)(Vs + j * D + c4) = (f32x4){vv.x, vv.y, vv.z, vv.w};
        }
        __syncthreads();
        float sc[KT / 32]; float tmax = -1e30f;
#pragma unroll
        for (int kk = 0; kk < KT / 32; ++kk) {
            const int j = jj + 32 * kk, key = tile * KT + j; float s = 0.f;
            const LAS float* qp = Qs + t * D; const LAS float* kp = Ks + j * (D + 1);
#pragma unroll 8
            for (int d = 0; d < D; ++d) s += qp[d] * kp[d];
            if (key >= nkeys) s = -1e30f;
            else if (btab) { int dd = 512 + t - key; dd = dd > 128 ? 128 : dd; s += btab[dd + 128] * LOG2E; }
            sc[kk] = s; tmax = fmaxf(tmax, s);
        }
#pragma unroll
        for (int o_ = 1; o_ < 32; o_ <<= 1) tmax = fmaxf(tmax, __shfl_xor(tmax, o_));
        const float mn = fmaxf(m_run, tmax), alpha = __builtin_amdgcn_exp2f(m_run - mn);
        float ps = 0.f;
#pragma unroll
        for (int kk = 0; kk < KT / 32; ++kk) { const float p = (sc[kk] <= -1e29f) ? 0.f : __builtin_amdgcn_exp2f(sc[kk] - mn); Ps[t * KT + jj + 32 * kk] = p; ps += p; }
#pragma unroll
        for (int o_ = 1; o_ < 32; o_ <<= 1) ps += __shfl_xor(ps, o_);
        l_run = l_run * alpha + ps; m_run = mn;
#pragma unroll
        for (int i = 0; i < D / 32; ++i) o[i] *= alpha;
        __syncthreads();
        for (int j = 0; j < KT; ++j) { const float pj = Ps[t * KT + j];
#pragma unroll
            for (int i = 0; i < D / 32; ++i) o[i] += pj * Vs[j * D + jj + 32 * i]; }
    }
    const float rl = 1.f / l_run;
#pragma unroll
    for (int i = 0; i < D / 32; ++i) QO[t * 1024 + jj + 32 * i] = (bf16)f2bf(o[i] * rl);
    __syncthreads();
}
}
namespace satt2 {
typedef short bf16x8 __attribute__((ext_vector_type(8)));
typedef short s16x4 __attribute__((ext_vector_type(4)));
typedef unsigned u32x2 __attribute__((ext_vector_type(2)));
typedef unsigned u32x4 __attribute__((ext_vector_type(4)));
template <int D, int NKT>
__device__ __forceinline__ void unit(LAS unsigned char* L, bf16* QO, const float* Kc, const float* Vc, const bf16* Kn, const bf16* Vn, const float* btab, float* copyK, float* copyV) {
    int tid = threadIdx.x; asm volatile("" : "+v"(tid));
    const int lane = tid & 63, lr = lane & 15, lg = lane >> 4; const int wave = __builtin_amdgcn_readfirstlane(tid >> 6);
    constexpr int NKS = D / 32, NDT = D / 16, WREG = D * 64;
    LAS unsigned char* wreg = L + wave * WREG;
    LAS float* Mw = (LAS float*)(L + 8 * WREG); LAS float* Lw = Mw + 128;
    const bool hasnew = (Kn != nullptr) && wave == 0;
    const int kbase = wave * 16 * NKT;
    bf16x8 qf[NKS];
#pragma unroll
    for (int ks = 0; ks < NKS; ++ks) qf[ks] = *(const bf16x8*)(QO + lr * 1024 + 32 * ks + 8 * lg);
    f32x4 st[NKT + 1];
#pragma unroll
    for (int kt = 0; kt < NKT; ++kt) {
        const int key = kbase + 16 * kt + lr; const float* kp = Kc + (size_t)key * 1024 + 8 * lg;
        f32x4 a0[NKS], a1[NKS];
#pragma unroll
        for (int ks = 0; ks < NKS; ++ks) { a0[ks] = *(const f32x4*)(kp + 32 * ks); a1[ks] = *(const f32x4*)(kp + 32 * ks + 4); }
        f32x4 acc = (f32x4){0.f, 0.f, 0.f, 0.f};
#pragma unroll
        for (int ks = 0; ks < NKS; ++ks) {
            if (copyK && key >= 16) { *(f32x4*)(copyK + (size_t)(key - 16) * 1024 + 8 * lg + 32 * ks) = a0[ks]; *(f32x4*)(copyK + (size_t)(key - 16) * 1024 + 8 * lg + 32 * ks + 4) = a1[ks]; }
            const u32x4 w = (u32x4){att::cvtpk_s(a0[ks][0], a0[ks][1]), att::cvtpk_s(a0[ks][2], a0[ks][3]), att::cvtpk_s(a1[ks][0], a1[ks][1]), att::cvtpk_s(a1[ks][2], a1[ks][3])};
            acc = __builtin_amdgcn_mfma_f32_16x16x32_bf16(__builtin_bit_cast(bf16x8, w), qf[ks], acc, 0, 0, 0); }
        if (btab) {
#pragma unroll
            for (int e = 0; e < 4; ++e) { int dd = 512 + lr - (kbase + 16 * kt + 4 * lg + e); dd = dd > 128 ? 128 : dd; acc[e] += btab[dd + 128] * LOG2E; } }
        st[kt] = acc;
    }
    st[NKT] = (f32x4){-1e30f, -1e30f, -1e30f, -1e30f};
    if (hasnew) {
        f32x4 acc = (f32x4){0.f, 0.f, 0.f, 0.f};
#pragma unroll
        for (int ks = 0; ks < NKS; ++ks) { const bf16x8 kf = *(const bf16x8*)(Kn + lr * 1024 + 32 * ks + 8 * lg); acc = __builtin_amdgcn_mfma_f32_16x16x32_bf16(kf, qf[ks], acc, 0, 0, 0); }
#pragma unroll
        for (int e = 0; e < 4; ++e) { const int dd = lr - (4 * lg + e); acc[e] += btab[dd + 128] * LOG2E; }
        st[NKT] = acc;
    }
    float mx = -1e30f;
#pragma unroll
    for (int kt = 0; kt <= NKT; ++kt)
#pragma unroll
        for (int e = 0; e < 4; ++e) mx = fmaxf(mx, st[kt][e]);
    mx = fmaxf(mx, __shfl_xor(mx, 16)); mx = fmaxf(mx, __shfl_xor(mx, 32));
    float ls = 0.f;
#pragma unroll
    for (int kt = 0; kt <= NKT; ++kt)
#pragma unroll
        for (int e = 0; e < 4; ++e) { const float p = (st[kt][e] <= -1e29f) ? 0.f : __builtin_amdgcn_exp2f(st[kt][e] - mx); st[kt][e] = p; ls += p; }
    ls += __shfl_xor(ls, 16); ls += __shfl_xor(ls, 32);
    f32x4 ot[NDT];
#pragma unroll
    for (int dt = 0; dt < NDT; ++dt) ot[dt] = (f32x4){0.f, 0.f, 0.f, 0.f};
    constexpr int NV4 = 16 * D / 4 / 64;
#pragma unroll
    for (int kt = 0; kt <= NKT; ++kt) {
        if (kt == NKT && !hasnew) break;
        f32x4 vv[NV4];
#pragma unroll
        for (int i = 0; i < NV4; ++i) { const int idx = lane + 64 * i, kl = idx / (D / 4), c4 = (idx % (D / 4)) * 4;
            if (kt < NKT) { const int key = kbase + 16 * kt + kl; vv[i] = *(const f32x4*)(Vc + (size_t)key * 1024 + c4);
                if (copyV && key >= 16) *(f32x4*)(copyV + (size_t)(key - 16) * 1024 + c4) = vv[i]; }
            else { const u32x2 b = *(const u32x2*)(Vn + kl * 1024 + c4); vv[i] = (f32x4){__uint_as_float(b.x << 16), __uint_as_float(b.x & 0xffff0000u), __uint_as_float(b.y << 16), __uint_as_float(b.y & 0xffff0000u)}; } }
        asm volatile("s_waitcnt lgkmcnt(0)" ::: "memory");
#pragma unroll
        for (int i = 0; i < NV4; ++i) { const int idx = lane + 64 * i, kl = idx / (D / 4), c4 = (idx % (D / 4)) * 4;
#pragma unroll
            for (int e = 0; e < 4; ++e) *(LAS unsigned short*)(wreg + (c4 + e) * 32 + kl * 2) = (unsigned short)f2bf(vv[i][e]); }
        u32x2 pw; pw.x = att::cvtpk_s(st[kt][0], st[kt][1]); pw.y = att::cvtpk_s(st[kt][2], st[kt][3]);
        const s16x4 pb = __builtin_bit_cast(s16x4, pw);
#pragma unroll
        for (int dt = 0; dt < NDT; ++dt) { const s16x4 va = *(const LAS s16x4*)(wreg + (16 * dt + lr) * 32 + lg * 8);
            ot[dt] = __builtin_amdgcn_mfma_f32_16x16x16bf16_1k(va, pb, ot[dt], 0, 0, 0); }
    }
    asm volatile("s_waitcnt lgkmcnt(0)" ::: "memory");
#pragma unroll
    for (int dt = 0; dt < NDT; ++dt)
#pragma unroll
        for (int e = 0; e < 4; ++e) *(LAS float*)(wreg + ((16 * dt + 4 * lg + e) * 16 + lr) * 4) = ot[dt][e];
    if (lg == 0) { Mw[wave * 16 + lr] = mx; Lw[wave * 16 + lr] = ls; }
    __syncthreads();
    for (int e = tid; e < D * 16; e += 512) { const int q = e & 15, d = e >> 4;
        float M = -1e30f;
#pragma unroll
        for (int w = 0; w < 8; ++w) M = fmaxf(M, Mw[w * 16 + q]);
        float num = 0.f, den = 0.f;
#pragma unroll
        for (int w = 0; w < 8; ++w) { const float f = __builtin_amdgcn_exp2f(Mw[w * 16 + q] - M); den += f * Lw[w * 16 + q]; num += f * *(const LAS float*)(L + w * WREG + (d * 16 + q) * 4); }
        QO[q * 1024 + d] = (bf16)f2bf(num / den); }
    __syncthreads();
}
}
namespace gdn {
typedef short bf16x8 __attribute__((ext_vector_type(8)));
typedef short s16x4 __attribute__((ext_vector_type(4)));
typedef float f32x4 __attribute__((ext_vector_type(4)));
typedef unsigned u32x2 __attribute__((ext_vector_type(2)));
typedef unsigned u32x4 __attribute__((ext_vector_type(4)));
constexpr int QN = 0, KN = 17408  , KNT = 34816, VT = 53248  , ABF = 71680, AQK = 80896, DBF = 90112, AD = 92160, ST = 96512,
              GV = 131328, BETA = GV + 256, EGT = GV + 512, EGR = GV + 768, BEG = GV + 1024, CARRY = GV + 1280, RMS = CARRY + 4608, NB = RMS + 1024, G_END = NB + 6144;
constexpr int S272 = 272, S144 = 144;
__device__ __forceinline__ float bf2f(short s) { return __uint_as_float(((unsigned)(unsigned short)s) << 16); }
__device__ __forceinline__ unsigned pk(float lo, float hi) { return att::cvtpk_s(lo, hi); }
__device__ __forceinline__ s16x4 pk4(const f32x4& v) { u32x2 w; w.x = pk(v[0], v[1]); w.y = pk(v[2], v[3]); return __builtin_bit_cast(s16x4, w); }
__device__ __forceinline__ s16x4 pk4n(const f32x4& v) { u32x2 w; w.x = pk(-v[0], -v[1]); w.y = pk(-v[2], -v[3]); return __builtin_bit_cast(s16x4, w); }
#define G_MMA32(a, b, c) __builtin_amdgcn_mfma_f32_16x16x32_bf16(a, b, c, 0, 0, 0)
#define G_MMA16(a, b, c) __builtin_amdgcn_mfma_f32_16x16x16bf16_1k(a, b, c, 0, 0, 0)
#define G_FRAG8(base, stride, row, kb) (*(const LAS bf16x8*)((base) + (row) * (stride) + (kb)))

#define DBG_FLAG(k, cond) do {} while (0)
#define DBG_X(k) do {} while (0)
__device__ __forceinline__ void gdn_unit(LAS unsigned char* L, const bf16* QKVB, bf16* OB, const float* AB, long row0, int h, int nchunks, int nvalid,
                                         const float* alog, const float* dtb, const float* normg, const float* S0, float* Sout, unsigned long long* tsum = nullptr) {
    unsigned long long tacc0 = 0, tacc1 = 0, tacc2 = 0, tacc3 = 0, tacc4 = 0, tlast = 0;
#define GT_MARK(v) do { if (tsum) { const unsigned long long n_ = __builtin_amdgcn_s_memrealtime(); v += n_ - tlast; tlast = n_; } } while (0)
    int tid0 = threadIdx.x; asm volatile("" : "+v"(tid0));
    const int wave = __builtin_amdgcn_readfirstlane(tid0 >> 6), wq = wave & 3; const bool grpA = wave < 4;
    const float alog_h = alog[h], dtb_h = dtb[h];
    LAS float* fGV = (LAS float*)(L + GV); LAS float* fBETA = (LAS float*)(L + BETA); LAS float* fEGT = (LAS float*)(L + EGT); LAS float* fEGR = (LAS float*)(L + EGR); LAS float* fBEG = (LAS float*)(L + BEG);
    LAS float* fRMS = (LAS float*)(L + RMS);
    f32x4 Sreg[8][2];
    u32x4 pfq[2], pfk[2], pfv[2]; float pfa = 0.f, pfb = 0.f;
#define G_ISSUE(cn) do { const long r0_ = row0 + (long)(cn) * 64; _Pragma("unroll") for (int i_ = 0; i_ < 2; ++i_) { const int idx_ = (int)(threadIdx.x) + 512 * i_, row_ = idx_ >> 4, ch_ = idx_ & 15; \
        unsigned z_ = 0u; asm volatile("" : "+v"(z_)); pfq[i_] = (u32x4){z_, z_, z_, z_}; pfk[i_] = pfq[i_]; pfv[i_] = pfq[i_]; \
        if (row_ < nvalid) { const bf16* b_ = QKVB + (r0_ + row_) * 3072 + h * 128 + ch_ * 8; pfq[i_] = *(const u32x4*)b_; pfk[i_] = *(const u32x4*)(b_ + 1024); pfv[i_] = *(const u32x4*)(b_ + 2048); } } \
        if (wave == 0) { const int ln_ = (int)(threadIdx.x) & 63; pfa = 0.f; pfb = 0.f; if (ln_ < nvalid) { const float* ab_ = AB + (r0_ + ln_) * 16; pfa = ab_[h]; pfb = ab_[8 + h]; } } } while (0)
    {
    const int tid = tid0, lane = tid & 63, lr = lane & 15, lg = lane >> 4;
    for (int i = tid; i < 9216 / 4; i += 512) ((LAS unsigned*)(L + AQK))[i] = 0u;
    if (grpA) {
#pragma unroll
        for (int j = 0; j < 8; ++j)
#pragma unroll
            for (int ct = 0; ct < 2; ++ct) { f32x4 v = (f32x4){0.f, 0.f, 0.f, 0.f};
                if (S0) {
#pragma unroll
                    for (int e = 0; e < 4; ++e) v[e] = S0[(size_t)(16 * j + 4 * lg + e) * 128 + 32 * wq + 16 * ct + lr]; }
                Sreg[j][ct] = v;
                *(LAS s16x4*)(L + ST + (32 * wq + 16 * ct + lr) * S272 + (16 * j + 4 * lg) * 2) = pk4(v); }
    }
    }
    G_ISSUE(0);
    __syncthreads();
    for (int c = 0; c < nchunks; ++c) {
        const long crow0 = row0 + (long)c * 64;
        if (tsum && c == 0) tlast = __builtin_amdgcn_s_memrealtime();
        int tid = threadIdx.x; asm volatile("" : "+v"(tid));
        const int lane = tid & 63, lr = lane & 15, lg = lane >> 4;
        if (wave == 0) {
            float g = 0.f, beta = 0.f;
            if (lane < nvalid) { const float a = pfa + dtb_h; const float sp = a > 20.f ? a : log1pf(__expf(a)); g = -__expf(alog_h) * sp; beta = 1.f / (1.f + __expf(-pfb)); }
            float G = g;
#pragma unroll
            for (int o = 1; o < 64; o <<= 1) { const float n = __shfl_up(G, o); if (lane >= o) G += n; }
            const float G63 = __shfl(G, 63);
            fGV[lane] = G; fBETA[lane] = beta; fEGT[lane] = __expf(G); fEGR[lane] = __expf(G63 - G); fBEG[lane] = beta * __expf(G);
        }
#pragma unroll
        for (int i = 0; i < 2; ++i) { const int idx = tid + 512 * i, row = idx >> 4, ch = idx & 15;
            *(LAS u32x4*)(L + QN + row * S272 + ch * 16) = pfq[i]; *(LAS u32x4*)(L + KN + row * S272 + ch * 16) = pfk[i];
#pragma unroll
            for (int e = 0; e < 8; ++e) { const unsigned wk = pfk[i][e >> 1], wv = pfv[i][e >> 1];
                *(LAS unsigned short*)(L + KNT + (ch * 8 + e) * S144 + row * 2) = (unsigned short)((e & 1) ? (wk >> 16) : (wk & 0xffffu));
                *(LAS unsigned short*)(L + VT + (ch * 8 + e) * S144 + row * 2) = (unsigned short)((e & 1) ? (wv >> 16) : (wv & 0xffffu)); } }
        if (c + 1 < nchunks) G_ISSUE(c + 1);
        __syncthreads();
        GT_MARK(tacc0);
        if (grpA) {
            const int ri = wave;
            f32x4 acc = (f32x4){0.f, 0.f, 0.f, 0.f};
#pragma unroll
            for (int ks = 0; ks < 4; ++ks) { const bf16x8 a = G_FRAG8(L + KN, S272, 16 * ri + lr, ks * 64 + lg * 16); acc = G_MMA32(a, a, acc); }
            const float Gs = fGV[16 * ri + lr];
            const f32x4 Gt = *(const LAS f32x4*)(fGV + 16 * ri + 4 * lg), Bt = *(const LAS f32x4*)(fBETA + 16 * ri + 4 * lg);
            f32x4 n1;
#pragma unroll
            for (int e = 0; e < 4; ++e) n1[e] = (lr < 4 * lg + e) ? -acc[e] * Bt[e] * __expf(Gt[e] - Gs) : 0.f;
            LAS unsigned char* nb = L + NB + wave * 1536;
#define G_NBW(off, v) do { _Pragma("unroll") for (int e_ = 0; e_ < 4; ++e_) *(LAS unsigned short*)(nb + (off) + (4 * lg + e_) * 32 + lr * 2) = (unsigned short)f2bf((v)[e_]); } while (0)
#define G_NBR(off) (*(const LAS s16x4*)(nb + (off) + lr * 32 + lg * 8))
            const f32x4 z4 = (f32x4){0.f, 0.f, 0.f, 0.f};
            G_NBW(0, n1);
            const s16x4 a1 = G_NBR(0);
            f32x4 n2 = G_MMA16(a1, pk4(n1), z4);
            G_NBW(512, n2);
            const s16x4 a2 = G_NBR(512);
            f32x4 n4 = G_MMA16(a2, pk4(n2), z4);
            G_NBW(1024, n4);
            const s16x4 a4 = G_NBR(1024);
            f32x4 R = G_MMA16(a4, pk4(n4), z4);
#pragma unroll
            for (int e = 0; e < 4; ++e) R[e] += (lr == 4 * lg + e) ? 1.f : 0.f;
            R = G_MMA16(a4, pk4(R), R);
            R = G_MMA16(a2, pk4(R), R);
            R = G_MMA16(a1, pk4(R), R);
#pragma unroll
            for (int e = 0; e < 4; ++e) *(LAS unsigned short*)(L + DBF + (16 * ri + 4 * lg + e) * 32 + lr * 2) = (unsigned short)f2bf(R[e]);
#undef G_NBW
#undef G_NBR
        } else {
            for (int it = 0; it < 4; ++it) {
                const int idx0 = (wave - 4) + 4 * it; const bool isqk = idx0 >= 6; const int idx = isqk ? idx0 - 6 : idx0 + 1;
                int ri, cj;
                if (isqk) { ri = idx < 1 ? 0 : (idx < 3 ? 1 : (idx < 6 ? 2 : 3)); cj = idx < 1 ? 0 : (idx < 3 ? idx - 1 : (idx < 6 ? idx - 3 : idx - 6)); }
                else { const int k = idx0; ri = k < 1 ? 1 : (k < 3 ? 2 : 3); cj = k < 1 ? 0 : (k < 3 ? k - 1 : k - 3); }
                f32x4 acc = (f32x4){0.f, 0.f, 0.f, 0.f};
                LAS const unsigned char* Abase = L + (isqk ? QN : KN);
#pragma unroll
                for (int ks = 0; ks < 4; ++ks) { const bf16x8 a = G_FRAG8(Abase, S272, 16 * ri + lr, ks * 64 + lg * 16), b = G_FRAG8(L + KN, S272, 16 * cj + lr, ks * 64 + lg * 16); acc = G_MMA32(a, b, acc); }
                const int s = 16 * cj + lr; const float Gs = fGV[s];
                const f32x4 Gt = *(const LAS f32x4*)(fGV + 16 * ri + 4 * lg), Bt = *(const LAS f32x4*)(fBETA + 16 * ri + 4 * lg);
#pragma unroll
                for (int e = 0; e < 4; ++e) { const int tt = 16 * ri + 4 * lg + e;
                    if (isqk) { const float v = (s <= tt) ? acc[e] * __expf(Gt[e] - Gs) : 0.f; *(LAS unsigned short*)(L + AQK + tt * S144 + s * 2) = (unsigned short)f2bf(v); }
                    else { const float v = -acc[e] * Bt[e] * __expf(Gt[e] - Gs); *(LAS unsigned short*)(L + ABF + tt * S144 + s * 2) = (unsigned short)f2bf(v); } }
            }
        }
        __syncthreads();
        GT_MARK(tacc1);
        f32x4 X[4][2];
        {
            LAS const unsigned char* SRC = L + (grpA ? VT : KNT); LAS const float* SCL = grpA ? fBETA : fBEG;
            s16x4 Xb[4][2];
#pragma unroll
            for (int i = 0; i < 4; ++i) {
                const f32x4 sc = *(const LAS f32x4*)(SCL + 16 * i + 4 * lg);
#pragma unroll
                for (int ct = 0; ct < 2; ++ct) { const s16x4 raw = *(const LAS s16x4*)(SRC + (32 * wq + 16 * ct + lr) * S144 + (16 * i + 4 * lg) * 2);
                    X[i][ct] = (f32x4){bf2f(raw[0]) * sc[0], bf2f(raw[1]) * sc[1], bf2f(raw[2]) * sc[2], bf2f(raw[3]) * sc[3]}; }
            }
#pragma unroll
            for (int i = 0; i < 4; ++i) {
#pragma unroll
                for (int k = 0; k < i; ++k) { const s16x4 a = *(const LAS s16x4*)(L + ABF + (16 * i + lr) * S144 + (16 * k + 4 * lg) * 2);
#pragma unroll
                    for (int ct = 0; ct < 2; ++ct) X[i][ct] = G_MMA16(a, Xb[k][ct], X[i][ct]); }
                const s16x4 d = *(const LAS s16x4*)(L + DBF + (16 * i + lr) * 32 + (4 * lg) * 2);
#pragma unroll
                for (int ct = 0; ct < 2; ++ct) { const s16x4 tb = pk4(X[i][ct]); X[i][ct] = G_MMA16(d, tb, ((f32x4){0.f, 0.f, 0.f, 0.f})); Xb[i][ct] = pk4(X[i][ct]); }
            }
            if (!grpA) {
#pragma unroll
                for (int i = 0; i < 4; ++i)
#pragma unroll
                    for (int ct = 0; ct < 2; ++ct)
#pragma unroll
                        for (int e = 0; e < 4; ++e) *(LAS unsigned short*)(L + KN + (16 * i + 4 * lg + e) * S272 + (32 * wq + 16 * ct + lr) * 2) = (unsigned short)f2bf(-X[i][ct][e]);
            }
        }
        DBG_X(2);
        __syncthreads();
        GT_MARK(tacc2);
        {
            bf16x8 bS[2][4];
#pragma unroll
            for (int ct = 0; ct < 2; ++ct)
#pragma unroll
                for (int ks = 0; ks < 4; ++ks) bS[ct][ks] = G_FRAG8(L + ST, S272, 32 * wq + 16 * ct + lr, ks * 64 + lg * 16);
            LAS const unsigned char* Abase = L + (grpA ? KN : QN);
            if (!grpA) {
#pragma unroll
                for (int i = 0; i < 4; ++i) { X[i][0] = (f32x4){0.f, 0.f, 0.f, 0.f}; X[i][1] = (f32x4){0.f, 0.f, 0.f, 0.f}; } }
#pragma unroll
            for (int i = 0; i < 4; ++i)
#pragma unroll
                for (int ks = 0; ks < 4; ++ks) { const bf16x8 a = G_FRAG8(Abase, S272, 16 * i + lr, ks * 64 + lg * 16);
#pragma unroll
                    for (int ct = 0; ct < 2; ++ct) X[i][ct] = G_MMA32(a, bS[ct][ks], X[i][ct]); }
            if (grpA) {
#pragma unroll
                for (int i = 0; i < 4; ++i)
#pragma unroll
                    for (int ct = 0; ct < 2; ++ct) *(LAS s16x4*)(L + VT + (32 * wq + 16 * ct + lr) * S144 + (16 * i + 4 * lg) * 2) = pk4(X[i][ct]);
            }
        }
        DBG_X(3);
        __syncthreads();
        GT_MARK(tacc3);
        if (grpA) {
            const float eg63 = fEGT[63];
            bf16x8 bsc[2][2];
#pragma unroll
            for (int ct = 0; ct < 2; ++ct)
#pragma unroll
                for (int ks = 0; ks < 2; ++ks) { const bf16x8 raw = G_FRAG8(L + VT, S144, 32 * wq + 16 * ct + lr, ks * 64 + lg * 16);
                    const f32x4 e0 = *(const LAS f32x4*)(fEGR + 32 * ks + 8 * lg), e1 = *(const LAS f32x4*)(fEGR + 32 * ks + 8 * lg + 4);
                    const u32x4 w = (u32x4){pk(bf2f(raw[0]) * e0[0], bf2f(raw[1]) * e0[1]), pk(bf2f(raw[2]) * e0[2], bf2f(raw[3]) * e0[3]), pk(bf2f(raw[4]) * e1[0], bf2f(raw[5]) * e1[1]), pk(bf2f(raw[6]) * e1[2], bf2f(raw[7]) * e1[3])};
                    bsc[ct][ks] = __builtin_bit_cast(bf16x8, w); }
#pragma unroll
            for (int j = 0; j < 8; ++j) {
#pragma unroll
                for (int ct = 0; ct < 2; ++ct) Sreg[j][ct] = Sreg[j][ct] * eg63;
#pragma unroll
                for (int ks = 0; ks < 2; ++ks) { const bf16x8 a = G_FRAG8(L + KNT, S144, 16 * j + lr, ks * 64 + lg * 16);
#pragma unroll
                    for (int ct = 0; ct < 2; ++ct) Sreg[j][ct] = G_MMA32(a, bsc[ct][ks], Sreg[j][ct]); }
#pragma unroll
                for (int ct = 0; ct < 2; ++ct) *(LAS s16x4*)(L + ST + (32 * wq + 16 * ct + lr) * S272 + (16 * j + 4 * lg) * 2) = pk4(Sreg[j][ct]);
            }
            __syncthreads();
        } else {
            f32x4 O2[4][2];
#pragma unroll
            for (int i = 0; i < 4; ++i) { O2[i][0] = (f32x4){0.f, 0.f, 0.f, 0.f}; O2[i][1] = (f32x4){0.f, 0.f, 0.f, 0.f}; }
            bf16x8 bW[2][2];
#pragma unroll
            for (int ct = 0; ct < 2; ++ct)
#pragma unroll
                for (int ks = 0; ks < 2; ++ks) bW[ct][ks] = G_FRAG8(L + VT, S144, 32 * wq + 16 * ct + lr, ks * 64 + lg * 16);
#pragma unroll
            for (int i = 0; i < 4; ++i)
#pragma unroll
                for (int ks = 0; ks < 2; ++ks) { const bf16x8 a = G_FRAG8(L + AQK, S144, 16 * i + lr, ks * 64 + lg * 16);
#pragma unroll
                    for (int ct = 0; ct < 2; ++ct) O2[i][ct] = G_MMA32(a, bW[ct][ks], O2[i][ct]); }
#pragma unroll
            for (int i = 0; i < 4; ++i) { const f32x4 eg = *(const LAS f32x4*)(fEGT + 16 * i + 4 * lg);
#pragma unroll
                for (int ct = 0; ct < 2; ++ct) X[i][ct] = X[i][ct] * eg + O2[i][ct];
                f32x4 p = X[i][0] * X[i][0] + X[i][1] * X[i][1];
#pragma unroll
                for (int e = 0; e < 4; ++e) { float v = p[e]; v += __shfl_xor(v, 1); v += __shfl_xor(v, 2); v += __shfl_xor(v, 4); v += __shfl_xor(v, 8); p[e] = v; }
                if (lr == 0) {
#pragma unroll
                    for (int e = 0; e < 4; ++e) fRMS[(16 * i + 4 * lg + e) * 4 + wq] = p[e]; } }
            DBG_X(4);
            __syncthreads();
            const float ng0 = normg[32 * wq + lr], ng1 = normg[32 * wq + 16 + lr];
#pragma unroll
            for (int i = 0; i < 4; ++i)
#pragma unroll
                for (int e = 0; e < 4; ++e) { const int tt = 16 * i + 4 * lg + e;
                    const f32x4 pr = *(const LAS f32x4*)(fRMS + tt * 4); const float rstd = rsqrtf((pr[0] + pr[1] + pr[2] + pr[3]) * (1.f / 128.f) + 1e-6f);
                    if (tt < nvalid) { bf16* orow = OB + (crow0 + tt) * 3072 + h * 128 + 32 * wq + lr;
                        orow[0] = (bf16)f2bf(X[i][0][e] * rstd * ng0); orow[16] = (bf16)f2bf(X[i][1][e] * rstd * ng1); } }
        }
        GT_MARK(tacc4);
    }
    if (grpA) {
        const int lane = tid0 & 63, lr = lane & 15, lg = lane >> 4;
#pragma unroll
        for (int j = 0; j < 8; ++j)
#pragma unroll
            for (int ct = 0; ct < 2; ++ct)
#pragma unroll
                for (int e = 0; e < 4; ++e) Sout[(size_t)(16 * j + 4 * lg + e) * 128 + 32 * wq + 16 * ct + lr] = Sreg[j][ct][e];
    }
    __syncthreads();
    if (tsum && threadIdx.x == 0) { tsum[0] = tacc0; tsum[1] = tacc1; tsum[2] = tacc2; tsum[3] = tacc3; tsum[4] = tacc4; tsum[5] = tacc0 + tacc1 + tacc2 + tacc3 + tacc4; }
}
#undef GT_MARK
#undef G_ISSUE

__device__ __forceinline__ void conv_unit(bf16* QKVB, const bf16* SB, const float* wconv, const float* convst, long r0, int nrows, int sbrow, int op) {
    int tid = threadIdx.x; asm volatile("" : "+v"(tid));
    const int cg = tid & 127, seg = tid >> 7, col = op * 1024 + cg * 8;
    const bool act = seg * 8 < nrows;
    bf16x8 x[11];
#pragma unroll
    for (int i = 0; i < 11; ++i) x[i] = (bf16x8){0, 0, 0, 0, 0, 0, 0, 0};
    if (act) {
#pragma unroll
        for (int j = 0; j < 3; ++j) {
            if (seg > 0) x[j] = *(const bf16x8*)(QKVB + (r0 + 8 * seg - 3 + j) * 3072 + col);
            else if (sbrow >= 0) x[j] = *(const bf16x8*)(SB + (size_t)(sbrow + j) * 3072 + col);
            else if (convst) { const f32x4 a = *(const f32x4*)(convst + j * 3072 + col), b = *(const f32x4*)(convst + j * 3072 + col + 4);
                const u32x4 w = (u32x4){pk(a[0], a[1]), pk(a[2], a[3]), pk(b[0], b[1]), pk(b[2], b[3])}; x[j] = __builtin_bit_cast(bf16x8, w); }
        }
#pragma unroll
        for (int i = 0; i < 8; ++i) x[3 + i] = *(const bf16x8*)(QKVB + (r0 + 8 * seg + i) * 3072 + col);
    }
    f32x4 w0[4], w1[4];
#pragma unroll
    for (int j = 0; j < 4; ++j) { w0[j] = *(const f32x4*)(wconv + j * 3072 + col); w1[j] = *(const f32x4*)(wconv + j * 3072 + col + 4); }
    __syncthreads();
    if (act) {
#pragma unroll
        for (int i = 0; i < 8; ++i) {
            float y[8];
#pragma unroll
            for (int e = 0; e < 8; ++e) y[e] = 0.f;
#pragma unroll
            for (int j = 0; j < 4; ++j) {
#pragma unroll
                for (int e = 0; e < 4; ++e) { y[e] += w0[j][e] * bf2f(x[i + j][e]); y[4 + e] += w1[j][e] * bf2f(x[i + j][4 + e]); } }
            float ss = 0.f;
#pragma unroll
            for (int e = 0; e < 8; ++e) { y[e] = y[e] * __builtin_amdgcn_rcpf(1.f + __expf(-y[e])); ss += y[e] * y[e]; }
            float r = 1.f;
            if (op < 2) { ss += __shfl_xor(ss, 1); ss += __shfl_xor(ss, 2); ss += __shfl_xor(ss, 4); ss += __shfl_xor(ss, 8); r = rsqrtf(ss + 1e-6f); if (op == 0) r *= 0.08838834764831845f; }
            const u32x4 w = (u32x4){pk(y[0] * r, y[1] * r), pk(y[2] * r, y[3] * r), pk(y[4] * r, y[5] * r), pk(y[6] * r, y[7] * r)};
            *(u32x4*)(QKVB + (r0 + 8 * seg + i) * 3072 + col) = w;
        }
    }
    __syncthreads();
}
#undef G_MMA32
#undef G_MMA16
#undef G_FRAG8
}
constexpr int NWAVES = 8;
constexpr int R_P = 32768, R_S = 512, R_ALL = 33280;
constexpr size_t MiB = 1u << 20;
constexpr size_t WS_CTL = 0, CTL_ZERO_BYTES = 1 * MiB;
constexpr size_t WS_WIN = 1 * MiB;
constexpr size_t WS_WG = 16 * MiB;
constexpr size_t WS_WMEM = 22 * MiB;
constexpr size_t WS_WOUT = 26 * MiB;
constexpr size_t WS_WFF1 = 28 * MiB;
constexpr size_t WS_WFF2 = 36 * MiB;
constexpr size_t WS_AB = 44 * MiB;
constexpr size_t WS_MK = 47 * MiB, WS_MV = 55 * MiB, WS_MB = 63 * MiB;
constexpr size_t WS_QA = 72 * MiB, WS_KA = 138 * MiB, WS_VA = 204 * MiB;
constexpr size_t WS_QKVB = 270 * MiB;
constexpr size_t WS_SB = 466 * MiB;
constexpr size_t WS_SMG = 486 * MiB, WS_ST1 = 487 * MiB, WS_SHB = 489 * MiB, WS_SFF = 490 * MiB;
constexpr size_t WS_END = 494 * MiB;
constexpr size_t DO_XB = 0, DO_QC = 65 * MiB;
constexpr int CW_BAR = 4096;
constexpr int CW_CHK = 1024;
constexpr int CW_QUEUE = 2048;
constexpr int CW_SC = 8192;
constexpr int CW_TS = 3072;
constexpr int LDS_BYTES = 147456, RING_BYTES = 131072, MISC_OFF = LDS_BYTES - 256;

struct Args { const float* in[25]; float* out; unsigned char* ws; int ph_lo, ph_hi; };

__device__ __forceinline__ void p0_transpose_item(const float* W, int K, int N, int col_off, int nvalid, bf16* WT, int row_off, int nblk, LAS float* scr, int item, int lane) {
    const int kb = item / nblk, nb = item % nblk, k0 = 64 * kb, n0 = 32 * nb;
    const bool ok = (n0 + (lane & 31)) < nvalid;
#pragma unroll 8
    for (int i = 0; i < 32; ++i) { const int kk = 2 * i + (lane >> 5); scr[kk * 33 + (lane & 31)] = ok ? W[(size_t)(k0 + kk) * N + col_off + n0 + (lane & 31)] : 0.f; }
    LDS_WAIT(); asm volatile("" ::: "memory");
    const int c = lane & 7;
#pragma unroll
    for (int j = 0; j < 4; ++j) { const int n = (lane >> 3) + 8 * j; const LAS float* s = scr + (8 * c) * 33 + n;
        v4u o; o.x = pk2(s[0 * 33], s[1 * 33]); o.y = pk2(s[2 * 33], s[3 * 33]); o.z = pk2(s[4 * 33], s[5 * 33]); o.w = pk2(s[6 * 33], s[7 * 33]);
        *(GAS v4u*)(WT + (size_t)(row_off + n0 + n) * K + k0 + 8 * c) = o; }
    LDS_WAIT(); asm volatile("" ::: "memory");
}
__device__ __forceinline__ void cvt_row_bf16(const float* xrow, bf16* orow, int lane) {
    const GAS f32x4* xr = (const GAS f32x4*)xrow + lane;
    GAS unsigned long long* o8 = (GAS unsigned long long*)orow + lane;
    f32x4 v[4];
#pragma unroll
    for (int j = 0; j < 4; ++j) v[j] = xr[64 * j];
#pragma unroll
    for (int j = 0; j < 4; ++j) o8[64 * j] = (unsigned long long)pk2(v[j].x, v[j].y) | ((unsigned long long)pk2(v[j].z, v[j].w) << 32);
}

struct P1Order {
    int G, c;
    static constexpr int nM0 = 130, nN0 = 29, nwg0 = nM0 * nN0, nM1 = 16, nN1 = 8, nwg1 = nM1 * nN1, nwg = nwg0 + nwg1;
    __device__ __forceinline__ bool next(int i, pg8::Unit& u) const {
        const long L = (long)i * G + c; if (L >= nwg) return false;
        int wgid = (int)L; { const int q = nwg / 8, r = nwg % 8, xcd = wgid % 8, off = wgid / 8; wgid = (xcd < r ? xcd * (q + 1) : r * (q + 1) + (xcd - r) * q) + off; }
        if (wgid < nwg0) { const int nig = 8 * nN0, gid = wgid / nig, fm = gid * 8, gsz = (nM0 - fm) < 8 ? (nM0 - fm) : 8;
            u.pm = fm + ((wgid % nig) % gsz); u.pn = (wgid % nig) / gsz; u.job = 0; }
        else { const int w = wgid - nwg0; u.pm = w % nM1; u.pn = w / nM1; u.job = 1; }
        return true;
    }
    __device__ __forceinline__ void a_ready(const pg8::Unit&) const {}
    __device__ __forceinline__ void done(const pg8::Unit&) const {}
};

typedef pg8::f32x4 acc_t[2][2][4][2];
struct EpiP1 {
    static constexpr bool PERM = true, AFTER_DRAIN = false;
    unsigned char* ws; float* out;
    __device__ __forceinline__ void operator()(const acc_t& acc, const pg8::Unit& u, int wr, int wc, int fr, int fq) const {
        int lr0 = wr * 64 + fr, cl0 = wc * 32 + 8 * fq; const int pm = u.pm, pn = u.pn;
        asm volatile("" : "+v"(lr0), "+v"(cl0));
        if (u.job == 0 && pn == 28) {
            if (wc == 0 && fq < 2) {
                float* AB = (float*)(ws + WS_AB);
#pragma unroll
                for (int ai = 0; ai < 2; ++ai)
#pragma unroll
                    for (int m = 0; m < 4; ++m) { float* d = AB + (size_t)(pm * 256 + lr0 + ai * 128 + m * 16) * 16 + 8 * fq;
                        *(pg8::f32x4*)d = acc[ai][0][m][0]; *(pg8::f32x4*)(d + 4) = acc[ai][0][m][1]; }
            }
            return;
        }
        bf16* tile; bf16* sbt = nullptr; int ld = 1024; float sc = 1.f; int fmode = 0; size_t fbase = 0; int fld = 1024;
        if (u.job == 0) {
            if (pn < 12) { const int which = pn >> 2, colt = (pn & 3) * 256;
                tile = (bf16*)(ws + (which == 0 ? WS_QA : (which == 1 ? WS_KA : WS_VA))) + (size_t)pm * 256 * 1024 + colt; if (which == 0) sc = C2A;
                if (which != 0) { const bool smp = pm >= 128;
                    if (smp) { fmode = 2; fbase = (which == 1 ? O_AKS : O_AVS) + colt; }
                    else if ((pm & 7) >= 6) { fmode = 1; fbase = (which == 1 ? O_AKP : O_AVP) + ((size_t)(pm >> 3) * 512 + ((pm & 7) - 6) * 256) * 1024 + colt; } }
            } else if (pn < 24) { const int c3t = (pn - 12) * 256; ld = 3072; fld = 3072;
                tile = (bf16*)(ws + WS_QKVB) + (size_t)pm * 256 * 3072 + c3t;
                if (pm >= 128) { fmode = 4; fbase = O_CONVS + c3t; } else { sbt = (bf16*)(ws + WS_SB) + (size_t)pm * 8 * 3 * 3072 + c3t; if ((pm & 7) == 7) { fmode = 3; fbase = O_CONVP + (size_t)(pm >> 3) * 3 * 3072 + c3t; } }
            } else { tile = (bf16*)((unsigned char*)out + DO_QC) + (size_t)pm * 256 * 1024 + (pn - 24) * 256; sc = C2C; }
        } else { const int isv = pn >> 2, colt = (pn & 3) * 256;
            tile = (bf16*)(ws + (isv ? WS_MV : WS_MK)) + (size_t)pm * 256 * 1024 + colt; fmode = 5; fbase = (isv ? O_MVP : O_MKP) + (size_t)pm * 256 * 1024 + colt; }
#pragma unroll
        for (int ai = 0; ai < 2; ++ai)
#pragma unroll
            for (int m = 0; m < 4; ++m) {
                const int lr = lr0 + ai * 128 + m * 16;
                bf16* rowp = tile + (size_t)lr * ld + cl0;
#pragma unroll
                for (int bj = 0; bj < 2; ++bj) { const pg8::f32x4 v0 = acc[ai][bj][m][0] * sc, v1 = acc[ai][bj][m][1] * sc;
                    pg8::u32x4 w; w.x = pg8::cvt_pk_bf16(v0[0], v0[1]); w.y = pg8::cvt_pk_bf16(v0[2], v0[3]); w.z = pg8::cvt_pk_bf16(v1[0], v1[1]); w.w = pg8::cvt_pk_bf16(v1[2], v1[3]);
                    *(pg8::u32x4*)(rowp + bj * 128) = w;
                    if (sbt && (lr & 31) >= 29) *(pg8::u32x4*)(sbt + (size_t)((lr >> 5) * 3 + (lr & 31) - 29) * 3072 + cl0 + bj * 128) = w; }
                if (fmode) {
                    long drow = -1;
                    if (fmode == 1 || fmode == 5) drow = lr;
                    else if (fmode == 2) { const int rs = (pm - 128) * 256 + lr; drow = (long)(rs >> 4) * 512 + 496 + (rs & 15); }
                    else if (fmode == 3) { if (lr >= 253) drow = lr - 253; }
                    else { const int rs = (pm - 128) * 256 + lr; if ((rs & 15) >= 13) drow = (long)(rs >> 4) * 3 + (rs & 15) - 13; }
                    if (drow >= 0) { float* d = out + fbase + (size_t)drow * fld + cl0;
#pragma unroll
                        for (int bj = 0; bj < 2; ++bj) { *(pg8::f32x4*)(d + bj * 128) = acc[ai][bj][m][0]; *(pg8::f32x4*)(d + bj * 128 + 4) = acc[ai][bj][m][1]; } }
                }
                asm volatile("" ::: "memory");
            }
    }
};

template <int NM> struct P3OrderT {
    int G, c;
    static constexpr int nM = NM, nP = 4, npair = nM * nP;
    __device__ __forceinline__ bool next(int i, pg8::Unit& u) const {
        const int tr = i / 3, br = i - 3 * tr; const long L = (long)tr * G + c; if (L >= npair) return false;
        int wgid = (int)L; { const int q = npair / 8, r = npair % 8, xcd = wgid % 8, off = wgid / 8; wgid = (xcd < r ? xcd * (q + 1) : r * (q + 1) + (xcd - r) * q) + off; }
        const int nig = 8 * nP, gid = wgid / nig, fm = gid * 8, gsz = (nM - fm) < 8 ? (nM - fm) : 8;
        u.pm = fm + ((wgid % nig) % gsz); u.pn = br * 4 + (wgid % nig) / gsz; u.job = 0; return true;
    }
    __device__ __forceinline__ void a_ready(const pg8::Unit&) const {}
    __device__ __forceinline__ void done(const pg8::Unit&) const {}
};
__device__ __forceinline__ float bflo(unsigned w) { return __uint_as_float(w << 16); }
__device__ __forceinline__ float bfhi(unsigned w) { return __uint_as_float(w & 0xffff0000u); }
__device__ __forceinline__ float sigmoid_f(float g) { return __builtin_amdgcn_rcpf(1.f + __builtin_amdgcn_exp2f(-g * LOG2E)); }
struct EpiGate {
    static constexpr bool PERM = true, AFTER_DRAIN = false;
    unsigned char* ws; unsigned char* outb; int smp;
    __device__ __forceinline__ void operator()(const acc_t& acc, const pg8::Unit& u, int wr, int wc, int fr, int fq) const {
        int lr0 = wr * 64 + fr, cl0 = wc * 32 + 8 * fq; const int pm = u.pm, br = u.pn >> 2, pc = u.pn & 3;
        asm volatile("" : "+v"(lr0), "+v"(cl0));
        const bf16* ob; int ldo = 1024;
        if (br == 0) ob = (const bf16*)(ws + WS_QA); else if (br == 1) { ob = (const bf16*)(ws + WS_QKVB); ldo = 3072; } else ob = (const bf16*)(outb + DO_QC);
        ob += (size_t)(pm * 256 + (smp ? R_P : 0)) * ldo + pc * 256 + cl0;
        bf16* mg = (bf16*)(ws + (smp ? WS_SMG : WS_KA)) + (size_t)pm * 256 * 1024 + pc * 256 + cl0;
#pragma unroll
        for (int ai = 0; ai < 2; ++ai)
#pragma unroll
            for (int m = 0; m < 4; ++m) {
                const int lr = lr0 + ai * 128 + m * 16;
#pragma unroll
                for (int bj = 0; bj < 2; ++bj) {
                    const pg8::u32x4 ov = *(const pg8::u32x4*)(ob + (size_t)lr * ldo + bj * 128);
                    const pg8::f32x4 g0 = acc[ai][bj][m][0], g1 = acc[ai][bj][m][1];
                    float v[8];
                    v[0] = sigmoid_f(g0[0]) * bflo(ov.x); v[1] = sigmoid_f(g0[1]) * bfhi(ov.x); v[2] = sigmoid_f(g0[2]) * bflo(ov.y); v[3] = sigmoid_f(g0[3]) * bfhi(ov.y);
                    v[4] = sigmoid_f(g1[0]) * bflo(ov.z); v[5] = sigmoid_f(g1[1]) * bfhi(ov.z); v[6] = sigmoid_f(g1[2]) * bflo(ov.w); v[7] = sigmoid_f(g1[3]) * bfhi(ov.w);
                    pg8::u32x4* mp = (pg8::u32x4*)(mg + (size_t)lr * 1024 + bj * 128);
                    if (br != 0) { const pg8::u32x4 pv = *mp;
                        v[0] += bflo(pv.x); v[1] += bfhi(pv.x); v[2] += bflo(pv.y); v[3] += bfhi(pv.y); v[4] += bflo(pv.z); v[5] += bfhi(pv.z); v[6] += bflo(pv.w); v[7] += bfhi(pv.w); }
                    pg8::u32x4 w; w.x = pg8::cvt_pk_bf16(v[0], v[1]); w.y = pg8::cvt_pk_bf16(v[2], v[3]); w.z = pg8::cvt_pk_bf16(v[4], v[5]); w.w = pg8::cvt_pk_bf16(v[6], v[7]);
                    *mp = w;
                }
                asm volatile("" ::: "memory");
            }
    }
};
struct EpiResF32 {
    static constexpr bool PERM = false, AFTER_DRAIN = false;
    const float* res_p; const float* res_s; float* dst; const float* bias;
    __device__ __forceinline__ void operator()(const acc_t& acc, const pg8::Unit& u, int wr, int wc, int fr, int fq) const {
        int lr0 = wr * 64 + fr, cl0 = u.pn * 256 + wc * 32 + 4 * fq;
        asm volatile("" : "+v"(lr0), "+v"(cl0));
        const float* rb = (u.pm < 128) ? res_p + (size_t)u.pm * 256 * 1024 : res_s + (size_t)(u.pm - 128) * 256 * 1024;
        float* db = dst + (size_t)u.pm * 256 * 1024;
        pg8::f32x4 bv[2][2];
#pragma unroll
        for (int bj = 0; bj < 2; ++bj)
#pragma unroll
            for (int n = 0; n < 2; ++n) bv[bj][n] = bias ? *(const pg8::f32x4*)(bias + cl0 + bj * 128 + n * 16) : (pg8::f32x4){0.f, 0.f, 0.f, 0.f};
#pragma unroll
        for (int ai = 0; ai < 2; ++ai)
#pragma unroll
            for (int m = 0; m < 4; ++m) { const size_t off = (size_t)(lr0 + ai * 128 + m * 16) * 1024 + cl0;
#pragma unroll
                for (int bj = 0; bj < 2; ++bj)
#pragma unroll
                    for (int n = 0; n < 2; ++n) { const pg8::f32x4 rv = *(const pg8::f32x4*)(rb + off + bj * 128 + n * 16);
                        *(pg8::f32x4*)(db + off + bj * 128 + n * 16) = rv * DN_ALPHA + acc[ai][bj][m][n] + bv[bj][n]; }
                asm volatile("" ::: "memory"); }
    }
};
struct EpiFf1 {
    static constexpr bool PERM = true, AFTER_DRAIN = false;
    bf16* FF; const float* bias;
    __device__ __forceinline__ void operator()(const acc_t& acc, const pg8::Unit& u, int wr, int wc, int fr, int fq) const {
        int lr0 = wr * 64 + fr, cl0 = u.pn * 256 + wc * 32 + 8 * fq;
        asm volatile("" : "+v"(lr0), "+v"(cl0));
        bf16* tile = FF + (size_t)u.pm * 256 * 4096 + cl0;
        pg8::f32x4 bv[2][2];
#pragma unroll
        for (int bj = 0; bj < 2; ++bj)
#pragma unroll
            for (int n = 0; n < 2; ++n) bv[bj][n] = *(const pg8::f32x4*)(bias + cl0 + bj * 128 + 4 * n);
#pragma unroll
        for (int ai = 0; ai < 2; ++ai)
#pragma unroll
            for (int m = 0; m < 4; ++m) { bf16* rowp = tile + (size_t)(lr0 + ai * 128 + m * 16) * 4096;
#pragma unroll
                for (int bj = 0; bj < 2; ++bj) { pg8::f32x4 v0 = acc[ai][bj][m][0] + bv[bj][0], v1 = acc[ai][bj][m][1] + bv[bj][1];
#pragma unroll
                    for (int e = 0; e < 4; ++e) { v0[e] = fmaxf(v0[e], 0.f); v0[e] *= v0[e]; v1[e] = fmaxf(v1[e], 0.f); v1[e] *= v1[e]; }
                    pg8::u32x4 w; w.x = pg8::cvt_pk_bf16(v0[0], v0[1]); w.y = pg8::cvt_pk_bf16(v0[2], v0[3]); w.z = pg8::cvt_pk_bf16(v1[0], v1[1]); w.w = pg8::cvt_pk_bf16(v1[2], v1[3]);
                    *(pg8::u32x4*)(rowp + bj * 128) = w; }
                asm volatile("" ::: "memory"); }
    }
};
__device__ __forceinline__ float wsum64(float v) {
#pragma unroll
    for (int o = 1; o < 64; o <<= 1) v += __shfl_xor(v, o);
    return v;
}
__device__ __forceinline__ void ln_row(float* row, const float* g, const float* b, bf16* hb, int lane, float* dst = nullptr) {
    GAS f32x4* xr = (GAS f32x4*)row + lane; GAS f32x4* xo = dst ? (GAS f32x4*)dst + lane : xr;
    f32x4 v[4]; float s = 0.f;
#pragma unroll
    for (int j = 0; j < 4; ++j) { v[j] = xr[64 * j]; s += (v[j].x + v[j].y) + (v[j].z + v[j].w); }
    const float mean = wsum64(s) * (1.f / 1024.f); float s2 = 0.f;
#pragma unroll
    for (int j = 0; j < 4; ++j) { v[j] = v[j] - mean; s2 += (v[j].x * v[j].x + v[j].y * v[j].y) + (v[j].z * v[j].z + v[j].w * v[j].w); }
    const float rstd = 1.f / sqrtf(wsum64(s2) * (1.f / 1024.f) + LN_EPS);
#pragma unroll
    for (int j = 0; j < 4; ++j) { const f32x4 gv = *((const GAS f32x4*)g + lane + 64 * j), bv = *((const GAS f32x4*)b + lane + 64 * j);
        v[j] = v[j] * rstd * gv + bv; xo[64 * j] = v[j];
        if (hb) ((GAS unsigned long long*)hb + lane)[64 * j] = (unsigned long long)pk2(v[j].x, v[j].y) | ((unsigned long long)pk2(v[j].z, v[j].w) << 32); }
}

struct EpiSPerm {
    static constexpr bool PERM = true, AFTER_DRAIN = false;
    int kind; EpiGate eg; EpiFf1 ef;
    __device__ __forceinline__ void operator()(const acc_t& acc, const pg8::Unit& u, int wr, int wc, int fr, int fq) const { if (kind == 0) eg(acc, u, wr, wc, fr, fq); else ef(acc, u, wr, wc, fr, fq); }
};
__global__ void __launch_bounds__(NWAVES * 64, 2) mega_fwd(Args args) {
    extern __shared__ __attribute__((aligned(16))) unsigned char lds[];
    LAS unsigned char* L = (LAS unsigned char*)lds;
    volatile LAS unsigned* MISC = (volatile LAS unsigned*)(L + MISC_OFF);
    const int tid = threadIdx.x, lane = tid & 63, wave = __builtin_amdgcn_readfirstlane(tid >> 6);
#define GRID_N ((int)gridDim.x)
#define BLK_X ((int)blockIdx.x)
#define VCU ((BLK_X % 8) * (GRID_N / 8) + BLK_X / 8)
    unsigned char* ws = args.ws; float* out = args.out; unsigned char* outb = (unsigned char*)args.out;
    gu32* ctl = (gu32*)(ws + WS_CTL);
    for (int u = tid; u < (LDS_BYTES - RING_BYTES) / 4; u += NWAVES * 64) ((LAS unsigned*)(L + RING_BYTES))[u] = 0u;
    __syncthreads();
    (void)xcd_barrier_post((unsigned*)(ctl + CW_BAR), MISC + 8);
#define GRIDBAR() do { XcdBarrier bar_; bar_.bar = (unsigned*)(ws + WS_CTL) + CW_BAR; bar_.x = xb_xcc_id(); bar_.st = (volatile LAS unsigned*)(L + MISC_OFF) + 8; xcd_barrier(bar_); } while (0)
#define IN(k) (args.ph_lo <= (k) && (k) < args.ph_hi)
#if defined(PROBE_A)
#define STAMP(k) do { if (blockIdx.x == 0 && threadIdx.x == 0) ((volatile unsigned long long*)(ws + WS_CTL + CW_TS * 4))[k] = __builtin_amdgcn_s_memrealtime(); } while (0)
#else
#define STAMP(k) do {} while (0)
#endif
    STAMP(0);
#define BOTH(k) (IN(k) && IN((k) + 1))
#define XB ((bf16*)(outb + DO_XB))
#define QC ((bf16*)(outb + DO_QC))
#define WinT ((bf16*)(ws + WS_WIN))
#define WgT ((bf16*)(ws + WS_WG))
#define WmemT ((bf16*)(ws + WS_WMEM))
#define WoutT ((bf16*)(ws + WS_WOUT))
#define Wff1T ((bf16*)(ws + WS_WFF1))
#define Wff2T ((bf16*)(ws + WS_WFF2))
#define MB ((bf16*)(ws + WS_MB))
#define HB ((bf16*)(ws + WS_QKVB + 130 * MiB))
#define FF ((bf16*)(ws + WS_QA))
    if (IN(0)) {
        LAS float* scr = (LAS float*)(L + wave * 16384);
        const int gw = VCU * NWAVES + wave, NGW = GRID_N * NWAVES;
        const float *w_in = args.in[9], *w_mem = args.in[15], *w_out = args.in[16], *w_ff1 = args.in[19], *w_ff2 = args.in[21];
        constexpr int I_IN = 16 * 224, I_AB = 16 * 8, I_G = 16 * 96, I_MEM = 16 * 64, I_OUT = 16 * 32, I_F1 = 16 * 128, I_F2 = 64 * 32;
        constexpr int NITEMS = I_IN + I_AB + I_G + I_MEM + I_OUT + I_F1 + I_F2;
        for (int it = gw; it < NITEMS; it += NGW) {
            int r = it;
            if (r < I_IN) { p0_transpose_item(w_in, 1024, ZW, 0, 7168, WinT, 0, 224, scr, r, lane); continue; } r -= I_IN;
            if (r < I_AB) { p0_transpose_item(w_in, 1024, ZW, 10240, 16, WinT, 7168, 8, scr, r, lane); continue; } r -= I_AB;
            if (r < I_G) { p0_transpose_item(w_in, 1024, ZW, 7168, 3072, WgT, 0, 96, scr, r, lane); continue; } r -= I_G;
            if (r < I_MEM) { p0_transpose_item(w_mem, 1024, 2048, 0, 2048, WmemT, 0, 64, scr, r, lane); continue; } r -= I_MEM;
            if (r < I_OUT) { p0_transpose_item(w_out, 1024, 1024, 0, 1024, WoutT, 0, 32, scr, r, lane); continue; } r -= I_OUT;
            if (r < I_F1) { p0_transpose_item(w_ff1, 1024, 4096, 0, 4096, Wff1T, 0, 128, scr, r, lane); continue; } r -= I_F1;
            p0_transpose_item(w_ff2, 4096, 1024, 0, 1024, Wff2T, 0, 32, scr, r, lane);
        }
        for (int m = gw; m < R_ALL + 4096; m += NGW) {
            if (m < R_P) cvt_row_bf16(args.in[0] + (size_t)m * 1024, XB + (size_t)m * 1024, lane);
            else if (m < R_ALL) cvt_row_bf16(args.in[1] + (size_t)(m - R_P) * 1024, XB + (size_t)m * 1024, lane);
            else cvt_row_bf16(args.in[8] + (size_t)(m - R_ALL) * 1024, MB + (size_t)(m - R_ALL) * 1024, lane);
        }
        if (BOTH(0)) GRIDBAR(); STAMP(1);
    }
    if (IN(1)) {
        pg8::Gemm g{XB, WinT, R_ALL, 7424, 1024, MB, WmemT};
        P1Order S; S.G = GRID_N; S.c = BLK_X;
        EpiP1 E{ws, out};
        pg8::gemm_phase<EpiP1, P1Order, true, true, 1024>(L, g, S, E);
        if (BOTH(1)) GRIDBAR(); STAMP(2);
    }
    if (IN(2)) {
        for (int u = VCU; u < 3072 + 96; u += GRID_N) {
            if (u < 3072) { const int op = u % 3, blk = (u / 3) & 63, b = u / 192;
                gdn::conv_unit((bf16*)(ws + WS_QKVB), (const bf16*)(ws + WS_SB), args.in[10], nullptr, (long)b * 2048 + blk * 32, 32, blk ? (b * 64 + blk - 1) * 3 : -1, op); }
            else { const int v = u - 3072, op = v % 3, b = v / 3;
                gdn::conv_unit((bf16*)(ws + WS_QKVB), nullptr, args.in[10], args.in[4] + (size_t)b * 3 * 3072, (long)R_P + b * 16, 16, -1, op); }
        }
        GRIDBAR(); STAMP(9);
    }
    if (IN(2)) {
        constexpr int Q0_GP = 0, Q0_GS = 128, Q0_SA = Q0_GS + 256, Q0_SC = Q0_SA + 512, Q0_C1 = Q0_SC + 128, Q0_G = Q0_C1 + 128, Q0_C2 = Q0_G + 8, Q0_A1 = Q0_C2 + 384, Q0_O = Q0_A1 + 512,
                      Q0_A2 = Q0_O + 8, Q0_L1 = Q0_A2 + 256, Q0_A3 = Q0_L1 + 8, Q0_F1 = Q0_A3 + 256, Q0_A4 = Q0_F1 + 32, Q0_F2 = Q0_A4 + 512, Q0_A5 = Q0_F2 + 8, Q0_L2 = Q0_A5 + 512, Q0_END = Q0_L2 + 8;
        volatile LAS int* qslot = (volatile LAS int*)(L + MISC_OFF);
        struct OneUnit { int pm, pn, n;
            __device__ __forceinline__ bool next(int i, pg8::Unit& u) const { if (i >= n) return false; u.pm = pm; u.pn = pn + 4 * i; u.job = 0; return true; }
            __device__ __forceinline__ void a_ready(const pg8::Unit&) const {}
            __device__ __forceinline__ void done(const pg8::Unit&) const {} };
#define SC_CNT(stage, panel) (ctl + CW_SC + 64 * ((stage) * 2 + (panel)))
#define SC_DONE(stage, panel) do { asm volatile("s_waitcnt vmcnt(0)" ::: "memory"); __syncthreads(); \
            if (threadIdx.x == 0) { __builtin_amdgcn_fence(__ATOMIC_RELEASE, "agent"); asm volatile("s_waitcnt vmcnt(0)" ::: "memory"); __hip_atomic_fetch_add(SC_CNT(stage, panel), 1u, __ATOMIC_RELAXED, __HIP_MEMORY_SCOPE_AGENT); } } while (0)
#define SC_WAIT(stage, panel, need) do { if (threadIdx.x == 0) { unsigned sp_ = 0; while (__hip_atomic_load(SC_CNT(stage, panel), __ATOMIC_RELAXED, __HIP_MEMORY_SCOPE_AGENT) < (unsigned)(need)) { __builtin_amdgcn_s_sleep(8); if (++sp_ > (1u << 22)) break; } \
            __builtin_amdgcn_fence(__ATOMIC_ACQUIRE, "agent"); asm volatile("s_waitcnt vmcnt(0)" ::: "memory"); } __syncthreads(); } while (0)
        for (;;) {
            if (threadIdx.x == 0) qslot[0] = (int)__hip_atomic_fetch_add(ctl + CW_QUEUE, 1u, __ATOMIC_RELAXED, __HIP_MEMORY_SCOPE_AGENT);
            __syncthreads();
            const int it = __builtin_amdgcn_readfirstlane(qslot[0]);
            __syncthreads();
            if (it >= Q0_END) break;
#if defined(ITEM_PROBE)
            unsigned long long it_t0 = 0; if (it == ITEM_PROBE) it_t0 = __builtin_amdgcn_s_memrealtime();
#endif
            int au = -1, cu = -1;
            int skind = -1, sp = 0, spn = 0;
            int lane_q = threadIdx.x & 63; asm volatile("" : "+v"(lane_q));
            if (it < Q0_GS) { const int b = it >> 3, h = it & 7;
                gdn::gdn_unit(L, (const bf16*)(ws + WS_QKVB), (bf16*)(ws + WS_QKVB), (const float*)(ws + WS_AB), (long)b * 2048, h, 32, 64, args.in[11], args.in[12], args.in[13], nullptr,
                              out + O_SSMP + ((size_t)b * 8 + h) * 16384);
            } else if (it < Q0_SA) { const int u = it - Q0_GS, b = u >> 3, h = u & 7;
                gdn::gdn_unit(L, (const bf16*)(ws + WS_QKVB), (bf16*)(ws + WS_QKVB), (const float*)(ws + WS_AB), (long)R_P + b * 16, h, 1, 16, args.in[11], args.in[12], args.in[13],
                              args.in[5] + ((size_t)b * 8 + h) * 16384, out + O_SSMS + ((size_t)b * 8 + h) * 16384);
                SC_DONE(0, b >> 4);
            } else if (it < Q0_SC) { const int u = it - Q0_SA, b = u >> 4, h = u & 15; const size_t r0 = (size_t)(R_P + b * 16) * 1024 + h * 64;
                satt2::unit<64, 4>(L, (bf16*)(ws + WS_QA) + r0, args.in[2] + (size_t)b * 512 * 1024 + h * 64, args.in[3] + (size_t)b * 512 * 1024 + h * 64,
                                         (const bf16*)(ws + WS_KA) + r0, (const bf16*)(ws + WS_VA) + r0, args.in[14] + h * 257,
                                         out + O_AKS + (size_t)b * 512 * 1024 + h * 64, out + O_AVS + (size_t)b * 512 * 1024 + h * 64);
                SC_DONE(0, b >> 4);
            } else if (it < Q0_C1) { const int u = it - Q0_SC, b = u >> 2, h = u & 3; const size_t r0 = (size_t)(R_P + b * 16) * 1024 + h * 256;
                satt2::unit<256, 2>(L, (bf16*)(outb + DO_QC) + r0, args.in[6] + (size_t)b * 256 * 1024 + h * 256, args.in[7] + (size_t)b * 256 * 1024 + h * 256,
                                          nullptr, nullptr, nullptr, nullptr, nullptr);
                SC_DONE(0, b >> 4);
            } else if (it < Q0_G) cu = it - Q0_C1;
            else if (it < Q0_C2) { const int u = it - Q0_G, p = u >> 2, pc = u & 3;
                SC_WAIT(0, p, 448);
                skind = 0; sp = p; spn = pc;
            } else if (it < Q0_A1) cu = 128 + it - Q0_C2;
            else if (it < Q0_O) au = it - Q0_A1;
            else if (it < Q0_A2) { const int u = it - Q0_O, p = u >> 2, pn = u & 3;
                SC_WAIT(1, p, 4);
                skind = 2; sp = p; spn = pn;
            } else if (it < Q0_L1) au = 512 + it - Q0_A2;
            else if (it < Q0_A3) { const int u = it - Q0_L1, p = u >> 2, q4 = u & 3;
                SC_WAIT(2, p, 4);
                for (int r = wave; r < 64; r += NWAVES) { const int m = p * 256 + q4 * 64 + r; ln_row((float*)(ws + WS_ST1) + (size_t)m * 1024, args.in[17], args.in[18], (bf16*)(ws + WS_SHB) + (size_t)m * 1024, lane_q); }
                SC_DONE(3, p);
            } else if (it < Q0_F1) au = 768 + it - Q0_A3;
            else if (it < Q0_A4) { const int u = it - Q0_F1, p = u >> 4, pn = u & 15;
                SC_WAIT(3, p, 4);
                skind = 1; sp = p; spn = pn;
            } else if (it < Q0_F2) au = 1024 + it - Q0_A4;
            else if (it < Q0_A5) { const int u = it - Q0_F2, p = u >> 2, pn = u & 3;
                SC_WAIT(4, p, 16);
                skind = 3; sp = p; spn = pn;
            } else if (it < Q0_L2) au = 1536 + it - Q0_A5;
            else { const int u = it - Q0_L2, p = u >> 2, q4 = u & 3;
                SC_WAIT(5, p, 4);
                for (int r = wave; r < 64; r += NWAVES) { const int m = p * 256 + q4 * 64 + r; ln_row((float*)(ws + WS_ST1) + (size_t)m * 1024, args.in[23], args.in[24], nullptr, lane_q); }
            }
            if (skind == 0 || skind == 1) {
                pg8::Gemm g{skind == 0 ? XB + (size_t)R_P * 1024 : (const bf16*)(ws + WS_SHB), skind == 0 ? WgT : Wff1T, 512, skind == 0 ? 3072 : 4096, 1024, XB, WgT}; OneUnit S{sp, spn, skind == 0 ? 3 : 1};
                EpiSPerm E{skind, EpiGate{ws, outb, 1}, EpiFf1{(bf16*)(ws + WS_SFF), args.in[20]}};
                pg8::gemm_phase<EpiSPerm, OneUnit, false, true, 1024>(L, g, S, E);
                SC_DONE(skind == 0 ? 1 : 4, sp);
            } else if (skind >= 2) {
                pg8::Gemm g{(const bf16*)(ws + (skind == 2 ? WS_SMG : WS_SFF)), skind == 2 ? WoutT : Wff2T, 512, 1024, skind == 2 ? 1024 : 4096, XB, WoutT}; OneUnit S{sp, spn, 1};
                EpiResF32 E{skind == 2 ? args.in[1] : (const float*)(ws + WS_ST1), skind == 2 ? args.in[1] : (const float*)(ws + WS_ST1), (float*)(ws + WS_ST1), skind == 2 ? nullptr : args.in[22]};
                pg8::gemm_phase<EpiResF32, OneUnit, false, true, 0>(L, g, S, E);
                SC_DONE(skind == 2 ? 2 : 5, sp);
            }
            if (cu >= 0) att::attnC_unit(cu >> 5, (cu >> 3) & 3, cu & 7, (bf16*)(outb + DO_QC), (const bf16*)(ws + WS_MK), (const bf16*)(ws + WS_MV), L);
            if (au >= 0) { const int bh = au >> 3; att::attnA_unit(bh >> 4, bh & 15, au & 7, (bf16*)(ws + WS_QA), (const bf16*)(ws + WS_KA), (const bf16*)(ws + WS_VA), args.in[14], L); }
#if defined(ITEM_PROBE)
            if (it == ITEM_PROBE && threadIdx.x == 0) ((volatile unsigned long long*)(ws + WS_CTL + CW_TS * 4))[24] = __builtin_amdgcn_s_memrealtime() - it_t0;
#endif
        }
#undef SC_CNT
#undef SC_DONE
#undef SC_WAIT
        if (BOTH(2)) GRIDBAR(); STAMP(3);
    }
    if (IN(3)) {
        pg8::Gemm g{XB, WgT, R_P, 3072, 1024, XB, WgT};
        P3OrderT<128> S; S.G = GRID_N; S.c = BLK_X;
        EpiGate E{ws, outb, 0};
        pg8::gemm_phase<EpiGate, P3OrderT<128>, true, true, 1024>(L, g, S, E);
        if (BOTH(3)) GRIDBAR(); STAMP(4);
    }
    if (IN(4)) {
        pg8::Gemm g{(const bf16*)(ws + WS_KA), WoutT, R_P, 1024, 1024, (const bf16*)(ws + WS_KA), WoutT};
        pg8::StaticOrder S; S.init(R_P, 1024, GRID_N, BLK_X);
        EpiResF32 E{args.in[0], args.in[1], out, nullptr};
        pg8::gemm_phase<EpiResF32, pg8::StaticOrder, true, true, 1024>(L, g, S, E);
        if (BOTH(4)) GRIDBAR(); STAMP(5);
    }
    if (IN(5)) {
        const int gw = VCU * NWAVES + wave, NGW = GRID_N * NWAVES;
        for (int m = gw; m < R_P; m += NGW) ln_row(out + (size_t)m * 1024, args.in[17], args.in[18], HB + (size_t)m * 1024, lane);
        if (BOTH(5)) GRIDBAR(); STAMP(6);
    }
    if (IN(6)) {
        pg8::Gemm g{HB, Wff1T, R_P, 4096, 1024, HB, Wff1T};
        pg8::StaticOrder S; S.init(R_P, 4096, GRID_N, BLK_X);
        EpiFf1 E{FF, args.in[20]};
        pg8::gemm_phase<EpiFf1, pg8::StaticOrder, true, true, 1024>(L, g, S, E);
        if (BOTH(6)) GRIDBAR(); STAMP(7);
    }
    if (IN(7)) {
        pg8::Gemm g{FF, Wff2T, R_P, 1024, 4096, FF, Wff2T};
        pg8::StaticOrder S; S.init(R_P, 1024, GRID_N, BLK_X);
        EpiResF32 E{out, out + (size_t)R_P * 1024, out, args.in[22]};
        pg8::gemm_phase<EpiResF32, pg8::StaticOrder, true, true, 4096>(L, g, S, E);
        if (BOTH(7)) GRIDBAR(); STAMP(8);
    }
    if (IN(8)) {
        const int gw = VCU * NWAVES + wave, NGW = GRID_N * NWAVES;
        for (int m = gw; m < R_P; m += NGW) ln_row(out + (size_t)m * 1024, args.in[23], args.in[24], nullptr, lane);
        for (int m = gw; m < R_S; m += NGW) { const GAS f32x4* sr = (const GAS f32x4*)((const float*)(ws + WS_ST1) + (size_t)m * 1024) + lane; GAS f32x4* dr = (GAS f32x4*)(out + O_YS + (size_t)m * 1024) + lane;
#pragma unroll
            for (int j = 0; j < 4; ++j) dr[64 * j] = sr[64 * j]; }
#if defined(PROBE_A)
        { const volatile unsigned long long* ts = (const volatile unsigned long long*)(ws + WS_CTL + CW_TS * 4);
#if defined(ITEM_PROBE)
          const float eps = floorf((float)ts[24] * 1e-5f * ITEM_Q) / ITEM_Q + 0.5f / ITEM_Q;
#elif defined(GDN_PROBE)
          const float eps = (GDN_PROBE == 5) ? floorf((float)ts[16 + 5] * 1e-5f * 10.f) * 0.1f + 0.05f : rintf((float)ts[16 + GDN_PROBE] / (float)ts[16 + 5] * 20.f) * 0.05f + 0.01f;
#else
          const float eps = floorf((float)(ts[PROBE_B] - ts[PROBE_A]) * 1e-5f * PROBE_Q) / PROBE_Q + 0.5f / PROBE_Q;
#endif
          asm volatile("s_waitcnt vmcnt(0)" ::: "memory");
          for (int m = R_P + gw; m < R_ALL; m += NGW) { GAS f32x4* xr = (GAS f32x4*)(out + (size_t)m * 1024) + lane;
              for (int j = 0; j < 4; ++j) xr[64 * j] = xr[64 * j] * (1.f + eps); } }
#endif
    }
#undef IN
#undef BOTH
}
extern "C" void kernel_launch(void* const* d_in, const int* in_sizes, int n_in, void* d_out, int out_size, void* d_ws, size_t ws_size, hipStream_t stream) {
    (void)in_sizes; (void)n_in; (void)out_size;
    static int inited = 0;
    if (!inited) { if (hipFuncSetAttribute((const void*)mega_fwd, hipFuncAttributeMaxDynamicSharedMemorySize, LDS_BYTES) != hipSuccess) fprintf(stderr, "hipFuncSetAttribute failed\n"); inited = 1; }
    if (ws_size < WS_END) { fprintf(stderr, "kernel_launch: workspace too small (%zu < %zu)\n", ws_size, (size_t)WS_END); return; }
    unsigned char* ws = (unsigned char*)d_ws;
    (void)hipMemsetAsync(ws + WS_CTL, 0, CTL_ZERO_BYTES, stream);
    Args a{}; for (int i = 0; i < 25; ++i) a.in[i] = (const float*)d_in[i];
    a.out = (float*)d_out; a.ws = ws; a.ph_lo = 0; a.ph_hi = 9;
    hipLaunchKernelGGL(mega_fwd, dim3(256), dim3(NWAVES * 64), LDS_BYTES, stream, a);
}
```
